# Optimizing an MI355X kernel written in HIP

```python
import math
import jax, jax.numpy as jnp
from jax import lax
import numpy as np

D_MODEL = 2048
BATCH = 2
SEQ = 16384
DEPTH = 1
DEC_BATCH = 32
DEC_SEQ = 64
PAST_LEN = 1024

CHUNK = 64
N_META = 16
Q_BLOCK = 128
GLA_HEADS = 4
GLA_DK = D_MODEL // (2 * GLA_HEADS)
GLA_DV = D_MODEL // GLA_HEADS
GATE_RANK = 16
GLA_TAU = 16.0
DIFF_HEADS = 8
DIFF_DQK = D_MODEL // (2 * DIFF_HEADS)
DIFF_DV = 2 * DIFF_DQK
ROPE_DIM = DIFF_DQK // 4
ROPE_THETA = 500000.0
D_FF = 4 * D_MODEL
EPS = 1e-6
SPLIT_SIZES = (GLA_HEADS * GLA_DK, GLA_HEADS * GLA_DK, GLA_HEADS * GLA_DV, GATE_RANK, GLA_HEADS * GLA_DV,
               2 * DIFF_HEADS * DIFF_DQK, 2 * DIFF_HEADS * DIFF_DQK, DIFF_HEADS * DIFF_DV, D_MODEL, D_MODEL)
IN_COLS = sum(SPLIT_SIZES)

kernel_name = 'hybrid_gla_diffattn_streaming_step'


def rmsnorm(x, g):
    xf = x.astype(jnp.float32)
    y = xf * lax.rsqrt(jnp.mean(jnp.square(xf), axis=-1, keepdims=True) + EPS)
    return (y * g.astype(jnp.float32)).astype(x.dtype)


def rope(x, pos):
    half = ROPE_DIM // 2
    inv_freq = jnp.power(ROPE_THETA, -jnp.arange(0, ROPE_DIM, 2, dtype=jnp.float32) / ROPE_DIM)
    ang = pos[:, None] * inv_freq[None, :]
    cos = jnp.cos(ang)[:, None, None, :]
    sin = jnp.sin(ang)[:, None, None, :]
    xf = x.astype(jnp.float32)
    x1 = xf[..., :half]
    x2 = xf[..., half:ROPE_DIM]
    out = jnp.concatenate([x1 * cos - x2 * sin, x2 * cos + x1 * sin, xf[..., ROPE_DIM:]], axis=-1)
    return out.astype(x.dtype)


def in_projection(u, lp):
    B, T = u.shape[:2]
    z = u @ lp['w_in']
    parts = []
    off = 0
    for size in SPLIT_SIZES:
        parts.append(z[..., off:off + size])
        off += size
    gq, gk, gv, alow, r, dq, dk, dv, ga, gb = parts
    gq = gq.reshape(B, T, GLA_HEADS, GLA_DK) * (GLA_DK ** -0.5)
    gk = gk.reshape(B, T, GLA_HEADS, GLA_DK)
    gv = gv.reshape(B, T, GLA_HEADS, GLA_DV)
    log_a = jax.nn.log_sigmoid((alow @ lp['w_gla_a2'] + lp['b_gla_a']).astype(jnp.float32)) / GLA_TAU
    log_a = log_a.reshape(B, T, GLA_HEADS, GLA_DK)
    dq = dq.reshape(B, T, DIFF_HEADS, 2, DIFF_DQK)
    dk = dk.reshape(B, T, DIFF_HEADS, 2, DIFF_DQK)
    dv = dv.reshape(B, T, DIFF_HEADS, DIFF_DV)
    return gq, gk, gv, log_a, r, dq, dk, dv, ga, gb


def gla_chunk(S, q, k, v, log_a):
    T = q.shape[1]
    b = jnp.cumsum(log_a, axis=1)
    qf = q.astype(jnp.float32)
    kf = k.astype(jnp.float32)
    vf = v.astype(jnp.float32)
    Sf = S.astype(jnp.float32)
    inter = jnp.einsum('bthc,bhcv->bthv', qf * jnp.exp(b), Sf)
    causal = jnp.tril(jnp.ones((T, T), dtype=bool))[None, :, :, None, None]
    rel = jnp.where(causal, b[:, :, None] - b[:, None], -jnp.inf)
    scores = jnp.einsum('bthc,bshc,btshc->bhts', qf, kf, jnp.exp(rel))
    intra = jnp.einsum('bhts,bshv->bthv', scores, vf)
    b_last = b[:, -1]
    k_dec = kf * jnp.exp(b_last[:, None] - b)
    S_new = jnp.exp(b_last)[..., None] * Sf + jnp.einsum('bshc,bshv->bhcv', k_dec, vf)
    return (inter + intra).astype(v.dtype), S_new.astype(S.dtype)


def diff_lambda(lp, lam_init):
    f = jnp.float32
    return (jnp.exp(jnp.sum(lp['diff_lq1'].astype(f) * lp['diff_lk1'].astype(f)))
            - jnp.exp(jnp.sum(lp['diff_lq2'].astype(f) * lp['diff_lk2'].astype(f))) + lam_init)


def diff_attend(q, k, v, mask, lam):
    s = jnp.einsum('bqhmd,bkhmd->bhmqk', q, k).astype(jnp.float32) * (DIFF_DQK ** -0.5)
    s = jnp.where(mask, s, -jnp.inf)
    p = jax.nn.softmax(s, axis=-1)
    pd = p[:, :, 0] - lam * p[:, :, 1]
    return jnp.einsum('bhqk,bkhv->bqhv', pd.astype(v.dtype), v)


def merge_and_ffn(x, o_gla, r, o_diff, ga, gb, lp, lam_init):
    B, T = x.shape[:2]
    a = rmsnorm(o_gla, lp['gla_norm']).reshape(B, T, GLA_HEADS * GLA_DV) * jax.nn.silu(r)
    d = (rmsnorm(o_diff, lp['diff_norm']) * (1.0 - lam_init)).reshape(B, T, DIFF_HEADS * DIFF_DV)
    mix = jax.nn.sigmoid(ga) * (a @ lp['w_br_gla']) + jax.nn.sigmoid(gb) * (d @ lp['w_br_diff'])
    h = x + rmsnorm(mix @ lp['w_o'], lp['norm_mix_post'])
    m = jnp.square(jax.nn.relu(rmsnorm(h, lp['norm_ffn_pre']) @ lp['w_ff1'])) @ lp['w_ff2']
    return h + rmsnorm(m, lp['norm_ffn_post'])


def prompt_layer(x, lp, lam_init):
    Bp, L = x.shape[:2]
    n_real = L - N_META
    u = rmsnorm(x, lp['norm_mix_pre'])
    gq, gk, gv, log_a, r, dq, dk, dv, ga, gb = in_projection(u, lp)
    S0 = jnp.zeros((Bp, GLA_HEADS, GLA_DK, GLA_DV), dtype=x.dtype)
    o_meta, S = gla_chunk(S0, gq[:, :N_META], gk[:, :N_META], gv[:, :N_META], log_a[:, :N_META])

    def to_chunks(t):
        return jnp.moveaxis(t[:, N_META:].reshape((Bp, n_real // CHUNK, CHUNK) + t.shape[2:]), 1, 0)

    def step(S_c, xs):
        o, S_n = gla_chunk(S_c, *xs)
        return S_n, o

    S_fin, o_real = lax.scan(step, S, (to_chunks(gq), to_chunks(gk), to_chunks(gv), to_chunks(log_a)))
    o_real = jnp.moveaxis(o_real, 0, 1).reshape(Bp, n_real, GLA_HEADS, GLA_DV)
    o_gla = jnp.concatenate([o_meta, o_real], axis=1)
    pos = jnp.arange(L, dtype=jnp.float32)
    dq = rope(dq, pos)
    dk = rope(dk, pos)
    lam = diff_lambda(lp, lam_init)
    o_dmeta = diff_attend(dq[:, :N_META], dk[:, :N_META], dv[:, :N_META],
                          jnp.ones((N_META, N_META), dtype=bool), lam)
    key_chunk = jnp.concatenate([-jnp.ones((N_META,), jnp.int32), jnp.arange(n_real, dtype=jnp.int32) // CHUNK])
    n_blk = n_real // Q_BLOCK
    q_blocks = jnp.moveaxis(dq[:, N_META:].reshape(Bp, n_blk, Q_BLOCK, DIFF_HEADS, 2, DIFF_DQK), 1, 0)

    def attend_block(args):
        qb, i = args
        q_chunk = (i * Q_BLOCK + jnp.arange(Q_BLOCK, dtype=jnp.int32)) // CHUNK
        mask = key_chunk[None, :] <= q_chunk[:, None]
        return diff_attend(qb, dk, dv, mask, lam)

    o_dreal = lax.map(attend_block, (q_blocks, jnp.arange(n_blk, dtype=jnp.int32)))
    o_dreal = jnp.moveaxis(o_dreal, 0, 1).reshape(Bp, n_real, DIFF_HEADS, DIFF_DV)
    o_diff = jnp.concatenate([o_dmeta, o_dreal], axis=1)
    y = merge_and_ffn(x, o_gla, r, o_diff, ga, gb, lp, lam_init)
    return y, dk, dv, S_fin


def sample_layer(x, cache_k_l, cache_v_l, state_l, lp, lam_init):
    T = x.shape[1]
    P = cache_k_l.shape[1]
    u = rmsnorm(x, lp['norm_mix_pre'])
    gq, gk, gv, log_a, r, dq, dk, dv, ga, gb = in_projection(u, lp)
    o_gla, S_new = gla_chunk(state_l, gq, gk, gv, log_a)
    pos = jnp.arange(T, dtype=jnp.float32) + P
    dq = rope(dq, pos)
    dk = rope(dk, pos)
    lam = diff_lambda(lp, lam_init)
    k_all = jnp.concatenate([cache_k_l.astype(dk.dtype), dk], axis=1)
    v_all = jnp.concatenate([cache_v_l.astype(dv.dtype), dv], axis=1)
    o_diff = diff_attend(dq, k_all, v_all, jnp.ones((T, P + T), dtype=bool), lam)
    y = merge_and_ffn(x, o_gla, r, o_diff, ga, gb, lp, lam_init)
    return y, dk, dv, S_new


def setup_inputs(seed: int = 0) -> dict:
    key = jax.random.key(seed)
    ks = jax.random.split(key, 24)
    f32 = jnp.float32

    def nrm(k, shape, scale=1.0):
        return jax.random.normal(k, shape, f32) * scale

    def gain(k, n):
        return 1.0 + 0.02 * jax.random.normal(k, (DEPTH, n), f32)

    return {
        'x_prompt': nrm(ks[0], (BATCH, SEQ, D_MODEL)),
        'x_sample': nrm(ks[1], (DEC_BATCH, DEC_SEQ, D_MODEL)),
        'cache_k': nrm(ks[2], (DEPTH, DEC_BATCH, PAST_LEN, DIFF_HEADS, 2, DIFF_DQK)),
        'cache_v': nrm(ks[3], (DEPTH, DEC_BATCH, PAST_LEN, DIFF_HEADS, DIFF_DV)),
        'state_gla': nrm(ks[4], (DEPTH, DEC_BATCH, GLA_HEADS, GLA_DK, GLA_DV), 0.5),
        'meta': nrm(ks[5], (N_META, D_MODEL)),
        'norm_mix_pre': gain(ks[6], D_MODEL),
        'w_in': nrm(ks[7], (DEPTH, D_MODEL, IN_COLS), D_MODEL ** -0.5),
        'w_gla_a2': nrm(ks[8], (DEPTH, GATE_RANK, GLA_HEADS * GLA_DK), GATE_RANK ** -0.5),
        'b_gla_a': nrm(ks[9], (DEPTH, GLA_HEADS * GLA_DK), 0.1),
        'gla_norm': gain(ks[10], GLA_DV),
        'diff_lq1': nrm(ks[11], (DEPTH, DIFF_DQK), 0.1),
        'diff_lk1': nrm(ks[12], (DEPTH, DIFF_DQK), 0.1),
        'diff_lq2': nrm(ks[13], (DEPTH, DIFF_DQK), 0.1),
        'diff_lk2': nrm(ks[14], (DEPTH, DIFF_DQK), 0.1),
        'diff_norm': gain(ks[15], DIFF_DV),
        'w_br_gla': nrm(ks[16], (DEPTH, GLA_HEADS * GLA_DV, D_MODEL), (GLA_HEADS * GLA_DV) ** -0.5),
        'w_br_diff': nrm(ks[17], (DEPTH, DIFF_HEADS * DIFF_DV, D_MODEL), (DIFF_HEADS * DIFF_DV) ** -0.5),
        'w_o': nrm(ks[18], (DEPTH, D_MODEL, D_MODEL), D_MODEL ** -0.5),
        'norm_mix_post': gain(ks[19], D_MODEL),
        'norm_ffn_pre': gain(ks[20], D_MODEL),
        'w_ff1': nrm(ks[21], (DEPTH, D_MODEL, D_FF), D_MODEL ** -0.5),
        'w_ff2': nrm(ks[22], (DEPTH, D_FF, D_MODEL), D_FF ** -0.5),
        'norm_ffn_post': gain(ks[23], D_MODEL),
    }


def reference(x_prompt, x_sample, cache_k, cache_v, state_gla, meta, norm_mix_pre, w_in, w_gla_a2,
              b_gla_a, gla_norm, diff_lq1, diff_lk1, diff_lq2, diff_lk2, diff_norm, w_br_gla, w_br_diff,
              w_o, norm_mix_post, norm_ffn_pre, w_ff1, w_ff2, norm_ffn_post):
    Bp = x_prompt.shape[0]
    hp = jnp.concatenate([jnp.broadcast_to(meta[None].astype(x_prompt.dtype), (Bp, N_META, D_MODEL)),
                          x_prompt], axis=1)
    hs = x_sample
    kp_list, vp_list, sp_list, ks_list, vs_list, ss_list = [], [], [], [], [], []
    for l in range(DEPTH):
        lp = {
            'norm_mix_pre': norm_mix_pre[l], 'w_in': w_in[l], 'w_gla_a2': w_gla_a2[l], 'b_gla_a': b_gla_a[l],
            'gla_norm': gla_norm[l], 'diff_lq1': diff_lq1[l], 'diff_lk1': diff_lk1[l],
            'diff_lq2': diff_lq2[l], 'diff_lk2': diff_lk2[l], 'diff_norm': diff_norm[l],
            'w_br_gla': w_br_gla[l], 'w_br_diff': w_br_diff[l], 'w_o': w_o[l],
            'norm_mix_post': norm_mix_post[l], 'norm_ffn_pre': norm_ffn_pre[l],
            'w_ff1': w_ff1[l], 'w_ff2': w_ff2[l], 'norm_ffn_post': norm_ffn_post[l],
        }
        lam_init = 0.8 - 0.6 * math.exp(-0.3 * l)
        hp, kp, vp, sp = prompt_layer(hp, lp, lam_init)
        hs, kn, vn, sn = sample_layer(hs, cache_k[l], cache_v[l], state_gla[l], lp, lam_init)
        kp_list.append(kp)
        vp_list.append(vp)
        sp_list.append(sp)
        ks_list.append(kn)
        vs_list.append(vn)
        ss_list.append(sn)
    y_prompt = hp[:, N_META:]
    y_sample = hs
    new_k_prompt = jnp.stack(kp_list, axis=0)
    new_v_prompt = jnp.stack(vp_list, axis=0)
    new_state_gla_prompt = jnp.stack(sp_list, axis=0)
    new_k_sample = jnp.stack(ks_list, axis=0)
    new_v_sample = jnp.stack(vs_list, axis=0)
    new_state_gla_sample = jnp.stack(ss_list, axis=0)
    return (y_prompt, y_sample, new_k_prompt, new_v_prompt, new_state_gla_prompt,
            new_k_sample, new_v_sample, new_state_gla_sample)
```

```cpp
#include <hip/hip_runtime.h>
#include <cstdio>
#include <cstdint>

#define GAS __attribute__((address_space(1)))
#define LAS __attribute__((address_space(3)))
typedef unsigned short bf16_t;
typedef short bf16x8 __attribute__((ext_vector_type(8)));
typedef short s16x4 __attribute__((ext_vector_type(4)));
typedef float f32x4 __attribute__((ext_vector_type(4)));
typedef float f32x2 __attribute__((ext_vector_type(2)));
typedef float f32x16 __attribute__((ext_vector_type(16)));
typedef unsigned u32x4 __attribute__((ext_vector_type(4)));
typedef unsigned u32x2 __attribute__((ext_vector_type(2)));
typedef GAS unsigned gu32;

__device__ __forceinline__ unsigned cvt_pk_bf16(float lo, float hi) { unsigned r; asm volatile("v_cvt_pk_bf16_f32 %0, %1, %2" : "=v"(r) : "v"(lo), "v"(hi)); return r; }
__device__ __forceinline__ float bf_lo(unsigned w) { return __uint_as_float(w << 16); }
__device__ __forceinline__ float bf_hi(unsigned w) { return __uint_as_float(w & 0xffff0000u); }
__device__ __forceinline__ float bf2f(bf16_t b) { return __uint_as_float(((unsigned)b) << 16); }
__device__ __forceinline__ unsigned f2bf(float f) { unsigned u = __float_as_uint(f); return (u + 0x7fffu + ((u >> 16) & 1u)) >> 16; }
__device__ __forceinline__ int lane_id() { int l; asm volatile("v_mbcnt_lo_u32_b32 %0, -1, 0\n\tv_mbcnt_hi_u32_b32 %0, -1, %0" : "=v"(l) :: "memory"); return l; }
__device__ __forceinline__ float xor1(float v) { return __int_as_float(__builtin_amdgcn_update_dpp(0, __float_as_int(v), 0xB1, 0xf, 0xf, false)); }
__device__ __forceinline__ float sigmoidf_(float x) { return __builtin_amdgcn_rcpf(1.0f + __expf(-x)); }

constexpr int DM = 2048, NBATCH = 2, SEQ = 16384, NMETA = 16, LP = SEQ + NMETA;
constexpr int BS = 16640, PADR = 240;
constexpr int NSMP = 32, TSMP = 64, PAST = 1024;
constexpr int SR0 = NBATCH * BS;
constexpr int TP = SR0 + NSMP * TSMP;
constexpr int NCHUNK = TP / 64;
constexpr int DFF = 8192;
constexpr float EPS = 1e-6f;
constexpr int N1 = 12544;

constexpr size_t O_YP = 0, O_YS = 67108864, O_KP = 71303168, O_VP = 138477568, O_SP = 205651968, O_KS = 206700544, O_VS = 210894848, O_SS = 215089152, O_END = 231866368;

__host__ __device__ __forceinline__ int v_img_off(int key, int col) { const int sg = (key & 3) + 4 * ((key >> 4) & 1) + 8 * ((key >> 2) & 3);
    return ((col >> 5) * 32 + sg) * 64 + ((((col >> 4) & 1) ^ ((sg >> 2) & 1)) * 32) + (col & 15) * 2; }

namespace pg8 {
constexpr int BM = 256, BK = 64, HALF = 128, HTB = HALF * BK * 2, STAGE_BYTES = 8 * HTB, NXCD = 8;
__host__ __device__ __forceinline__ int lds_byte(int r, int c) { const int st = (r >> 4) * 2 + (c >> 5), rr = r & 15, cc = c & 31, ob = rr * 64 + cc * 2; return st * 1024 + (ob ^ (((ob >> 9) & 1) << 5)); }
__host__ __device__ __forceinline__ void stage_rc(int b, int& R, int& C) { const int st = b / 1024, sb = b % 1024, swz = sb ^ (((sb >> 9) & 1) << 5); R = (st >> 1) * 16 + swz / 64; C = (st & 1) * 32 + (swz % 64) / 2; }
__host__ __device__ __forceinline__ int perm32(int rho) { const int n = rho >> 4, i = rho & 15; return 8 * (i >> 2) + 4 * n + (i & 3); }

struct Unit { int pm, pn, sub; };

__device__ __forceinline__ bool tile_of(long L, int nM, int nN, Unit& u, const int WGM, const bool rev = false) {
    const int nwg = nM * nN; if (L >= nwg) return false;
    int wgid = (int)L; { const int q = nwg / NXCD, r = nwg % NXCD, xcd = wgid % NXCD; int off = wgid / NXCD; if (rev) off = q + (xcd < r ? 1 : 0) - 1 - off;
      wgid = (xcd < r ? xcd * (q + 1) : r * (q + 1) + (xcd - r) * q) + off; }
    const int nig = WGM * nN, gid = wgid / nig, fm = gid * WGM, gsz = (nM - fm) < WGM ? (nM - fm) : WGM;
    u.pm = fm + ((wgid % nig) % gsz); u.pn = (wgid % nig) / gsz; u.sub = 0; return true;
}
struct StaticOrder {
    const bf16_t* A; const bf16_t* Bt; int nM, nN, G, c, K, wgm; bool rev = false;
    __device__ __forceinline__ bool next(int i, Unit& u) const { return tile_of((long)i * G + c, nM, nN, u, wgm, rev); }
    __device__ __forceinline__ void addr(const Unit& u, const char*& a, const char*& b) const { a = (const char*)A + (size_t)u.pm * 256 * K * 2; b = (const char*)Bt + (size_t)u.pn * 256 * K * 2; }
};

template <class Epi, class Sched>
__device__ __forceinline__ void gemm_phase(LAS unsigned char* lds, const int K, const Sched& S, const Epi& E, const int wid) {
    const int lane = lane_id(), tid = wid * 64 + lane, wr = wid >> 2, wc = wid & 3, fr = lane & 15, fq = lane >> 4;
    const int nt = K / BK;
    unsigned voffA[2], voffB[2];
#pragma unroll
    for (int i = 0; i < 2; ++i) { int R, C; stage_rc(tid * 16 + i * 8192, R, C); const int Rb = Epi::PERM ? ((R & ~31) + perm32(R & 31)) : R;
        voffA[i] = (unsigned)(R * K + C) * 2u; voffB[i] = (unsigned)(Rb * K + C) * 2u; }
    const size_t kstep = (size_t)(BK * 2);
    const size_t hstep = (size_t)HALF * K * 2;
    const unsigned ldsw = (unsigned)wid * 1024u;
    const int aoff = lds_byte(wr * 64 + fr, fq * 8), boff = lds_byte(wc * 32 + fr, fq * 8);
#define PG8_SA(b, h) (((b) * 2 + (h)) * HTB)
#define PG8_SB(b, h) ((4 + (b) * 2 + (h)) * HTB)
#define PG8_STAGE(bufoff, gbase, voff) do { _Pragma("unroll") for (int _i = 0; _i < 2; ++_i) \
        __builtin_amdgcn_global_load_lds((const unsigned*)((const char*)(gbase) + (voff)[_i]), (LAS unsigned*)(lds + (bufoff) + ldsw + _i * 8192), 16, 0, 0); } while (0)
#define PG8_LDA(dst, b, h) do { _Pragma("unroll") for (int m = 0; m < 4; ++m) _Pragma("unroll") for (int k = 0; k < 2; ++k) dst[m][k] = *(const LAS bf16x8*)(lds + PG8_SA(b, h) + aoff + m * 2048 + k * 1024); } while (0)
#define PG8_LDB(dst, b, h) do { _Pragma("unroll") for (int n = 0; n < 2; ++n) _Pragma("unroll") for (int k = 0; k < 2; ++k) dst[n][k] = *(const LAS bf16x8*)(lds + PG8_SB(b, h) + boff + n * 2048 + k * 1024); } while (0)
#define PG8_MMA(ai, bj, At, Bt) do { __builtin_amdgcn_s_setprio(1); _Pragma("unroll") for (int m = 0; m < 4; ++m) _Pragma("unroll") for (int n = 0; n < 2; ++n) _Pragma("unroll") for (int k = 0; k < 2; ++k) \
        acc[ai][bj][m][n] = __builtin_amdgcn_mfma_f32_16x16x32_bf16(Bt[n][k], At[m][k], acc[ai][bj][m][n], 0, 0, 0); __builtin_amdgcn_s_setprio(0); } while (0)
#define PG8_WAIT_V(n) asm volatile("s_waitcnt vmcnt(" #n ")" ::: "memory")
#define PG8_WAIT_L(n) asm volatile("s_waitcnt lgkmcnt(" #n ")" ::: "memory")
#define PG8_BAR __builtin_amdgcn_s_barrier()
#define PG8_SCHED __builtin_amdgcn_sched_barrier(0)
    Unit cur, nxt; int ui = 0;
    if (!S.next(0, cur)) return;
    f32x4 acc[2][2][4][2];
#pragma unroll
    for (int a = 0; a < 2; ++a)
#pragma unroll
        for (int b = 0; b < 2; ++b)
#pragma unroll
            for (int m = 0; m < 4; ++m)
#pragma unroll
                for (int n = 0; n < 2; ++n) acc[a][b][m][n] = (f32x4){0.f, 0.f, 0.f, 0.f};
    bf16x8 At[4][2], B0[2][2], B1[2][2];
    const char* cA; const char* cB; S.addr(cur, cA, cB);
    PG8_STAGE(PG8_SB(0, 0), cB, voffB); PG8_STAGE(PG8_SB(0, 1), cB + hstep, voffB); PG8_STAGE(PG8_SA(0, 0), cA, voffA); PG8_STAGE(PG8_SA(0, 1), cA + hstep, voffA);
    if (wr == 1) PG8_BAR;
    PG8_WAIT_V(2); PG8_BAR;
    PG8_STAGE(PG8_SB(1, 0), cB + kstep, voffB); PG8_STAGE(PG8_SA(1, 0), cA + kstep, voffA); PG8_STAGE(PG8_SB(1, 1), cB + hstep + kstep, voffB);
    PG8_WAIT_V(6); PG8_BAR;
    for (;;) {
        const bool has_next = S.next(ui + 1, nxt);
        const char* nA = cA; const char* nB = cB; if (has_next) S.addr(nxt, nA, nB);
        for (int t = 0; t < nt; t += 2) {
            const bool last = (t == nt - 2);
            const char* a1 = cA + (size_t)(t + 1) * kstep;
            const char* a2 = last ? nA : cA + (size_t)(t + 2) * kstep; const char* b2 = last ? nB : cB + (size_t)(t + 2) * kstep;
            const char* a3 = a2 + kstep; const char* b3 = b2 + kstep;
            PG8_LDB(B0, 0, 0); PG8_LDB(B1, 0, 1); PG8_SCHED; PG8_LDA(At, 0, 0); PG8_STAGE(PG8_SA(1, 1), a1 + hstep, voffA);
            PG8_WAIT_V(8); PG8_WAIT_L(0); PG8_BAR; PG8_MMA(0, 0, At, B0); PG8_MMA(0, 1, At, B1); PG8_BAR; PG8_SCHED;
            PG8_LDA(At, 0, 1); PG8_STAGE(PG8_SB(0, 0), b2, voffB); PG8_STAGE(PG8_SB(0, 1), b2 + hstep, voffB); PG8_STAGE(PG8_SA(0, 0), a2, voffA);
            PG8_WAIT_V(8); PG8_WAIT_L(0); PG8_BAR; PG8_MMA(1, 0, At, B0); PG8_MMA(1, 1, At, B1); PG8_BAR; PG8_SCHED;
            PG8_LDB(B0, 1, 0); PG8_LDB(B1, 1, 1); PG8_SCHED; PG8_LDA(At, 1, 0); PG8_STAGE(PG8_SA(0, 1), a2 + hstep, voffA);
            PG8_WAIT_V(8); PG8_WAIT_L(0); PG8_BAR; PG8_MMA(0, 0, At, B0); PG8_MMA(0, 1, At, B1); PG8_BAR; PG8_SCHED;
            PG8_LDA(At, 1, 1); PG8_STAGE(PG8_SB(1, 0), b3, voffB); PG8_STAGE(PG8_SB(1, 1), b3 + hstep, voffB); PG8_STAGE(PG8_SA(1, 0), a3, voffA);
            PG8_WAIT_V(8); PG8_WAIT_L(0); PG8_BAR; PG8_MMA(1, 0, At, B0); PG8_MMA(1, 1, At, B1); PG8_BAR; PG8_SCHED;
        }
        if (wr == 0) PG8_BAR;
        const bool keep = E(acc, cur, wr, wc, fr, fq);
        if (!has_next) break;
        if (!keep) {
#pragma unroll
        for (int a = 0; a < 2; ++a)
#pragma unroll
            for (int b = 0; b < 2; ++b)
#pragma unroll
                for (int m = 0; m < 4; ++m)
#pragma unroll
                    for (int n = 0; n < 2; ++n) acc[a][b][m][n] = (f32x4){0.f, 0.f, 0.f, 0.f};
        }
        cur = nxt; cA = nA; cB = nB; ++ui;
        if (wr == 1) PG8_BAR;
    }
    PG8_WAIT_V(0);
    PG8_BAR;
#undef PG8_SA
#undef PG8_SB
#undef PG8_STAGE
#undef PG8_LDA
#undef PG8_LDB
#undef PG8_MMA
#undef PG8_WAIT_V
#undef PG8_WAIT_L
#undef PG8_BAR
#undef PG8_SCHED
}
}
namespace att {
constexpr float SCALE = 0.08838834764831845f;
constexpr float THR = 8.f;
constexpr int NW = 8, QBLK = 32, KVBLK = 64, QB = NW * QBLK, D = 128, PITCH = 2048;
constexpr int SHM_V = KVBLK * D * 2, SHM_K = KVBLK * D * 2;
constexpr int LDS_BYTES = 2 * SHM_V + 2 * SHM_K + NW * 64 * 4;

#define KSWZ(row, colB) ((row) * 256 + ((colB) ^ (((row) & 7) << 4)))
#define SBAR() __builtin_amdgcn_sched_barrier(0)
__device__ __forceinline__ int v_st(int k, int c) { const int kk = (k & ~0xC) | ((k & 4) << 1) | ((k & 8) >> 1); return ((kk >> 3) * 4 + (c >> 5)) * 512 + ((kk & 7) * 32 + (c & 31)) * 2; }
__device__ __forceinline__ int v_rd_base(int lane) { return ((lane & 3) << 3) | (((lane >> 2) & 3) << 6) | (((lane >> 4) & 1) << 5) | (((lane >> 5) & 1) << 8); }
constexpr int v_rd_off(int d0, int ks, int half) { return d0 * 512 + ks * 4096 + half * 2048; }
__device__ __forceinline__ int crow(int r, int hi) { return (r & 3) + 8 * (r >> 2) + 4 * hi; }
__device__ __forceinline__ bf16x8 load8(const bf16_t* p) { return *reinterpret_cast<const bf16x8*>(p); }

__device__ __forceinline__ void mask_tile_bc(f32x16& p0, f32x16& p1, bool all) {
    const float NEG = -__builtin_inff();
#pragma unroll
    for (int r = 0; r < 16; ++r) { p0[r] = NEG; if (r < 8) p1[r] = NEG; else p1[r] = all ? NEG : p1[r]; }
}
__device__ __forceinline__ void partialSM(f32x16& p0, f32x16& p1, float& m_reg, float& mn, float& alpha) {
    float pmax = p0[0]; for (int r = 1; r < 16; ++r) pmax = fmaxf(pmax, p0[r]); for (int r = 0; r < 16; ++r) pmax = fmaxf(pmax, p1[r]);
    { auto rr = __builtin_amdgcn_permlane32_swap(__float_as_uint(pmax), __float_as_uint(pmax), false, false);
      pmax = fmaxf(__uint_as_float(rr[0]), __uint_as_float(rr[1])); }
    constexpr float C2 = 1.4426950408889634f * SCALE;
    if (__builtin_expect(__all((pmax - m_reg) * SCALE <= THR), 1)) { mn = m_reg; alpha = 1.f; }
    else { mn = fmaxf(m_reg, pmax); alpha = __builtin_amdgcn_exp2f((m_reg - mn) * C2); m_reg = mn; }
    const float mnL = -mn * C2;
    for (int r = 0; r < 16; ++r) p0[r] = fmaf(p0[r], C2, mnL); for (int r = 0; r < 16; ++r) p1[r] = fmaf(p1[r], C2, mnL);
    for (int r = 0; r < 16; ++r) p0[r] = __builtin_amdgcn_exp2f(p0[r]);
}
__device__ __forceinline__ void finishSM(f32x16& p0, f32x16& p1, float alpha, float& l_reg, bf16x8& pa0, bf16x8& pa1, bf16x8& pa2, bf16x8& pa3) {
    for (int r = 0; r < 16; ++r) p1[r] = __builtin_amdgcn_exp2f(p1[r]);
    float ps = 0; for (int r = 0; r < 16; ++r) ps += p0[r]; for (int r = 0; r < 16; ++r) ps += p1[r];
    { auto rr = __builtin_amdgcn_permlane32_swap(__float_as_uint(ps), __float_as_uint(ps), false, false);
      ps = __uint_as_float(rr[0]) + __uint_as_float(rr[1]); }
    l_reg = l_reg * alpha + ps;
#define PK4(P, B_, OUT) do { unsigned a0 = cvt_pk_bf16(P[B_+0], P[B_+1]), a1 = cvt_pk_bf16(P[B_+2], P[B_+3]);                          \
        unsigned b0 = cvt_pk_bf16(P[B_+4], P[B_+5]), b1 = cvt_pk_bf16(P[B_+6], P[B_+7]);                                             \
        auto r0 = __builtin_amdgcn_permlane32_swap(a0, b0, false, false); auto r1 = __builtin_amdgcn_permlane32_swap(a1, b1, false, false); \
        u32x4 w = {r0[0], r1[0], r0[1], r1[1]}; OUT = *reinterpret_cast<bf16x8*>(&w); } while (0)
    PK4(p0, 0, pa0); PK4(p0, 8, pa1); PK4(p1, 0, pa2); PK4(p1, 8, pa3);
#undef PK4
}
template <int KB>
__device__ __forceinline__ void qkt(f32x16& p0, f32x16& p1, const char* K_lds, int r32, int hi, const bf16x8* qr, bool act) {
    if (!act) { const float NEG = -__builtin_inff();
#pragma unroll
        for (int r = 0; r < 16; ++r) { p0[r] = NEG; p1[r] = NEG; } return; }
    p0 = f32x16{}; p1 = f32x16{};
    const char* kb[4];
#pragma unroll
    for (int dd = 0; dd < 4; ++dd) kb[dd] = K_lds + KB * SHM_K + KSWZ(r32, (dd * 16 + hi * 8) * 2);
#pragma unroll
    for (int d0 = 0; d0 < 8; ++d0) { const char* a = kb[d0 & 3] + (d0 >> 2) * 128;
        bf16x8 b0 = *reinterpret_cast<const bf16x8*>(a);
        bf16x8 b1 = *reinterpret_cast<const bf16x8*>(a + 32 * 256);
        p0 = __builtin_amdgcn_mfma_f32_32x32x16_bf16(b0, qr[d0], p0, 0, 0, 0);
        p1 = __builtin_amdgcn_mfma_f32_32x32x16_bf16(b1, qr[d0], p1, 0, 0, 0); }
}
template <int VB>
__device__ __forceinline__ void pv_tile(f32x16* o, int vb0, bf16x8 pa0, bf16x8 pa1, bf16x8 pa2, bf16x8 pa3, bool act) {
    if (!act) return;
#define TRRD(dst, off) asm volatile("ds_read_b64_tr_b16 %0, %1 offset:%2" : "=&v"(dst) : "v"(vb0), "i"(off) : "memory")
#define PV_D0(d0) do { s16x4 l0, l1, l2, l3, h0, h1, h2, h3; constexpr int b_ = VB * SHM_V + v_rd_off(d0, 0, 0); \
        TRRD(l0, b_); TRRD(h0, b_ + 2048); TRRD(l1, b_ + 4096); TRRD(h1, b_ + 6144); TRRD(l2, b_ + 8192); TRRD(h2, b_ + 10240); TRRD(l3, b_ + 12288); TRRD(h3, b_ + 14336); \
        asm volatile("s_waitcnt lgkmcnt(0)" ::: "memory"); SBAR(); \
        o[d0] = __builtin_amdgcn_mfma_f32_32x32x16_bf16(pa0, (bf16x8){l0[0], l0[1], l0[2], l0[3], h0[0], h0[1], h0[2], h0[3]}, o[d0], 0, 0, 0);   \
        o[d0] = __builtin_amdgcn_mfma_f32_32x32x16_bf16(pa1, (bf16x8){l1[0], l1[1], l1[2], l1[3], h1[0], h1[1], h1[2], h1[3]}, o[d0], 0, 0, 0);   \
        o[d0] = __builtin_amdgcn_mfma_f32_32x32x16_bf16(pa2, (bf16x8){l2[0], l2[1], l2[2], l2[3], h2[0], h2[1], h2[2], h2[3]}, o[d0], 0, 0, 0);   \
        o[d0] = __builtin_amdgcn_mfma_f32_32x32x16_bf16(pa3, (bf16x8){l3[0], l3[1], l3[2], l3[3], h3[0], h3[1], h3[2], h3[3]}, o[d0], 0, 0, 0); } while (0)
    PV_D0(0); PV_D0(1); PV_D0(2); PV_D0(3);
#undef PV_D0
#undef TRRD
}

struct BlockRef { const bf16_t* Q; const bf16_t* K; const bf16_t* V; int jlo, jhi, lastbase, first; };
struct Seam { bf16x8 qr[8]; bf16x8 st_v0, st_v1, st_k0, st_k1; };
#define ROW(p, k0, rr) ((p) + (size_t)((k0) + (rr)) * PITCH + sc)
#define VMW() asm volatile("s_waitcnt vmcnt(0)" ::: "memory")
#define VMWN(n) asm volatile("s_waitcnt vmcnt(%0)" :: "i"(n) : "memory")
#define SLOAD_H(Kp, Vp, k0) do { S.st_v0 = load8(ROW(Vp, k0, sr)); S.st_v1 = load8(ROW(Vp, k0, 32 + sr));              \
                         S.st_k0 = load8(ROW(Kp, k0, sr)); S.st_k1 = load8(ROW(Kp, k0, 32 + sr)); } while (0)
#define SWRITE_HK(bf) do { *(bf16x8*)(K_lds + (bf) * SHM_K + kws) = S.st_k0; *(bf16x8*)(K_lds + (bf) * SHM_K + kws + 32 * 256) = S.st_k1; } while (0)
#define SWRITE_HV(bf) do { *(bf16x8*)(V_lds + (bf) * SHM_V + vst0) = S.st_v0; *(bf16x8*)(V_lds + (bf) * SHM_V + vst1) = S.st_v1; } while (0)
#define SWRITE_H(bf) do { SWRITE_HV(bf); SWRITE_HK(bf); } while (0)
__device__ __forceinline__ void attn_prime(const BlockRef& cur, char* lds, Seam& S, const int wid) {
    int lane = lane_id(); asm volatile("" : "+v"(lane));
    const int tid = wid * 64 + lane, r32 = lane & 31, hi = lane >> 5;
    const int sr = tid >> 4, sc = (tid & 15) * 8, kws = KSWZ(sr, sc * 2); char* K_lds = lds + 2 * SHM_V;
    const int kb0 = cur.jlo * KVBLK;
    for (int d0 = 0; d0 < 8; ++d0) S.qr[d0] = load8(cur.Q + (size_t)(wid * QBLK + r32) * PITCH + d0 * 16 + hi * 8);
    SLOAD_H(cur.K, cur.V, kb0); VMW(); SWRITE_HK(0);
    __syncthreads();
}
__device__ __forceinline__ void attn_block(const int MODE, const BlockRef& cur, const BlockRef& nxt, char* lds, Seam& S, float* stash, bf16_t* Oout, float lam, const int wid) {
    int lane = lane_id(); asm volatile("" : "+v"(lane));
    const int tid = wid * 64 + lane, r32 = lane & 31, hi = lane >> 5;
    const int j_lo = cur.jlo, j_hi = cur.jhi;
    const int NT = j_hi - j_lo;
    const int kbn = nxt.jlo * KVBLK;
    const int lastw = cur.first ? cur.lastbase : cur.lastbase + (wid >> 1);
    char* V_lds = lds; char* K_lds = lds + 2 * SHM_V;
    float* ws = (float*)(lds + 2 * SHM_V + 2 * SHM_K) + wid * 64; float* li_l = ws, * al_l = ws + 32;
    float m_reg = -1e30f, l_reg = 0; f32x16 o[4] = {};
    const int sr = tid >> 4, sc = (tid & 15) * 8, vst0 = v_st(sr, sc), vst1 = v_st(32 + sr, sc), kws = KSWZ(sr, sc * 2);
    const int vb0 = (int)(uintptr_t)V_lds + v_rd_base(lane);
    const bf16_t* Kh = cur.K; const bf16_t* Vh = cur.V;
#define RESC(a) do { if (__any((a) < 1.f)) { if (hi == 0) al_l[r32] = (a); asm volatile("s_waitcnt lgkmcnt(0)" ::: "memory");              \
                     for (int d_ = 0; d_ < 4; ++d_) for (int r = 0; r < 16; ++r) o[d_][r] *= al_l[crow(r, hi)]; } } while (0)
#define KBASE(t) ((j_lo + (t)) * KVBLK)
#define ACT(t) true
#define MASKT(P0_, P1_, t) do { const int jt_ = j_lo + (t); if (jt_ == 3 || jt_ > lastw) mask_tile_bc(P0_, P1_, jt_ > lastw); } while (0)
    constexpr int NQL = 8;
#define SEAM_K0() do { VMWN(NQL); SWRITE_HK(0); SBAR(); } while (0)
    f32x16 pA0, pA1, pB0, pB1; float mnA, mnB, alA, alB; bf16x8 pa0, pa1, pa2, pa3;
    SWRITE_HV(0); SBAR();
    if (NT > 1) { SLOAD_H(Kh, Vh, KBASE(1)); }
    SBAR(); qkt<0>(pA0, pA1, K_lds, r32, hi, S.qr, ACT(0));
    MASKT(pA0, pA1, 0); partialSM(pA0, pA1, m_reg, mnA, alA);
    if (NT > 1) { VMW(); SWRITE_H(1); }
    __syncthreads();
#define HALF_STEP(PX0, PX1, mnX, alX, PY0, PY1, alY, t, KB, VB, SB) do {                                                      \
        SBAR(); qkt<KB>(PX0, PX1, K_lds, r32, hi, S.qr, ACT(t));                                             \
        finishSM(PY0, PY1, alY, l_reg, pa0, pa1, pa2, pa3); SBAR();                                                           \
        if ((t) + 1 < NT) { SLOAD_H(Kh, Vh, KBASE((t) + 1)); SBAR(); }                                               \
        pv_tile<VB>(o, vb0, pa0, pa1, pa2, pa3, ACT((t) - 1)); MASKT(PX0, PX1, (t)); partialSM(PX0, PX1, m_reg, mnX, alX);                                        \
        __syncthreads();                                                                                                      \
        if ((t) + 1 < NT) { VMW(); SWRITE_H(SB); }                                                                          \
        RESC(alX); __syncthreads(); } while (0)
    for (int t = 1; t + 1 < NT; t += 2) {
        HALF_STEP(pB0, pB1, mnB, alB, pA0, pA1, alA, t, 1, 0, 0);
        HALF_STEP(pA0, pA1, mnA, alA, pB0, pB1, alB, t + 1, 0, 1, 1);
    }
    const bool even = (NT & 1) == 0;
    if (even) { SBAR(); qkt<1>(pB0, pB1, K_lds, r32, hi, S.qr, ACT(NT - 1)); SBAR(); }
    SLOAD_H(nxt.K, nxt.V, kbn); SBAR();
#pragma unroll
    for (int d0 = 0; d0 < 8; ++d0) S.qr[d0] = load8(nxt.Q + (size_t)(wid * QBLK + r32) * PITCH + d0 * 16 + hi * 8);
    SBAR();
    finishSM(pA0, pA1, alA, l_reg, pa0, pa1, pa2, pa3); SBAR();
    pv_tile<0>(o, vb0, pa0, pa1, pa2, pa3, ACT(even ? NT - 2 : NT - 1));
    if (even) { MASKT(pB0, pB1, NT - 1); partialSM(pB0, pB1, m_reg, mnB, alB); __syncthreads(); RESC(alB);
        finishSM(pB0, pB1, alB, l_reg, pa0, pa1, pa2, pa3); SBAR(); pv_tile<1>(o, vb0, pa0, pa1, pa2, pa3, ACT(NT - 1)); }
    SBAR(); SEAM_K0();
    if (hi == 0) li_l[r32] = l_reg; asm volatile("s_waitcnt lgkmcnt(0)" ::: "memory");
    int hie = hi; asm volatile("" : "+v"(hie));
    float rli[16];
#pragma unroll
    for (int r = 0; r < 16; ++r) rli[r] = __builtin_amdgcn_rcpf(li_l[crow(r, hie)]);
    if (MODE == 0) {
        float* Ow = stash + (wid * QBLK + 4 * hie) * D + r32;
#pragma unroll
        for (int r = 0; r < 16; ++r) {
#pragma unroll
            for (int d0 = 0; d0 < 4; ++d0) Ow[((r & 3) + 8 * (r >> 2)) * D + d0 * 32] = o[d0][r] * rli[r]; }
    } else {
        const float* Sw = stash + (wid * QBLK + 4 * hie) * D + r32;
        bf16_t* Ow = Oout + (size_t)((wid * QBLK + 4 * hie) * PITCH + r32);
#pragma unroll
        for (int rg = 0; rg < 4; ++rg) {
            float sv[4][4];
#pragma unroll
            for (int rr = 0; rr < 4; ++rr)
#pragma unroll
                for (int d0 = 0; d0 < 4; ++d0) sv[rr][d0] = Sw[(rr + 8 * rg) * D + d0 * 32];
#pragma unroll
            for (int rr = 0; rr < 4; ++rr) { const int r = 4 * rg + rr;
#pragma unroll
                for (int d0 = 0; d0 < 4; ++d0) { const float v = sv[rr][d0] - lam * (o[d0][r] * rli[r]);
                    const float vn = xor1(v);
                    if ((r32 & 1) == 0) *(unsigned*)(Ow + (rr + 8 * rg) * PITCH + d0 * 32) = cvt_pk_bf16(v, vn); } }
            SBAR(); }
    }
    __syncthreads();
#undef RESC
#undef KBASE
#undef ACT
#undef MASKT
#undef SEAM_K0
#undef HALF_STEP
}
#undef ROW
#undef VMWN
#undef SLOAD_H
#undef SWRITE_HK
#undef SWRITE_HV
#undef SWRITE_H
}
namespace att2 {
using att::crow; using att::load8; using att::v_rd_base; using att::SCALE; using att::THR;
constexpr int NW = 8, QBLK = 32, KV = 32, PITCH = 2048, DV = 256;
constexpr int SHM_V = KV * DV * 2, SHM_K = KV * 128 * 2;
constexpr int OFF_K = 2 * SHM_V, OFF_S = OFF_K + 2 * SHM_K, LDS_BYTES = OFF_S + NW * 64 * 4;
__device__ __forceinline__ int v_st(int k, int c) { const int kk = (k & ~0xC) | ((k & 4) << 1) | ((k & 8) >> 1); return ((kk >> 3) * 8 + (c >> 5)) * 512 + ((kk & 7) * 32 + (c & 31)) * 2; }
constexpr int v_rd_off(int d0, int ks, int half) { return d0 * 512 + ks * 8192 + half * 4096; }

__device__ __forceinline__ void mask1(f32x16& p, bool all) {
    const float NEG = -__builtin_inff();
#pragma unroll
    for (int r = 0; r < 16; ++r) { if (r < 8) p[r] = NEG; else p[r] = all ? NEG : p[r]; }
}
__device__ __forceinline__ void partialSM(f32x16& p, float& m_reg, float& mn, float& alpha) {
    float pmax = p[0]; for (int r = 1; r < 16; ++r) pmax = fmaxf(pmax, p[r]);
    { auto rr = __builtin_amdgcn_permlane32_swap(__float_as_uint(pmax), __float_as_uint(pmax), false, false);
      pmax = fmaxf(__uint_as_float(rr[0]), __uint_as_float(rr[1])); }
    constexpr float C2 = 1.4426950408889634f * SCALE;
    if (__builtin_expect(__all((pmax - m_reg) * SCALE <= THR), 1)) { mn = m_reg; alpha = 1.f; }
    else { mn = fmaxf(m_reg, pmax); alpha = __builtin_amdgcn_exp2f((m_reg - mn) * C2); m_reg = mn; }
    const float mnL = -mn * C2;
    for (int r = 0; r < 16; ++r) p[r] = fmaf(p[r], C2, mnL);
    for (int r = 0; r < 8; ++r) p[r] = __builtin_amdgcn_exp2f(p[r]);
}
__device__ __forceinline__ void finishSM(f32x16& p, float alpha, float& l_reg, bf16x8& pa0, bf16x8& pa1) {
    for (int r = 8; r < 16; ++r) p[r] = __builtin_amdgcn_exp2f(p[r]);
    float ps = 0; for (int r = 0; r < 16; ++r) ps += p[r];
    { auto rr = __builtin_amdgcn_permlane32_swap(__float_as_uint(ps), __float_as_uint(ps), false, false);
      ps = __uint_as_float(rr[0]) + __uint_as_float(rr[1]); }
    l_reg = l_reg * alpha + ps;
#define PK4(P, B_, OUT) do { unsigned a0 = cvt_pk_bf16(P[B_+0], P[B_+1]), a1 = cvt_pk_bf16(P[B_+2], P[B_+3]);                          \
        unsigned b0 = cvt_pk_bf16(P[B_+4], P[B_+5]), b1 = cvt_pk_bf16(P[B_+6], P[B_+7]);                                             \
        auto r0 = __builtin_amdgcn_permlane32_swap(a0, b0, false, false); auto r1 = __builtin_amdgcn_permlane32_swap(a1, b1, false, false); \
        u32x4 w = {r0[0], r1[0], r0[1], r1[1]}; OUT = *reinterpret_cast<bf16x8*>(&w); } while (0)
    PK4(p, 0, pa0); PK4(p, 8, pa1);
#undef PK4
}
template <int KB>
__device__ __forceinline__ void qkt(f32x16& p, const char* K_lds, int r32, int hi, const bf16x8* qr) {
    p = f32x16{};
    const char* kb[4];
#pragma unroll
    for (int dd = 0; dd < 4; ++dd) kb[dd] = K_lds + KB * SHM_K + KSWZ(r32, (dd * 16 + hi * 8) * 2);
#pragma unroll
    for (int d0 = 0; d0 < 8; ++d0) { const bf16x8 b0 = *reinterpret_cast<const bf16x8*>(kb[d0 & 3] + (d0 >> 2) * 128);
        p = __builtin_amdgcn_mfma_f32_32x32x16_bf16(b0, qr[d0], p, 0, 0, 0); }
}
template <int VB>
__device__ __forceinline__ void pv_tile(f32x16* o, int vb0, bf16x8 pa0, bf16x8 pa1) {
#define TRRD(dst, off) asm volatile("ds_read_b64_tr_b16 %0, %1 offset:%2" : "=&v"(dst) : "v"(vb0), "i"(off) : "memory")
#define PV_D0(d0) do { s16x4 l0, l1, h0, h1; constexpr int b_ = VB * SHM_V + v_rd_off(d0, 0, 0); \
        TRRD(l0, b_); TRRD(h0, b_ + 4096); TRRD(l1, b_ + 8192); TRRD(h1, b_ + 12288); \
        asm volatile("s_waitcnt lgkmcnt(0)" ::: "memory"); SBAR(); \
        o[d0] = __builtin_amdgcn_mfma_f32_32x32x16_bf16(pa0, (bf16x8){l0[0], l0[1], l0[2], l0[3], h0[0], h0[1], h0[2], h0[3]}, o[d0], 0, 0, 0);   \
        o[d0] = __builtin_amdgcn_mfma_f32_32x32x16_bf16(pa1, (bf16x8){l1[0], l1[1], l1[2], l1[3], h1[0], h1[1], h1[2], h1[3]}, o[d0], 0, 0, 0); } while (0)
    PV_D0(0); PV_D0(1); PV_D0(2); PV_D0(3); PV_D0(4); PV_D0(5); PV_D0(6); PV_D0(7);
#undef PV_D0
#undef TRRD
}
template <int VB>
__device__ __forceinline__ void pv_partial(f32x16* o, int vb0, bf16x8 pa0, bf16x8 pa1, f32x16& p, float& m_reg, float& mn, float& alpha) {
#define TRRD(dst, off) asm volatile("ds_read_b64_tr_b16 %0, %1 offset:%2" : "=&v"(dst) : "v"(vb0), "i"(off) : "memory")
#define PV_D0(d0) do { s16x4 l0, l1, h0, h1; constexpr int b_ = VB * SHM_V + v_rd_off(d0, 0, 0); \
        TRRD(l0, b_); TRRD(h0, b_ + 4096); TRRD(l1, b_ + 8192); TRRD(h1, b_ + 12288); \
        asm volatile("s_waitcnt lgkmcnt(0)" ::: "memory"); SBAR(); \
        o[d0] = __builtin_amdgcn_mfma_f32_32x32x16_bf16(pa0, (bf16x8){l0[0], l0[1], l0[2], l0[3], h0[0], h0[1], h0[2], h0[3]}, o[d0], 0, 0, 0);   \
        o[d0] = __builtin_amdgcn_mfma_f32_32x32x16_bf16(pa1, (bf16x8){l1[0], l1[1], l1[2], l1[3], h1[0], h1[1], h1[2], h1[3]}, o[d0], 0, 0, 0); } while (0)
    constexpr float C2 = 1.4426950408889634f * SCALE;
    PV_D0(0); float pmax = fmaxf(fmaxf(p[0], p[1]), fmaxf(p[2], p[3]));
    PV_D0(1); pmax = fmaxf(pmax, fmaxf(fmaxf(p[4], p[5]), fmaxf(p[6], p[7])));
    PV_D0(2); pmax = fmaxf(pmax, fmaxf(fmaxf(p[8], p[9]), fmaxf(p[10], p[11])));
    PV_D0(3); pmax = fmaxf(pmax, fmaxf(fmaxf(p[12], p[13]), fmaxf(p[14], p[15])));
    { auto rr = __builtin_amdgcn_permlane32_swap(__float_as_uint(pmax), __float_as_uint(pmax), false, false); pmax = fmaxf(__uint_as_float(rr[0]), __uint_as_float(rr[1])); }
    PV_D0(4);
    if (__builtin_expect(__all((pmax - m_reg) * SCALE <= THR), 1)) { mn = m_reg; alpha = 1.f; }
    else { mn = fmaxf(m_reg, pmax); alpha = __builtin_amdgcn_exp2f((m_reg - mn) * C2); m_reg = mn; }
    const float mnL = -mn * C2;
    PV_D0(5);
#pragma unroll
    for (int r = 0; r < 8; ++r) p[r] = fmaf(p[r], C2, mnL);
    PV_D0(6);
#pragma unroll
    for (int r = 8; r < 16; ++r) p[r] = fmaf(p[r], C2, mnL);
#pragma unroll
    for (int r = 0; r < 4; ++r) p[r] = __builtin_amdgcn_exp2f(p[r]);
    PV_D0(7);
#pragma unroll
    for (int r = 4; r < 8; ++r) p[r] = __builtin_amdgcn_exp2f(p[r]);
#undef PV_D0
#undef TRRD
}
struct BlockRef { const bf16_t* Q; const bf16_t* K; const bf16_t* V; int jlo, jhi, lastbase, first; };
struct Seam { bf16x8 qr[8]; bf16x8 st_v0, st_v1, st_k; };
#define ROW2(p, k0) ((p) + (size_t)((k0) + sr) * PITCH + sc)
#define VMW() asm volatile("s_waitcnt vmcnt(0)" ::: "memory")
#define VMWN(n) asm volatile("s_waitcnt vmcnt(%0)" :: "i"(n) : "memory")
#define SLOAD2(Kp, Vp, k0) do { S.st_v0 = load8(ROW2(Vp, k0)); S.st_v1 = load8(ROW2(Vp, k0) + 128); S.st_k = load8(ROW2(Kp, k0)); } while (0)
#define SWRITE2K(bf) do { *(bf16x8*)(K_lds + (bf) * SHM_K + kws) = S.st_k; } while (0)
#define SWRITE2V(bf) do { *(bf16x8*)(V_lds + (bf) * SHM_V + vst0) = S.st_v0; *(bf16x8*)(V_lds + (bf) * SHM_V + vst1) = S.st_v1; } while (0)
#define SWRITE2(bf) do { SWRITE2V(bf); SWRITE2K(bf); } while (0)
__device__ __forceinline__ void attn_prime(const BlockRef& cur, char* lds, Seam& S, const int wid) {
    int lane = lane_id(); asm volatile("" : "+v"(lane));
    const int tid = wid * 64 + lane, r32 = lane & 31, hi = lane >> 5;
    const int sr = tid >> 4, sc = (tid & 15) * 8, kws = KSWZ(sr, sc * 2); char* K_lds = lds + OFF_K;
    const int kb0 = cur.jlo * KV;
    for (int d0 = 0; d0 < 8; ++d0) S.qr[d0] = load8(cur.Q + (size_t)(wid * QBLK + r32) * PITCH + d0 * 16 + hi * 8);
    SLOAD2(cur.K, cur.V, kb0); VMW(); SWRITE2K(0);
    __syncthreads();
}
__device__ __forceinline__ void attn_block(const int MODE, const BlockRef& cur, const BlockRef& nxt, char* lds, Seam& S, float* stash, bf16_t* Oout, float lam, const int wid) {
    int lane = lane_id(); asm volatile("" : "+v"(lane));
    const int tid = wid * 64 + lane, r32 = lane & 31, hi = lane >> 5;
    const int j_lo = cur.jlo, NT = cur.jhi - cur.jlo;
    const int kbn = nxt.jlo * KV;
    const int lastw = cur.first ? cur.lastbase : cur.lastbase + 2 * (wid >> 1);
    char* V_lds = lds; char* K_lds = lds + OFF_K;
    float* ws = (float*)(lds + OFF_S) + wid * 64; float* li_l = ws, * al_l = ws + 32;
    float m_reg = -1e30f, l_reg = 0; f32x16 o[8] = {};
    const int sr = tid >> 4, sc = (tid & 15) * 8, vst0 = v_st(sr, sc), vst1 = v_st(sr, sc + 128), kws = KSWZ(sr, sc * 2);
    const int vb0 = (int)(uintptr_t)V_lds + v_rd_base(lane);
    const bf16_t* Kh = cur.K; const bf16_t* Vh = cur.V;
#define RESC(a) do { if (__any((a) < 1.f)) { if (hi == 0) al_l[r32] = (a); asm volatile("s_waitcnt lgkmcnt(0)" ::: "memory");              \
                     for (int d_ = 0; d_ < 8; ++d_) for (int r = 0; r < 16; ++r) o[d_][r] *= al_l[crow(r, hi)]; } } while (0)
#define KBASE(t) ((j_lo + (t)) * KV)
#define MASKT(P_, t) do { const int jt_ = j_lo + (t); if (jt_ == 7 || jt_ > lastw) mask1(P_, jt_ > lastw); } while (0)
#define SEAM_K0() do { VMWN(8); SWRITE2K(0); SBAR(); } while (0)
    f32x16 pA, pB; float mnA, mnB, alA, alB; bf16x8 pa0, pa1;
    SWRITE2V(0); SBAR();
    if (NT > 1) { SLOAD2(Kh, Vh, KBASE(1)); }
    SBAR(); qkt<0>(pA, K_lds, r32, hi, S.qr);
    MASKT(pA, 0); partialSM(pA, m_reg, mnA, alA);
    if (NT > 1) { VMW(); SWRITE2(1); }
    __syncthreads();
#define HALF_STEP(PX, mnX, alX, PY, alY, t, KB, VB, SB) do {                                                      \
        SBAR(); qkt<KB>(PX, K_lds, r32, hi, S.qr);                                             \
        finishSM(PY, alY, l_reg, pa0, pa1); SBAR();                                                           \
        if ((t) + 1 < NT) { SLOAD2(Kh, Vh, KBASE((t) + 1)); SBAR(); }                                               \
        MASKT(PX, (t)); pv_partial<VB>(o, vb0, pa0, pa1, PX, m_reg, mnX, alX);                                        \
        __syncthreads();                                                                                                      \
        if ((t) + 1 < NT) { VMW(); SWRITE2(SB); }                                                                          \
        RESC(alX); __syncthreads(); } while (0)
    for (int t = 1; t + 1 < NT; t += 2) {
        HALF_STEP(pB, mnB, alB, pA, alA, t, 1, 0, 0);
        HALF_STEP(pA, mnA, alA, pB, alB, t + 1, 0, 1, 1);
    }
    const bool even = (NT & 1) == 0;
    if (even) { SBAR(); qkt<1>(pB, K_lds, r32, hi, S.qr); SBAR(); }
    SLOAD2(nxt.K, nxt.V, kbn); SBAR();
#pragma unroll
    for (int d0 = 0; d0 < 8; ++d0) S.qr[d0] = load8(nxt.Q + (size_t)(wid * QBLK + r32) * PITCH + d0 * 16 + hi * 8);
    SBAR();
    finishSM(pA, alA, l_reg, pa0, pa1); SBAR();
    pv_tile<0>(o, vb0, pa0, pa1);
    if (even) { MASKT(pB, NT - 1); partialSM(pB, m_reg, mnB, alB); __syncthreads(); RESC(alB);
        finishSM(pB, alB, l_reg, pa0, pa1); SBAR(); pv_tile<1>(o, vb0, pa0, pa1); }
    SBAR(); SEAM_K0();
    if (hi == 0) li_l[r32] = l_reg; asm volatile("s_waitcnt lgkmcnt(0)" ::: "memory");
    int hie = hi; asm volatile("" : "+v"(hie));
    float rli[16];
#pragma unroll
    for (int r = 0; r < 16; ++r) rli[r] = __builtin_amdgcn_rcpf(li_l[crow(r, hie)]);
    if (MODE == 0) {
        float* Ow = stash + (wid * QBLK + 4 * hie) * DV + r32;
#pragma unroll
        for (int r = 0; r < 16; ++r) {
#pragma unroll
            for (int d0 = 0; d0 < 8; ++d0) Ow[((r & 3) + 8 * (r >> 2)) * DV + d0 * 32] = o[d0][r] * rli[r]; }
    } else {
        const float* Sw = stash + (wid * QBLK + 4 * hie) * DV + r32;
        bf16_t* Ow = Oout + (size_t)((wid * QBLK + 4 * hie) * PITCH + r32);
#pragma unroll
        for (int rg = 0; rg < 8; ++rg) {
            float sv[2][8];
#pragma unroll
            for (int rr = 0; rr < 2; ++rr)
#pragma unroll
                for (int d0 = 0; d0 < 8; ++d0) sv[rr][d0] = Sw[((2 * rg + rr) & 3) * DV + 8 * ((2 * rg + rr) >> 2) * DV + d0 * 32];
#pragma unroll
            for (int rr = 0; rr < 2; ++rr) { const int r = 2 * rg + rr;
#pragma unroll
                for (int d0 = 0; d0 < 8; ++d0) { const float v = sv[rr][d0] - lam * (o[d0][r] * rli[r]);
                    const float vn = xor1(v);
                    if ((r32 & 1) == 0) *(unsigned*)(Ow + ((r & 3) + 8 * (r >> 2)) * PITCH + d0 * 32) = cvt_pk_bf16(v, vn); } }
            SBAR(); }
    }
    __syncthreads();
#undef RESC
#undef KBASE
#undef MASKT
#undef SEAM_K0
#undef HALF_STEP
}
#undef ROW2
#undef VMW
#undef VMWN
#undef SLOAD2
#undef SWRITE2K
#undef SWRITE2V
#undef SWRITE2
}
namespace att4 {
using att::crow; using att::load8; using att::v_rd_base; using att::SCALE; using att::THR;
using att2::mask1; using att2::partialSM; using att2::finishSM; using att2::v_rd_off;
constexpr int NW = 8, QBLK = 32, KV = 32, PITCH = 2048, DV = 256;
constexpr int SHM_V = KV * DV * 2, SHM_K = KV * 128 * 2, NVB = 3;
constexpr int OFF_K = NVB * SHM_V, OFF_S = OFF_K + 2 * SHM_K, LDS_BYTES = OFF_S + NW * 64 * 4;
static_assert(SHM_K == att2::SHM_K && SHM_V == att2::SHM_V, "att4 reuses att2's tile readers");
struct PassRef { const bf16_t* Q; const bf16_t* K; const bf16_t* V; int jlo, jhi, lastbase, first; };
#define KRD(dst, addr, off) asm volatile("ds_read_b128 %0, %1 offset:%2" : "=&v"(dst) : "v"(addr), "i"(off) : "memory")
#define LGK0() asm volatile("s_waitcnt lgkmcnt(0)" ::: "memory")
#define MF(acc, a, b) acc = __builtin_amdgcn_mfma_f32_32x32x16_bf16(a, b, acc, 0, 0, 0)
template <int KB>
__device__ __forceinline__ void qkt_finish(f32x16& p, const int (&kb)[4], const bf16x8* qr, f32x16& py, float alY, float& l_reg, bf16x8& pa0, bf16x8& pa1) {
    constexpr int B = KB * SHM_K;
    bf16x8 f0, f1, f2, f3;
    p = f32x16{};
    KRD(f0, kb[0], B); KRD(f1, kb[1], B); LGK0(); SBAR();
    KRD(f2, kb[2], B); KRD(f3, kb[3], B); MF(p, f0, qr[0]); MF(p, f1, qr[1]);
#pragma unroll
    for (int r = 8; r < 12; ++r) py[r] = __builtin_amdgcn_exp2f(py[r]);
    LGK0(); SBAR();
    KRD(f0, kb[0], B + 128); KRD(f1, kb[1], B + 128); MF(p, f2, qr[2]); MF(p, f3, qr[3]);
#pragma unroll
    for (int r = 12; r < 16; ++r) py[r] = __builtin_amdgcn_exp2f(py[r]);
    LGK0(); SBAR();
    KRD(f2, kb[2], B + 128); KRD(f3, kb[3], B + 128); MF(p, f0, qr[4]); MF(p, f1, qr[5]);
    { float ps = 0;
#pragma unroll
      for (int r = 0; r < 16; ++r) ps += py[r];
      auto rr = __builtin_amdgcn_permlane32_swap(__float_as_uint(ps), __float_as_uint(ps), false, false);
      ps = __uint_as_float(rr[0]) + __uint_as_float(rr[1]); l_reg = l_reg * alY + ps; }
    LGK0(); SBAR();
    MF(p, f2, qr[6]); MF(p, f3, qr[7]);
#define PK4(P, B_, OUT) do { unsigned a0 = cvt_pk_bf16(P[B_+0], P[B_+1]), a1 = cvt_pk_bf16(P[B_+2], P[B_+3]);                          \
        unsigned b0 = cvt_pk_bf16(P[B_+4], P[B_+5]), b1 = cvt_pk_bf16(P[B_+6], P[B_+7]);                                             \
        auto r0 = __builtin_amdgcn_permlane32_swap(a0, b0, false, false); auto r1 = __builtin_amdgcn_permlane32_swap(a1, b1, false, false); \
        u32x4 w = {r0[0], r1[0], r0[1], r1[1]}; OUT = *reinterpret_cast<bf16x8*>(&w); } while (0)
    PK4(py, 0, pa0); PK4(py, 8, pa1);
#undef PK4
    SBAR();
}
template <bool WITH_P>
__device__ __forceinline__ void pv_partial(f32x16* o, int vbase, bf16x8 pa0, bf16x8 pa1, f32x16& p, float& m_reg, float& mn, float& alpha) {
#define TRRD(dst, off) asm volatile("ds_read_b64_tr_b16 %0, %1 offset:%2" : "=&v"(dst) : "v"(vbase), "i"(off) : "memory")
#define PV_RD(l0, h0, l1, h1, d0) do { constexpr int b_ = v_rd_off(d0, 0, 0); TRRD(l0, b_); TRRD(h0, b_ + 4096); TRRD(l1, b_ + 8192); TRRD(h1, b_ + 12288); } while (0)
#define PV_MM(l0, h0, l1, h1, d0) do { __builtin_amdgcn_s_setprio(1); \
        MF(o[d0], pa0, ((bf16x8){l0[0], l0[1], l0[2], l0[3], h0[0], h0[1], h0[2], h0[3]}));   \
        MF(o[d0], pa1, ((bf16x8){l1[0], l1[1], l1[2], l1[3], h1[0], h1[1], h1[2], h1[3]})); __builtin_amdgcn_s_setprio(0); } while (0)
    constexpr float C2 = 1.4426950408889634f * SCALE;
    s16x4 a0, a1, a2, a3, b0, b1, b2, b3; float pmax = 0.f, mnL = 0.f;
    PV_RD(a0, a1, a2, a3, 0); LGK0(); SBAR();
    PV_RD(b0, b1, b2, b3, 1); PV_MM(a0, a1, a2, a3, 0);
    if (WITH_P) pmax = fmaxf(fmaxf(fmaxf(p[0], p[1]), fmaxf(p[2], p[3])), fmaxf(fmaxf(p[4], p[5]), fmaxf(p[6], p[7])));
    LGK0(); SBAR();
    PV_RD(a0, a1, a2, a3, 2); PV_MM(b0, b1, b2, b3, 1);
    if (WITH_P) { pmax = fmaxf(pmax, fmaxf(fmaxf(fmaxf(p[8], p[9]), fmaxf(p[10], p[11])), fmaxf(fmaxf(p[12], p[13]), fmaxf(p[14], p[15]))));
        auto rr = __builtin_amdgcn_permlane32_swap(__float_as_uint(pmax), __float_as_uint(pmax), false, false); pmax = fmaxf(__uint_as_float(rr[0]), __uint_as_float(rr[1])); }
    LGK0(); SBAR();
    PV_RD(b0, b1, b2, b3, 3); PV_MM(a0, a1, a2, a3, 2);
    if (WITH_P) { if (__builtin_expect(__all((pmax - m_reg) * SCALE <= THR), 1)) { mn = m_reg; alpha = 1.f; }
        else { mn = fmaxf(m_reg, pmax); alpha = __builtin_amdgcn_exp2f((m_reg - mn) * C2); m_reg = mn; }
        mnL = -mn * C2; }
    LGK0(); SBAR();
    PV_RD(a0, a1, a2, a3, 4); PV_MM(b0, b1, b2, b3, 3);
    if (WITH_P) {
#pragma unroll
        for (int r = 0; r < 8; ++r) p[r] = fmaf(p[r], C2, mnL); }
    LGK0(); SBAR();
    PV_RD(b0, b1, b2, b3, 5); PV_MM(a0, a1, a2, a3, 4);
    if (WITH_P) {
#pragma unroll
        for (int r = 8; r < 16; ++r) p[r] = fmaf(p[r], C2, mnL); }
    LGK0(); SBAR();
    PV_RD(a0, a1, a2, a3, 6); PV_MM(b0, b1, b2, b3, 5);
    if (WITH_P) {
#pragma unroll
        for (int r = 0; r < 4; ++r) p[r] = __builtin_amdgcn_exp2f(p[r]); }
    LGK0(); SBAR();
    PV_RD(b0, b1, b2, b3, 7); PV_MM(a0, a1, a2, a3, 6);
    if (WITH_P) {
#pragma unroll
        for (int r = 4; r < 8; ++r) p[r] = __builtin_amdgcn_exp2f(p[r]); }
    LGK0(); SBAR();
    PV_MM(b0, b1, b2, b3, 7);
    SBAR();
#undef PV_MM
#undef PV_RD
#undef TRRD
}
__device__ __forceinline__ void attn_pass(const int MODE, const PassRef& cur, LAS unsigned char* ldsL, float* stash, bf16_t* Oout, float lam, const int wid) {
    int lane = lane_id(); asm volatile("" : "+v"(lane));
    const int r32 = lane & 31, hi = lane >> 5;
    const int j_lo = cur.jlo, NT = cur.jhi - cur.jlo;
    const int lastw = cur.first ? cur.lastbase : cur.lastbase + 2 * (wid >> 1);
    char* lds = (char*)ldsL;
    float* ws = (float*)(lds + OFF_S) + wid * 64; float* li_l = ws, * al_l = ws + 32;
    unsigned voffK, voffV0, voffV1;
    { const int o = wid * 1024 + lane * 16, row = o >> 8, c = ((o >> 4) & 15) ^ (row & 7); voffK = (unsigned)(row * PITCH * 2 + c * 16); }
    { const int o = wid * 1024 + lane * 16, st = o >> 9, kk = (st >> 3) * 8 + ((o & 511) >> 6), q = (o >> 4) & 3, c = (st & 7) * 32 + 8 * q, k = (kk & ~0xC) | ((kk & 4) << 1) | ((kk & 8) >> 1);
      voffV0 = (unsigned)(k * PITCH * 2 + c * 2); }
    { const int o = 8192 + wid * 1024 + lane * 16, st = o >> 9, kk = (st >> 3) * 8 + ((o & 511) >> 6), q = (o >> 4) & 3, c = (st & 7) * 32 + 8 * q, k = (kk & ~0xC) | ((kk & 4) << 1) | ((kk & 8) >> 1);
      voffV1 = (unsigned)(k * PITCH * 2 + c * 2); }
    const char* Kg = (const char*)cur.K + (size_t)j_lo * KV * PITCH * 2; const char* Vg = (const char*)cur.V + (size_t)j_lo * KV * PITCH * 2;
    constexpr size_t TSTEP = (size_t)KV * PITCH * 2;
#define DMA_K(t, kbuf) __builtin_amdgcn_global_load_lds((const unsigned*)(Kg + (size_t)(t) * TSTEP + voffK), (LAS unsigned*)(ldsL + OFF_K + (kbuf) * SHM_K + wid * 1024), 16, 0, 0)
#define DMA_V(t, vbuf) do { __builtin_amdgcn_global_load_lds((const unsigned*)(Vg + (size_t)(t) * TSTEP + voffV0), (LAS unsigned*)(ldsL + (vbuf) * SHM_V + wid * 1024), 16, 0, 0); \
                            __builtin_amdgcn_global_load_lds((const unsigned*)(Vg + (size_t)(t) * TSTEP + voffV1), (LAS unsigned*)(ldsL + (vbuf) * SHM_V + 8192 + wid * 1024), 16, 0, 0); } while (0)
#define VMC(n) asm volatile("s_waitcnt vmcnt(" #n ")" ::: "memory")
#define BAR() __builtin_amdgcn_s_barrier()
    bf16x8 qr[8];
#pragma unroll
    for (int d0 = 0; d0 < 8; ++d0) qr[d0] = load8(cur.Q + (size_t)(wid * QBLK + r32) * PITCH + d0 * 16 + hi * 8);
    DMA_K(0, 0); DMA_V(0, 0);
    if (NT > 1) { DMA_K(1, 1); DMA_V(1, 1); }
    const char* K_lds = lds + OFF_K;
    const int vb0 = (int)(uintptr_t)lds + v_rd_base(lane);
    float m_reg = -1e30f, l_reg = 0; f32x16 o[8] = {};
#define RESC(a) do { if (__any((a) < 1.f)) { if (hi == 0) al_l[r32] = (a); asm volatile("s_waitcnt lgkmcnt(0)" ::: "memory");              \
                     _Pragma("unroll") for (int d_ = 0; d_ < 8; ++d_) _Pragma("unroll") for (int r = 0; r < 16; ++r) o[d_][r] *= al_l[crow(r, hi)]; } } while (0)
#define MASKT(P_, t) do { const int jt_ = j_lo + (t); if (jt_ == 7 || jt_ > lastw) mask1(P_, jt_ > lastw); } while (0)
    f32x16 p; float mn, al; bf16x8 pa0, pa1;
    if (NT > 1) VMC(3); else VMC(0);
    BAR();
    att2::qkt<0>(p, K_lds, r32, hi, qr); MASKT(p, 0); partialSM(p, m_reg, mn, al);
    if (NT > 1) { VMC(2); BAR(); }
    int vslot = 0;
    for (int t = 1; t < NT; ++t) {
        SBAR();
        if (t + 1 < NT) { const int vn_ = vslot == 0 ? 2 : vslot - 1; DMA_K(t + 1, (t + 1) & 1); DMA_V(t + 1, vn_); }
        f32x16 pn; float aln;
        att2::qkt<0>(pn, K_lds + (t & 1) * SHM_K, r32, hi, qr); finishSM(p, al, l_reg, pa0, pa1); SBAR();
        MASKT(pn, t); pv_partial<true>(o, vb0 + vslot * SHM_V, pa0, pa1, pn, m_reg, mn, aln);
        RESC(aln);
        p = pn; al = aln;
        if (t + 1 < NT) VMC(2); else VMC(0);
        asm volatile("s_waitcnt lgkmcnt(0)" ::: "memory");
        BAR(); vslot = vslot == 2 ? 0 : vslot + 1;
    }
    finishSM(p, al, l_reg, pa0, pa1); SBAR();
    att2::pv_tile<0>(o, vb0 + vslot * SHM_V, pa0, pa1);
    if (hi == 0) li_l[r32] = l_reg; asm volatile("s_waitcnt lgkmcnt(0)" ::: "memory");
    int hie = hi; asm volatile("" : "+v"(hie));
    float rli[16];
#pragma unroll
    for (int r = 0; r < 16; ++r) rli[r] = __builtin_amdgcn_rcpf(li_l[crow(r, hie)]);
    if (MODE == 0) {
        float* Ow = stash + (wid * QBLK + 4 * hie) * DV + r32;
#pragma unroll
        for (int r = 0; r < 16; ++r) {
#pragma unroll
            for (int d0 = 0; d0 < 8; ++d0) Ow[((r & 3) + 8 * (r >> 2)) * DV + d0 * 32] = o[d0][r] * rli[r]; }
    } else {
        const float* Sw = stash + (wid * QBLK + 4 * hie) * DV + r32;
        bf16_t* Ow = Oout + (size_t)((wid * QBLK + 4 * hie) * PITCH + r32);
#pragma unroll
        for (int rg = 0; rg < 8; ++rg) {
            float sv[2][8];
#pragma unroll
            for (int rr = 0; rr < 2; ++rr)
#pragma unroll
                for (int d0 = 0; d0 < 8; ++d0) sv[rr][d0] = Sw[((2 * rg + rr) & 3) * DV + 8 * ((2 * rg + rr) >> 2) * DV + d0 * 32];
#pragma unroll
            for (int rr = 0; rr < 2; ++rr) { const int r = 2 * rg + rr;
#pragma unroll
                for (int d0 = 0; d0 < 8; ++d0) { const float v = sv[rr][d0] - lam * (o[d0][r] * rli[r]);
                    const float vn = xor1(v);
                    if ((r32 & 1) == 0) *(unsigned*)(Ow + ((r & 3) + 8 * (r >> 2)) * PITCH + d0 * 32) = cvt_pk_bf16(v, vn); } }
            SBAR(); }
    }
    VMC(0); BAR();
#undef RESC
#undef MASKT
#undef DMA_K
#undef DMA_V
#undef VMC
#undef BAR
}
#undef KRD
#undef LGK0
#undef MF
}
namespace att7 {
using att::crow; using att::load8; using att::v_rd_base; using att::SCALE; using att::THR;
using att2::mask1; using att2::v_rd_off;
constexpr int NW = 8, QBLK = 32, KV = 32, PITCH = 2048, DV = 256;
constexpr int SHM_V = KV * DV * 2, SHM_K = KV * 128 * 2, NVB = 3;
constexpr int OFF_K = NVB * SHM_V, OFF_Q = OFF_K + 2 * SHM_K, OFF_S = 132096, LDS_BYTES = OFF_S + NW * 64 * 4;
struct PassRef { const bf16_t* Q; const bf16_t* K; const bf16_t* V; int jlo, jhi, lastbase, first; };

#define KRD(dst, addr, off) asm volatile("ds_read_b128 %0, %1 offset:%2" : "=&v"(dst) : "v"(addr), "i"(off) : "memory")
#define LGK0() asm volatile("s_waitcnt lgkmcnt(0)" ::: "memory")
#define MF(acc, a, b) acc = __builtin_amdgcn_mfma_f32_32x32x16_bf16(a, b, acc, 0, 0, 0)
#define TRRD(dst, off) asm volatile("ds_read_b64_tr_b16 %0, %1 offset:%2" : "=&v"(dst) : "v"(vbase), "i"(off) : "memory")
#define PV_RD(l0, h0, l1, h1, d0) do { constexpr int b_ = v_rd_off(d0, 0, 0); TRRD(l0, b_); TRRD(h0, b_ + 4096); TRRD(l1, b_ + 8192); TRRD(h1, b_ + 12288); } while (0)
#define PV_MM(l0, h0, l1, h1, d0) do { \
        MF(o[d0], pa0, ((bf16x8){l0[0], l0[1], l0[2], l0[3], h0[0], h0[1], h0[2], h0[3]}));   \
        MF(o[d0], pa1, ((bf16x8){l1[0], l1[1], l1[2], l1[3], h1[0], h1[1], h1[2], h1[3]})); } while (0)
#define K_RD(dst, d0) KRD(dst, kbs[(d0) & 3], ((d0) >> 2) * 128)
#define Q_RD(dst, d0) KRD(dst, qb[(d0) & 3], ((d0) >> 2) * 128)

template <int N> __device__ __forceinline__ void lgk_wait() { asm volatile("s_waitcnt lgkmcnt(%0)" :: "n"(N) : "memory"); }
template <bool WITH_QK, bool WITH_PV>
__device__ __forceinline__ void fused_step(f32x16* o, int vbase, bf16x8& pa0, bf16x8& pa1, const int (&kbs)[4], const int (&qb)[4], f32x16& p, f32x16& pn, float& m_reg, float& l_reg, float& alpha,
                                           const bool mask_any, const bool mask_all) {
    constexpr float C2 = 1.4426950408889634f * SCALE;
    s16x4 lA, hA, lB, hB, lC, hC; bf16x8 kA, kB, kC, qA, qB, qC; float pmax = 0.f, mn = 0.f, mnL = 0.f, ps = 0.f; unsigned x0 = 0, x1 = 0, x2 = 0, x3 = 0, y0 = 0, y1 = 0, y2 = 0, y3 = 0;
    if (WITH_QK) pn = f32x16{};
#define WAITL(n) asm volatile("s_waitcnt lgkmcnt(" #n ")" ::: "memory")
#define RDV(l, h, g) do { constexpr int b_ = v_rd_off((g) >> 1, 0, 0) + ((g) & 1) * 8192; TRRD(l, b_); TRRD(h, b_ + 4096); } while (0)
#define MMV(l, h, g) MF(o[(g) >> 1], (((g) & 1) ? pa1 : pa0), ((bf16x8){l[0], l[1], l[2], l[3], h[0], h[1], h[2], h[3]}))
    if (WITH_PV) RDV(lA, hA, 0); if (WITH_PV) RDV(lB, hB, 1);
    if (WITH_PV) RDV(lC, hC, 2); lgk_wait<(WITH_PV ? 4 : 0) + (WITH_QK ? 0 : 0)>(); SBAR(); if (WITH_PV) MMV(lA, hA, 0); if (mask_any) mask1(p, mask_all); pmax = fmaxf(fmaxf(p[0], p[1]), fmaxf(p[2], p[3])); SBAR();
    if (WITH_PV) RDV(lA, hA, 3); lgk_wait<(WITH_PV ? 4 : 0) + (WITH_QK ? 0 : 0)>(); SBAR(); if (WITH_PV) MMV(lB, hB, 1); pmax = fmaxf(pmax, fmaxf(fmaxf(p[4], p[5]), fmaxf(p[6], p[7]))); SBAR();
    if (WITH_PV) RDV(lB, hB, 4); lgk_wait<(WITH_PV ? 4 : 0) + (WITH_QK ? 0 : 0)>(); SBAR(); if (WITH_PV) MMV(lC, hC, 2); pmax = fmaxf(pmax, fmaxf(fmaxf(p[8], p[9]), fmaxf(p[10], p[11]))); SBAR();
    if (WITH_PV) RDV(lC, hC, 5); lgk_wait<(WITH_PV ? 4 : 0) + (WITH_QK ? 0 : 0)>(); SBAR(); if (WITH_PV) MMV(lA, hA, 3); pmax = fmaxf(pmax, fmaxf(fmaxf(p[12], p[13]), fmaxf(p[14], p[15]))); SBAR();
    if (WITH_PV) RDV(lA, hA, 6); lgk_wait<(WITH_PV ? 4 : 0) + (WITH_QK ? 0 : 0)>(); SBAR(); if (WITH_PV) MMV(lB, hB, 4); { auto rr = __builtin_amdgcn_permlane32_swap(__float_as_uint(pmax), __float_as_uint(pmax), false, false); pmax = fmaxf(__uint_as_float(rr[0]), __uint_as_float(rr[1])); } SBAR();
    if (WITH_PV) RDV(lB, hB, 7); lgk_wait<(WITH_PV ? 4 : 0) + (WITH_QK ? 0 : 0)>(); SBAR(); if (WITH_PV) MMV(lC, hC, 5); if (__builtin_expect(__all((pmax - m_reg) * SCALE <= THR), 1)) { mn = m_reg; alpha = 1.f; } else { mn = fmaxf(m_reg, pmax); alpha = __builtin_amdgcn_exp2f((m_reg - mn) * C2); m_reg = mn; } mnL = -mn * C2; SBAR();
    if (WITH_PV) RDV(lC, hC, 8); lgk_wait<(WITH_PV ? 4 : 0) + (WITH_QK ? 0 : 0)>(); SBAR(); if (WITH_PV) MMV(lA, hA, 6); p[0] = fmaf(p[0], C2, mnL); p[1] = fmaf(p[1], C2, mnL); p[2] = fmaf(p[2], C2, mnL); p[3] = fmaf(p[3], C2, mnL); SBAR();
    if (WITH_PV) RDV(lA, hA, 9); lgk_wait<(WITH_PV ? 4 : 0) + (WITH_QK ? 0 : 0)>(); SBAR(); if (WITH_PV) MMV(lB, hB, 7); p[4] = fmaf(p[4], C2, mnL); p[5] = fmaf(p[5], C2, mnL); p[6] = fmaf(p[6], C2, mnL); p[7] = fmaf(p[7], C2, mnL); SBAR();
    if (WITH_PV) RDV(lB, hB, 10); lgk_wait<(WITH_PV ? 4 : 0) + (WITH_QK ? 0 : 0)>(); SBAR(); if (WITH_PV) MMV(lC, hC, 8); p[8] = fmaf(p[8], C2, mnL); p[9] = fmaf(p[9], C2, mnL); p[10] = fmaf(p[10], C2, mnL); p[11] = fmaf(p[11], C2, mnL); SBAR();
    if (WITH_PV) RDV(lC, hC, 11); lgk_wait<(WITH_PV ? 4 : 0) + (WITH_QK ? 0 : 0)>(); SBAR(); if (WITH_PV) MMV(lA, hA, 9); p[12] = fmaf(p[12], C2, mnL); p[13] = fmaf(p[13], C2, mnL); p[14] = fmaf(p[14], C2, mnL); p[15] = fmaf(p[15], C2, mnL); SBAR();
    if (WITH_PV) RDV(lA, hA, 12); lgk_wait<(WITH_PV ? 4 : 0) + (WITH_QK ? 0 : 0)>(); SBAR(); if (WITH_PV) MMV(lB, hB, 10); p[0] = __builtin_amdgcn_exp2f(p[0]); p[1] = __builtin_amdgcn_exp2f(p[1]); SBAR();
    if (WITH_PV) RDV(lB, hB, 13); lgk_wait<(WITH_PV ? 4 : 0) + (WITH_QK ? 0 : 0)>(); SBAR(); if (WITH_PV) MMV(lC, hC, 11); p[2] = __builtin_amdgcn_exp2f(p[2]); p[3] = __builtin_amdgcn_exp2f(p[3]); SBAR();
    if (WITH_PV) RDV(lC, hC, 14); lgk_wait<(WITH_PV ? 4 : 0) + (WITH_QK ? 0 : 0)>(); SBAR(); if (WITH_PV) MMV(lA, hA, 12); p[4] = __builtin_amdgcn_exp2f(p[4]); p[5] = __builtin_amdgcn_exp2f(p[5]); SBAR();
    if (WITH_PV) RDV(lA, hA, 15); lgk_wait<(WITH_PV ? 4 : 0) + (WITH_QK ? 0 : 0)>(); SBAR(); if (WITH_PV) MMV(lB, hB, 13); p[6] = __builtin_amdgcn_exp2f(p[6]); p[7] = __builtin_amdgcn_exp2f(p[7]); SBAR();
    if (WITH_QK) { K_RD(kB, 0); Q_RD(qB, 0); } lgk_wait<(WITH_PV ? 2 : 0) + (WITH_QK ? 2 : 0)>(); SBAR(); if (WITH_PV) MMV(lC, hC, 14); p[8] = __builtin_amdgcn_exp2f(p[8]); p[9] = __builtin_amdgcn_exp2f(p[9]); SBAR();
    if (WITH_QK) { K_RD(kC, 1); Q_RD(qC, 1); } lgk_wait<(WITH_PV ? 0 : 0) + (WITH_QK ? 4 : 0)>(); SBAR(); if (WITH_PV) MMV(lA, hA, 15); p[10] = __builtin_amdgcn_exp2f(p[10]); p[11] = __builtin_amdgcn_exp2f(p[11]); SBAR();
    if (WITH_QK) { K_RD(kA, 2); Q_RD(qA, 2); } lgk_wait<(WITH_PV ? 0 : 0) + (WITH_QK ? 4 : 0)>(); SBAR(); if (WITH_QK) MF(pn, kB, qB); p[12] = __builtin_amdgcn_exp2f(p[12]); p[13] = __builtin_amdgcn_exp2f(p[13]); SBAR();
    if (WITH_QK) { K_RD(kB, 3); Q_RD(qB, 3); } lgk_wait<(WITH_PV ? 0 : 0) + (WITH_QK ? 4 : 0)>(); SBAR(); if (WITH_QK) MF(pn, kC, qC); p[14] = __builtin_amdgcn_exp2f(p[14]); p[15] = __builtin_amdgcn_exp2f(p[15]); SBAR();
    if (WITH_QK) { K_RD(kC, 4); Q_RD(qC, 4); } lgk_wait<(WITH_PV ? 0 : 0) + (WITH_QK ? 4 : 0)>(); SBAR(); if (WITH_QK) MF(pn, kA, qA); ps = ((p[0] + p[1]) + (p[2] + p[3])) + ((p[4] + p[5]) + (p[6] + p[7])); SBAR();
    if (WITH_QK) { K_RD(kA, 5); Q_RD(qA, 5); } lgk_wait<(WITH_PV ? 0 : 0) + (WITH_QK ? 4 : 0)>(); SBAR(); if (WITH_QK) MF(pn, kB, qB); ps += ((p[8] + p[9]) + (p[10] + p[11])) + ((p[12] + p[13]) + (p[14] + p[15])); { auto rr = __builtin_amdgcn_permlane32_swap(__float_as_uint(ps), __float_as_uint(ps), false, false); ps = __uint_as_float(rr[0]) + __uint_as_float(rr[1]); } l_reg = l_reg * alpha + ps; SBAR();
    if (WITH_QK) { K_RD(kB, 6); Q_RD(qB, 6); } lgk_wait<(WITH_PV ? 0 : 0) + (WITH_QK ? 4 : 0)>(); SBAR(); if (WITH_QK) MF(pn, kC, qC); x0 = cvt_pk_bf16(p[0], p[1]); x1 = cvt_pk_bf16(p[2], p[3]); y0 = cvt_pk_bf16(p[4], p[5]); y1 = cvt_pk_bf16(p[6], p[7]); SBAR();
    if (WITH_QK) { K_RD(kC, 7); Q_RD(qC, 7); } lgk_wait<(WITH_PV ? 0 : 0) + (WITH_QK ? 4 : 0)>(); SBAR(); if (WITH_QK) MF(pn, kA, qA); x2 = cvt_pk_bf16(p[8], p[9]); x3 = cvt_pk_bf16(p[10], p[11]); y2 = cvt_pk_bf16(p[12], p[13]); y3 = cvt_pk_bf16(p[14], p[15]); SBAR();
     lgk_wait<(WITH_PV ? 0 : 0) + (WITH_QK ? 2 : 0)>(); SBAR(); if (WITH_QK) MF(pn, kB, qB); { auto r0 = __builtin_amdgcn_permlane32_swap(x0, y0, false, false); auto r1 = __builtin_amdgcn_permlane32_swap(x1, y1, false, false); u32x4 w = {r0[0], r1[0], r0[1], r1[1]}; pa0 = *reinterpret_cast<bf16x8*>(&w); } SBAR();
     lgk_wait<(WITH_PV ? 0 : 0) + (WITH_QK ? 0 : 0)>(); SBAR(); if (WITH_QK) MF(pn, kC, qC); { auto r0 = __builtin_amdgcn_permlane32_swap(x2, y2, false, false); auto r1 = __builtin_amdgcn_permlane32_swap(x3, y3, false, false); u32x4 w = {r0[0], r1[0], r0[1], r1[1]}; pa1 = *reinterpret_cast<bf16x8*>(&w); } SBAR();
#undef WAITL
#undef RDV
#undef MMV
}
__device__ __forceinline__ void attn_pass(const int MODE, const PassRef& cur, LAS unsigned char* ldsL, float* stash, bf16_t* Oout, float lam, const int wid) {
    int lane = lane_id(); asm volatile("" : "+v"(lane));
    const int r32 = lane & 31, hi = lane >> 5;
    const int j_lo = cur.jlo, NT = cur.jhi - cur.jlo;
    const int lastw = cur.first ? cur.lastbase : cur.lastbase + 2 * (wid >> 1);
    char* lds = (char*)ldsL;
    float* ws = (float*)(lds + OFF_S) + wid * 64; float* li_l = ws, * al_l = ws + 32;
    unsigned voffK, voffV0;
    { const int o = wid * 1024 + lane * 16, row = o >> 8, c = ((o >> 4) & 15) ^ (row & 7); voffK = (unsigned)(row * PITCH * 2 + c * 16); }
    { const int o = wid * 1024 + lane * 16, st = o >> 9, kk = (st >> 3) * 8 + ((o & 511) >> 6), q = (o >> 4) & 3, c = (st & 7) * 32 + 8 * q, k = (kk & ~0xC) | ((kk & 4) << 1) | ((kk & 8) >> 1);
      voffV0 = (unsigned)(k * PITCH * 2 + c * 2); }
    const char* Kg = (const char*)cur.K + (size_t)j_lo * KV * PITCH * 2; const char* Vg = (const char*)cur.V + (size_t)j_lo * KV * PITCH * 2;
    constexpr size_t TSTEP = (size_t)KV * PITCH * 2;
#define DMA_K(t, kbuf) __builtin_amdgcn_global_load_lds((const unsigned*)(Kg + (size_t)(t) * TSTEP + voffK), (LAS unsigned*)(ldsL + OFF_K + (kbuf) * SHM_K + wid * 1024), 16, 0, 0)
#define DMA_V(t, vbuf) do { __builtin_amdgcn_global_load_lds((const unsigned*)(Vg + (size_t)(t) * TSTEP + voffV0), (LAS unsigned*)(ldsL + (vbuf) * SHM_V + wid * 1024), 16, 0, 0); \
                            __builtin_amdgcn_global_load_lds((const unsigned*)(Vg + (size_t)(t) * TSTEP + (size_t)16 * PITCH * 2 + voffV0), (LAS unsigned*)(ldsL + (vbuf) * SHM_V + 8192 + wid * 1024), 16, 0, 0); } while (0)
#define VMC(n) asm volatile("s_waitcnt vmcnt(" #n ")" ::: "memory")
#define BAR() __builtin_amdgcn_s_barrier()
    { const int rq = lane >> 4;
#pragma unroll
      for (int i = 0; i < 8; ++i) { const int row = 4 * i + rq; const unsigned vq = (unsigned)(row * PITCH * 2 + (((lane & 15) ^ (row & 7)) * 16));
          __builtin_amdgcn_global_load_lds((const unsigned*)((const char*)cur.Q + (size_t)(wid * QBLK) * PITCH * 2 + vq), (LAS unsigned*)(ldsL + OFF_Q + wid * 8192 + i * 1024), 16, 0, 0); } }
    DMA_K(0, 0); DMA_V(0, 0);
    if (NT > 1) { DMA_K(1, 1); DMA_V(1, 1); }
    int kbs[4];
#pragma unroll
    for (int dd = 0; dd < 4; ++dd) kbs[dd] = (int)(uintptr_t)(lds + OFF_K) + KSWZ(r32, (dd * 16 + hi * 8) * 2);
    int qb[4];
#pragma unroll
    for (int dd = 0; dd < 4; ++dd) qb[dd] = kbs[dd] + (OFF_Q - OFF_K) + wid * 8192;
    const int vb0 = (int)(uintptr_t)lds + v_rd_base(lane);
    float m_reg = -1e30f, l_reg = 0; f32x16 o[8] = {};
#define RESC(a) do { if (__any((a) < 1.f)) { const int l_ = lane_id(), r_ = l_ & 31, h_ = l_ >> 5;   \
                     if (h_ == 0) al_l[r_] = (a); asm volatile("s_waitcnt lgkmcnt(0)" ::: "memory");              \
                     _Pragma("unroll") for (int d_ = 0; d_ < 8; ++d_) _Pragma("unroll") for (int r = 0; r < 16; ++r) o[d_][r] *= al_l[crow(r, h_)]; } } while (0)
#define KFLIP() { kbs[0] ^= SHM_K; kbs[1] ^= SHM_K; kbs[2] ^= SHM_K; kbs[3] ^= SHM_K; }
    f32x16 p, pn; float al = 1.f; bf16x8 pa0, pa1;
    if (NT > 1) VMC(3); else VMC(0);
    BAR();
    { p = f32x16{}; bf16x8 kf, qf;
#pragma unroll
      for (int d0 = 0; d0 < 8; ++d0) { K_RD(kf, d0); Q_RD(qf, d0); LGK0(); SBAR(); MF(p, kf, qf); } SBAR(); }
    if (NT > 1) { VMC(2); BAR(); }
    int vslot = 0;
    if (NT > 1) {
        if (NT > 2) DMA_K(2, 0);
        KFLIP();
        { const int jt_ = j_lo; fused_step<true, false>(o, vb0, pa0, pa1, kbs, qb, p, pn, m_reg, l_reg, al, jt_ == 7 || jt_ > lastw, jt_ > lastw); }
        p = pn;
        VMC(0); LGK0(); BAR();
        for (int t = 1; t + 1 < NT; ++t) {
            SBAR();
            { const int vn_ = vslot == 0 ? 2 : vslot - 1; if (t + 2 < NT) DMA_K(t + 2, t & 1); DMA_V(t + 1, vn_); }
            KFLIP();
            { const int jt_ = j_lo + t; fused_step<true, true>(o, vb0 + vslot * SHM_V, pa0, pa1, kbs, qb, p, pn, m_reg, l_reg, al, jt_ == 7 || jt_ > lastw, jt_ > lastw); }
            RESC(al);
            p = pn;
            VMC(2); LGK0();
            BAR(); vslot = vslot == 2 ? 0 : vslot + 1;
        }
        { const int jt_ = j_lo + NT - 1; fused_step<false, true>(o, vb0 + vslot * SHM_V, pa0, pa1, kbs, qb, p, pn, m_reg, l_reg, al, jt_ == 7 || jt_ > lastw, jt_ > lastw); }
        RESC(al);
        VMC(0); LGK0(); BAR();
        vslot = vslot == 2 ? 0 : vslot + 1;
    } else {
        { const int jt_ = j_lo; fused_step<false, false>(o, vb0, pa0, pa1, kbs, qb, p, pn, m_reg, l_reg, al, jt_ == 7 || jt_ > lastw, jt_ > lastw); }
    }
    att2::pv_tile<0>(o, vb0 + vslot * SHM_V, pa0, pa1);
    if (hi == 0) li_l[r32] = l_reg; asm volatile("s_waitcnt lgkmcnt(0)" ::: "memory");
    int hie = hi; asm volatile("" : "+v"(hie));
    float rli[16];
#pragma unroll
    for (int r = 0; r < 16; ++r) rli[r] = __builtin_amdgcn_rcpf(li_l[crow(r, hie)]);
    f32x4* st4 = (f32x4*)stash + (wid * 64 + lane);
    if (MODE == 0) {
#pragma unroll
        for (int k = 0; k < 32; ++k) { const int d0 = k >> 2, rq = k & 3;
            st4[k * 512] = (f32x4){o[d0][4 * rq] * rli[4 * rq], o[d0][4 * rq + 1] * rli[4 * rq + 1], o[d0][4 * rq + 2] * rli[4 * rq + 2], o[d0][4 * rq + 3] * rli[4 * rq + 3]}; }
    } else {
        bf16_t* Ow = Oout + (size_t)((wid * QBLK + 4 * hie) * PITCH + r32);
        f32x4 sa[8], sb[8];
#define ST_LD(buf, kg) do { _Pragma("unroll") for (int k_ = 0; k_ < 8; ++k_) buf[k_] = st4[((kg) * 8 + k_) * 512]; } while (0)
#define ST_USE(buf, kg) do { _Pragma("unroll") for (int k_ = 0; k_ < 8; ++k_) { const int k = (kg) * 8 + k_, d0 = k >> 2, rq = k & 3;                          \
            _Pragma("unroll") for (int j_ = 0; j_ < 4; ++j_) { const int r = 4 * rq + j_; const float v = buf[k_][j_] - lam * (o[d0][r] * rli[r]); const float vn = xor1(v);   \
                if ((r32 & 1) == 0) *(unsigned*)(Ow + ((r & 3) + 8 * (r >> 2)) * PITCH + d0 * 32) = cvt_pk_bf16(v, vn); } } } while (0)
        ST_LD(sa, 0); SBAR();
        ST_LD(sb, 1); SBAR(); ST_USE(sa, 0); SBAR();
        ST_LD(sa, 2); SBAR(); ST_USE(sb, 1); SBAR();
        ST_LD(sb, 3); SBAR(); ST_USE(sa, 2); SBAR();
        ST_USE(sb, 3);
#undef ST_LD
#undef ST_USE
    }
    VMC(0); BAR();
#undef RESC
#undef KFLIP
#undef DMA_K
#undef DMA_V
#undef VMC
#undef BAR
}
#undef KRD
#undef LGK0
#undef MF
#undef TRRD
#undef PV_RD
#undef PV_MM
#undef K_RD
}
namespace att8 {
using att::crow; using att::load8; using att::v_rd_base; using att::SCALE; using att::THR;
using att2::mask1; using att2::v_rd_off;
constexpr int NW = 8, QBLK = 32, KV = 32, PITCH = 2048, DV = 256, KP = 128, VP = 256;
constexpr int SHM_V = KV * DV * 2, SHM_K = KV * 128 * 2, NVB = 3;
constexpr int OFF_K = NVB * SHM_V, OFF_Q = OFF_K + 2 * SHM_K, OFF_S = 132096, LDS_BYTES = OFF_S + NW * 64 * 4;
struct PassRef { const bf16_t* Q; const bf16_t* K; const bf16_t* V; int jlo, jhi, lastbase, first; };

#define KRD(dst, addr, off) asm volatile("ds_read_b128 %0, %1 offset:%2" : "=&v"(dst) : "v"(addr), "i"(off) : "memory")
#define LGK0() asm volatile("s_waitcnt lgkmcnt(0)" ::: "memory")
#define TRRD2(dst, base, off) asm volatile("ds_read_b64_tr_b16 %0, %1 offset:%2" : "=&v"(dst) : "v"(base), "i"(off) : "memory")
#define MF16(a, b, c) __builtin_amdgcn_mfma_f32_16x16x32_bf16(a, b, c, 0, 0, 0)

#define MF(acc, a, b) acc = __builtin_amdgcn_mfma_f32_32x32x16_bf16(a, b, acc, 0, 0, 0)
#define TRRD(dst, off) asm volatile("ds_read_b64_tr_b16 %0, %1 offset:%2" : "=&v"(dst) : "v"(vbase), "i"(off) : "memory")
#define PV_RD(l0, h0, l1, h1, d0) do { constexpr int b_ = v_rd_off(d0, 0, 0); TRRD(l0, b_); TRRD(h0, b_ + 4096); TRRD(l1, b_ + 8192); TRRD(h1, b_ + 12288); } while (0)
#define PV_MM(l0, h0, l1, h1, d0) do { \
        MF(o[d0], pa0, ((bf16x8){l0[0], l0[1], l0[2], l0[3], h0[0], h0[1], h0[2], h0[3]}));   \
        MF(o[d0], pa1, ((bf16x8){l1[0], l1[1], l1[2], l1[3], h1[0], h1[1], h1[2], h1[3]})); } while (0)
#define K_RD(dst, d0) do { const int a_ = kbs[0] ^ (((d0) & 3) << 5); KRD(dst, a_, ((d0) >> 2) * 128); } while (0)
#define Q_RD(dst, d0) do { const int a_ = qb[0] ^ (((d0) & 3) << 5); KRD(dst, a_, ((d0) >> 2) * 128); } while (0)

template <int N> __device__ __forceinline__ void lgk_wait() { asm volatile("s_waitcnt lgkmcnt(%0)" :: "n"(N) : "memory"); }
template <bool WITH_QK, bool WITH_PV>
__device__ __forceinline__ void fused_step(f32x4 (&o)[32], const int vbE, bf16x8& pa0, bf16x8& pa1, const int (&kbs)[4], const int (&qb)[4], f32x16& p, f32x16& pn, float& m_reg, float& l_reg, float& alpha,
                                           const bool mask_any, const bool mask_all) {
    constexpr float C2 = 1.4426950408889634f * SCALE;
    s16x4 lA, hA, lB, hB, lC, hC; bf16x8 kA, kB, kC, qA, qB, qC; float pmax = 0.f, mn = 0.f, mnL = 0.f, ps = 0.f; unsigned x0 = 0, x1 = 0, x2 = 0, x3 = 0, y0 = 0, y1 = 0, y2 = 0, y3 = 0;
    if (WITH_QK) pn = f32x16{};
    int vb = vbE;
#define WAITL(n) asm volatile("s_waitcnt lgkmcnt(" #n ")" ::: "memory")
#define RDV(l, h, g) do { constexpr int b_ = ((g) & 7) * 2048; TRRD2(l, vb, b_); TRRD2(h, vb, b_ + 1024); } while (0)
#define MMV(l, h, g) do { constexpr int ct_ = (g) < 8 ? 2 * (g) : 2 * ((g) - 8) + 1; const bf16x8 vf_ = {l[0], l[1], l[2], l[3], h[0], h[1], h[2], h[3]}; o[ct_] = MF16(vf_, pa0, o[ct_]); o[16 + ct_] = MF16(vf_, pa1, o[16 + ct_]); } while (0)
    if (WITH_PV) RDV(lA, hA, 0); if (WITH_PV) RDV(lB, hB, 1);
    if (WITH_PV) RDV(lC, hC, 2); lgk_wait<(WITH_PV ? 4 : 0) + (WITH_QK ? 0 : 0)>(); SBAR(); if (WITH_PV) MMV(lA, hA, 0); if (mask_any) mask1(p, mask_all); pmax = fmaxf(fmaxf(p[0], p[1]), fmaxf(p[2], p[3])); SBAR();
    if (WITH_PV) RDV(lA, hA, 3); lgk_wait<(WITH_PV ? 4 : 0) + (WITH_QK ? 0 : 0)>(); SBAR(); if (WITH_PV) MMV(lB, hB, 1); pmax = fmaxf(pmax, fmaxf(fmaxf(p[4], p[5]), fmaxf(p[6], p[7]))); SBAR();
    if (WITH_PV) RDV(lB, hB, 4); lgk_wait<(WITH_PV ? 4 : 0) + (WITH_QK ? 0 : 0)>(); SBAR(); if (WITH_PV) MMV(lC, hC, 2); pmax = fmaxf(pmax, fmaxf(fmaxf(p[8], p[9]), fmaxf(p[10], p[11]))); SBAR();
    if (WITH_PV) RDV(lC, hC, 5); lgk_wait<(WITH_PV ? 4 : 0) + (WITH_QK ? 0 : 0)>(); SBAR(); if (WITH_PV) MMV(lA, hA, 3); pmax = fmaxf(pmax, fmaxf(fmaxf(p[12], p[13]), fmaxf(p[14], p[15]))); SBAR();
    if (WITH_PV) RDV(lA, hA, 6); lgk_wait<(WITH_PV ? 4 : 0) + (WITH_QK ? 0 : 0)>(); SBAR(); if (WITH_PV) MMV(lB, hB, 4); { auto rr = __builtin_amdgcn_permlane32_swap(__float_as_uint(pmax), __float_as_uint(pmax), false, false); pmax = fmaxf(__uint_as_float(rr[0]), __uint_as_float(rr[1])); } SBAR();
    if (WITH_PV) RDV(lB, hB, 7); lgk_wait<(WITH_PV ? 4 : 0) + (WITH_QK ? 0 : 0)>(); SBAR(); if (WITH_PV) MMV(lC, hC, 5); if (__builtin_expect(__all((pmax - m_reg) * SCALE <= THR), 1)) { mn = m_reg; alpha = 1.f; } else { mn = fmaxf(m_reg, pmax); alpha = __builtin_amdgcn_exp2f((m_reg - mn) * C2); m_reg = mn; } mnL = -mn * C2; SBAR();
    if (WITH_PV) vb ^= 32; if (WITH_PV) RDV(lC, hC, 8); lgk_wait<(WITH_PV ? 4 : 0) + (WITH_QK ? 0 : 0)>(); SBAR(); if (WITH_PV) MMV(lA, hA, 6); p[0] = fmaf(p[0], C2, mnL); p[1] = fmaf(p[1], C2, mnL); p[2] = fmaf(p[2], C2, mnL); p[3] = fmaf(p[3], C2, mnL); SBAR();
    if (WITH_PV) RDV(lA, hA, 9); lgk_wait<(WITH_PV ? 4 : 0) + (WITH_QK ? 0 : 0)>(); SBAR(); if (WITH_PV) MMV(lB, hB, 7); p[4] = fmaf(p[4], C2, mnL); p[5] = fmaf(p[5], C2, mnL); p[6] = fmaf(p[6], C2, mnL); p[7] = fmaf(p[7], C2, mnL); SBAR();
    if (WITH_PV) RDV(lB, hB, 10); lgk_wait<(WITH_PV ? 4 : 0) + (WITH_QK ? 0 : 0)>(); SBAR(); if (WITH_PV) MMV(lC, hC, 8); p[8] = fmaf(p[8], C2, mnL); p[9] = fmaf(p[9], C2, mnL); p[10] = fmaf(p[10], C2, mnL); p[11] = fmaf(p[11], C2, mnL); SBAR();
    if (WITH_PV) RDV(lC, hC, 11); lgk_wait<(WITH_PV ? 4 : 0) + (WITH_QK ? 0 : 0)>(); SBAR(); if (WITH_PV) MMV(lA, hA, 9); p[12] = fmaf(p[12], C2, mnL); p[13] = fmaf(p[13], C2, mnL); p[14] = fmaf(p[14], C2, mnL); p[15] = fmaf(p[15], C2, mnL); SBAR();
    if (WITH_PV) RDV(lA, hA, 12); lgk_wait<(WITH_PV ? 4 : 0) + (WITH_QK ? 0 : 0)>(); SBAR(); if (WITH_PV) MMV(lB, hB, 10); p[0] = __builtin_amdgcn_exp2f(p[0]); p[1] = __builtin_amdgcn_exp2f(p[1]); SBAR();
    if (WITH_PV) RDV(lB, hB, 13); lgk_wait<(WITH_PV ? 4 : 0) + (WITH_QK ? 0 : 0)>(); SBAR(); if (WITH_PV) MMV(lC, hC, 11); p[2] = __builtin_amdgcn_exp2f(p[2]); p[3] = __builtin_amdgcn_exp2f(p[3]); SBAR();
    if (WITH_PV) RDV(lC, hC, 14); lgk_wait<(WITH_PV ? 4 : 0) + (WITH_QK ? 0 : 0)>(); SBAR(); if (WITH_PV) MMV(lA, hA, 12); p[4] = __builtin_amdgcn_exp2f(p[4]); p[5] = __builtin_amdgcn_exp2f(p[5]); SBAR();
    if (WITH_PV) RDV(lA, hA, 15); lgk_wait<(WITH_PV ? 4 : 0) + (WITH_QK ? 0 : 0)>(); SBAR(); if (WITH_PV) MMV(lB, hB, 13); p[6] = __builtin_amdgcn_exp2f(p[6]); p[7] = __builtin_amdgcn_exp2f(p[7]); SBAR();
    if (WITH_QK) { K_RD(kB, 0); Q_RD(qB, 0); } lgk_wait<(WITH_PV ? 2 : 0) + (WITH_QK ? 2 : 0)>(); SBAR(); if (WITH_PV) MMV(lC, hC, 14); p[8] = __builtin_amdgcn_exp2f(p[8]); p[9] = __builtin_amdgcn_exp2f(p[9]); SBAR();
    if (WITH_QK) { K_RD(kC, 1); Q_RD(qC, 1); } lgk_wait<(WITH_PV ? 0 : 0) + (WITH_QK ? 4 : 0)>(); SBAR(); if (WITH_PV) MMV(lA, hA, 15); p[10] = __builtin_amdgcn_exp2f(p[10]); p[11] = __builtin_amdgcn_exp2f(p[11]); SBAR();
    if (WITH_QK) { K_RD(kA, 2); Q_RD(qA, 2); } lgk_wait<(WITH_PV ? 0 : 0) + (WITH_QK ? 4 : 0)>(); SBAR(); if (WITH_QK) MF(pn, kB, qB); p[12] = __builtin_amdgcn_exp2f(p[12]); p[13] = __builtin_amdgcn_exp2f(p[13]); SBAR();
    if (WITH_QK) { K_RD(kB, 3); Q_RD(qB, 3); } lgk_wait<(WITH_PV ? 0 : 0) + (WITH_QK ? 4 : 0)>(); SBAR(); if (WITH_QK) MF(pn, kC, qC); p[14] = __builtin_amdgcn_exp2f(p[14]); p[15] = __builtin_amdgcn_exp2f(p[15]); SBAR();
    if (WITH_QK) { K_RD(kC, 4); Q_RD(qC, 4); } lgk_wait<(WITH_PV ? 0 : 0) + (WITH_QK ? 4 : 0)>(); SBAR(); if (WITH_QK) MF(pn, kA, qA); ps = ((p[0] + p[1]) + (p[2] + p[3])) + ((p[4] + p[5]) + (p[6] + p[7])); SBAR();
    if (WITH_QK) { K_RD(kA, 5); Q_RD(qA, 5); } lgk_wait<(WITH_PV ? 0 : 0) + (WITH_QK ? 4 : 0)>(); SBAR(); if (WITH_QK) MF(pn, kB, qB); ps += ((p[8] + p[9]) + (p[10] + p[11])) + ((p[12] + p[13]) + (p[14] + p[15])); { auto rr = __builtin_amdgcn_permlane32_swap(__float_as_uint(ps), __float_as_uint(ps), false, false); ps = __uint_as_float(rr[0]) + __uint_as_float(rr[1]); } l_reg = l_reg * alpha + ps; SBAR();
    if (WITH_QK) { K_RD(kB, 6); Q_RD(qB, 6); } lgk_wait<(WITH_PV ? 0 : 0) + (WITH_QK ? 4 : 0)>(); SBAR(); if (WITH_QK) MF(pn, kC, qC); x0 = cvt_pk_bf16(p[0], p[1]); x1 = cvt_pk_bf16(p[2], p[3]); y0 = cvt_pk_bf16(p[4], p[5]); y1 = cvt_pk_bf16(p[6], p[7]); SBAR();
    if (WITH_QK) { K_RD(kC, 7); Q_RD(qC, 7); } lgk_wait<(WITH_PV ? 0 : 0) + (WITH_QK ? 4 : 0)>(); SBAR(); if (WITH_QK) MF(pn, kA, qA); x2 = cvt_pk_bf16(p[8], p[9]); x3 = cvt_pk_bf16(p[10], p[11]); y2 = cvt_pk_bf16(p[12], p[13]); y3 = cvt_pk_bf16(p[14], p[15]); SBAR();
     lgk_wait<(WITH_PV ? 0 : 0) + (WITH_QK ? 2 : 0)>(); SBAR(); if (WITH_QK) MF(pn, kB, qB); { auto r0 = __builtin_amdgcn_permlane16_swap(x0, x2, false, false); auto r1 = __builtin_amdgcn_permlane16_swap(x1, x3, false, false); u32x4 w0 = __builtin_bit_cast(u32x4, pa0), w1 = __builtin_bit_cast(u32x4, pa1); w0[0] = r0[0]; w0[1] = r1[0]; w1[0] = r0[1]; w1[1] = r1[1]; pa0 = __builtin_bit_cast(bf16x8, w0); pa1 = __builtin_bit_cast(bf16x8, w1); } SBAR();
     lgk_wait<(WITH_PV ? 0 : 0) + (WITH_QK ? 0 : 0)>(); SBAR(); if (WITH_QK) MF(pn, kC, qC); { auto r2 = __builtin_amdgcn_permlane16_swap(y0, y2, false, false); auto r3 = __builtin_amdgcn_permlane16_swap(y1, y3, false, false); u32x4 w0 = __builtin_bit_cast(u32x4, pa0), w1 = __builtin_bit_cast(u32x4, pa1); w0[2] = r2[0]; w0[3] = r3[0]; w1[2] = r2[1]; w1[3] = r3[1]; pa0 = __builtin_bit_cast(bf16x8, w0); pa1 = __builtin_bit_cast(bf16x8, w1); } SBAR();
#undef WAITL
#undef RDV
#undef MMV
}
__device__ __forceinline__ void attn_pass(const int MODE, const PassRef& cur, LAS unsigned char* ldsL, float* stash, bf16_t* Oout, float lam, const int wid) {
    int lane = lane_id(); asm volatile("" : "+v"(lane));
    const int r32 = lane & 31, hi = lane >> 5;
    const int j_lo = cur.jlo, NT = cur.jhi - cur.jlo;
    const int lastw = cur.first ? cur.lastbase : cur.lastbase + 2 * (wid >> 1);
    char* lds = (char*)ldsL;
    float* ws = (float*)(lds + OFF_S) + wid * 64; float* li_l = ws, * al_l = ws + 32;
    unsigned voffK, voffV0;
    voffK = (unsigned)(wid * 1024 + lane * 16);
    voffV0 = (unsigned)(wid * 1024 + lane * 16);
    const char* Kg = (const char*)cur.K + (size_t)j_lo * KV * KP * 2; const char* Vg = (const char*)cur.V + (size_t)j_lo * KV * VP * 2;
    constexpr size_t TSTEP_K = (size_t)KV * KP * 2, TSTEP_V = (size_t)KV * VP * 2;
#define DMA_K(t, kbuf) __builtin_amdgcn_global_load_lds((const unsigned*)(Kg + (size_t)(t) * TSTEP_K + voffK), (LAS unsigned*)(ldsL + OFF_K + (kbuf) * SHM_K + wid * 1024), 16, 0, 0)
#define DMA_V(t, vbuf) do { __builtin_amdgcn_global_load_lds((const unsigned*)(Vg + (size_t)(t) * TSTEP_V + voffV0), (LAS unsigned*)(ldsL + (vbuf) * SHM_V + wid * 1024), 16, 0, 0); \
                            __builtin_amdgcn_global_load_lds((const unsigned*)(Vg + (size_t)(t) * TSTEP_V + (size_t)8192 + voffV0), (LAS unsigned*)(ldsL + (vbuf) * SHM_V + 8192 + wid * 1024), 16, 0, 0); } while (0)
#define VMC(n) asm volatile("s_waitcnt vmcnt(" #n ")" ::: "memory")
#define BAR() __builtin_amdgcn_s_barrier()
    { const int rq = lane >> 4;
#pragma unroll
      for (int i = 0; i < 8; ++i) { const int row = 4 * i + rq; const unsigned vq = (unsigned)(row * PITCH * 2 + (((lane & 15) ^ (row & 7)) * 16));
          __builtin_amdgcn_global_load_lds((const unsigned*)((const char*)cur.Q + (size_t)(wid * QBLK) * PITCH * 2 + vq), (LAS unsigned*)(ldsL + OFF_Q + wid * 8192 + i * 1024), 16, 0, 0); } }
    DMA_K(0, 0); DMA_V(0, 0);
    if (NT > 1) { DMA_K(1, 1); DMA_V(1, 1); }
    int kbs[4];
#pragma unroll
    for (int dd = 0; dd < 4; ++dd) kbs[dd] = (int)(uintptr_t)(lds + OFF_K) + KSWZ(r32, (dd * 16 + hi * 8) * 2);
    int qb[4];
#pragma unroll
    for (int dd = 0; dd < 4; ++dd) qb[dd] = kbs[dd] + (OFF_Q - OFF_K) + wid * 8192;
    const int vb0 = (int)(uintptr_t)lds + (((lane >> 2) & 3) + 4 * ((lane >> 4) & 1) + 8 * ((lane >> 5) & 1)) * 64 + ((lane >> 4) & 1) * 32 + (lane & 3) * 8;
    float m_reg = -1e30f, l_reg = 0; f32x4 o[32];
#pragma unroll
    for (int k_ = 0; k_ < 32; ++k_) o[k_] = (f32x4){0.f, 0.f, 0.f, 0.f};
#define RESC(a) do { if (__any((a) < 1.f)) { const int l_ = lane_id();   \
                     if ((l_ >> 5) == 0) al_l[l_ & 31] = (a); asm volatile("s_waitcnt lgkmcnt(0)" ::: "memory");              \
                     const float a0_ = al_l[l_ & 15], a1_ = al_l[16 + (l_ & 15)];                                                \
                     _Pragma("unroll") for (int k_ = 0; k_ < 16; ++k_) { o[k_] *= a0_; o[16 + k_] *= a1_; } } } while (0)
#define KFLIP() { kbs[0] ^= SHM_K; kbs[1] ^= SHM_K; kbs[2] ^= SHM_K; kbs[3] ^= SHM_K; }
    f32x16 p, pn; float al = 1.f; bf16x8 pa0, pa1;
    if (NT > 1) VMC(3); else VMC(0);
    BAR();
    { p = f32x16{}; bf16x8 kf, qf;
#pragma unroll
      for (int d0 = 0; d0 < 8; ++d0) { K_RD(kf, d0); Q_RD(qf, d0); LGK0(); SBAR(); MF(p, kf, qf); } SBAR(); }
    if (NT > 1) { VMC(2); BAR(); }
    int vslot = 0;
    if (NT > 1) {
        if (NT > 2) DMA_K(2, 0);
        KFLIP();
        { const int jt_ = j_lo; fused_step<true, false>(o, vb0, pa0, pa1, kbs, qb, p, pn, m_reg, l_reg, al, jt_ == 7 || jt_ > lastw, jt_ > lastw); }
        p = pn;
        VMC(0); LGK0(); BAR();
        for (int t = 1; t + 1 < NT; ++t) {
            SBAR();
            { const int vn_ = vslot == 0 ? 2 : vslot - 1; if (t + 2 < NT) DMA_K(t + 2, t & 1); DMA_V(t + 1, vn_); }
            KFLIP();
            { const int jt_ = j_lo + t; fused_step<true, true>(o, vb0 + vslot * SHM_V, pa0, pa1, kbs, qb, p, pn, m_reg, l_reg, al, jt_ == 7 || jt_ > lastw, jt_ > lastw); }
            RESC(al);
            p = pn;
            VMC(2); LGK0();
            BAR(); vslot = vslot == 2 ? 0 : vslot + 1;
        }
        { const int jt_ = j_lo + NT - 1; fused_step<false, true>(o, vb0 + vslot * SHM_V, pa0, pa1, kbs, qb, p, pn, m_reg, l_reg, al, jt_ == 7 || jt_ > lastw, jt_ > lastw); }
        RESC(al);
        VMC(0); LGK0(); BAR();
        vslot = vslot == 2 ? 0 : vslot + 1;
    } else {
        { const int jt_ = j_lo; fused_step<false, false>(o, vb0, pa0, pa1, kbs, qb, p, pn, m_reg, l_reg, al, jt_ == 7 || jt_ > lastw, jt_ > lastw); }
    }
    { int vf_b = vb0 + vslot * SHM_V;
#pragma unroll
      for (int g = 0; g < 16; ++g) { s16x4 l_, h_; const int b_ = (g & 7) * 2048, ct_ = g < 8 ? 2 * g : 2 * (g - 8) + 1;
          if (g == 8) vf_b ^= 32;
          asm volatile("ds_read_b64_tr_b16 %0, %1 offset:%2" : "=&v"(l_) : "v"(vf_b), "i"(b_) : "memory"); asm volatile("ds_read_b64_tr_b16 %0, %1 offset:%2" : "=&v"(h_) : "v"(vf_b), "i"(b_ + 1024) : "memory");
          LGK0(); SBAR();
          const bf16x8 vf_ = {l_[0], l_[1], l_[2], l_[3], h_[0], h_[1], h_[2], h_[3]}; o[ct_] = MF16(vf_, pa0, o[ct_]); o[16 + ct_] = MF16(vf_, pa1, o[16 + ct_]); } }
    if (hi == 0) li_l[r32] = l_reg; asm volatile("s_waitcnt lgkmcnt(0)" ::: "memory");
    int l15 = lane & 15; asm volatile("" : "+v"(l15));
    const float rl0 = __builtin_amdgcn_rcpf(li_l[l15]), rl1 = __builtin_amdgcn_rcpf(li_l[16 + l15]);
    f32x4* st4 = (f32x4*)stash + (wid * 64 + lane);
    if (MODE == 0) {
#pragma unroll
        for (int k = 0; k < 32; ++k) st4[k * 512] = o[k] * (k < 16 ? rl0 : rl1);
    } else {
        bf16_t* Ow = Oout + (size_t)((wid * QBLK + l15) * PITCH + 4 * (lane >> 4));
        f32x4 sa[4], sb[4];
#define ST_LD(buf, kg) do { _Pragma("unroll") for (int k_ = 0; k_ < 4; ++k_) buf[k_] = st4[((kg) * 4 + k_) * 512]; } while (0)
#define ST_USE(buf, kg) do { _Pragma("unroll") for (int k_ = 0; k_ < 4; ++k_) { const int k = (kg) * 4 + k_, rt = k >> 4, ct = k & 15;                          \
            const f32x4 v = buf[k_] - o[k] * (lam * (rt ? rl1 : rl0));                                                                                     \
            *(u32x2*)(Ow + (size_t)(16 * rt) * PITCH + 16 * ct) = (u32x2){cvt_pk_bf16(v[0], v[1]), cvt_pk_bf16(v[2], v[3])}; } } while (0)
        ST_LD(sa, 0); SBAR();
        ST_LD(sb, 1); SBAR(); ST_USE(sa, 0); SBAR();
        ST_LD(sa, 2); SBAR(); ST_USE(sb, 1); SBAR();
        ST_LD(sb, 3); SBAR(); ST_USE(sa, 2); SBAR();
        ST_LD(sa, 4); SBAR(); ST_USE(sb, 3); SBAR();
        ST_LD(sb, 5); SBAR(); ST_USE(sa, 4); SBAR();
        ST_LD(sa, 6); SBAR(); ST_USE(sb, 5); SBAR();
        ST_LD(sb, 7); SBAR(); ST_USE(sa, 6); SBAR();
        ST_USE(sb, 7);
#undef ST_LD
#undef ST_USE
    }
    VMC(0); BAR();
#undef RESC
#undef KFLIP
#undef DMA_K
#undef DMA_V
#undef VMC
#undef BAR
}
#undef KRD
#undef LGK0
#undef MF
#undef TRRD
#undef PV_RD
#undef PV_MM
#undef TRRD2
#undef MF16
#undef K_RD
}
constexpr size_t MiB = 1u << 20;
constexpr size_t RB = (size_t)TP * DM * 2;
constexpr size_t WS_CTL = 0, CTL_ZERO_BYTES = 1 * MiB;
constexpr size_t WS_ROPE = 1 * MiB;
constexpr size_t WS_ALOW = 4 * MiB;
constexpr size_t WS_DECAY = 7 * MiB;
constexpr size_t WS_SCORE = 10 * MiB;
constexpr size_t WS_STASH = 28 * MiB;
constexpr size_t WS_W1G = 60 * MiB;
constexpr size_t WS_WGATE = 109 * MiB;
constexpr size_t WS_WBRG = 125 * MiB, WS_WBRD = 133 * MiB, WS_WO = 141 * MiB;
constexpr size_t WS_GV = 150 * MiB;
constexpr size_t WS_GQK = WS_GV + RB;
constexpr size_t WS_DQ = WS_GQK + RB;
constexpr size_t WS_KB = WS_DQ + RB;
constexpr size_t WS_VB = WS_KB + RB;
constexpr size_t WS_OD = WS_VB + RB;
constexpr size_t WS_RB = WS_OD + RB;
constexpr size_t WS_END = WS_RB + RB;
static_assert(WS_END == 1116 * MiB, "ws map");
constexpr size_t WS_WFF1 = WS_STASH, WS_WFF2 = WS_W1G;
constexpr int CW_BAR = 4096;
constexpr int CW_QUEUE = 64;

constexpr int RING_OFF = 0, RING_BYTES = 131072;
constexpr int MISC_OFF = RING_BYTES + 320;
constexpr int LDS_BYTES = 147456;

#define RLX_AGENT __ATOMIC_RELAXED, __HIP_MEMORY_SCOPE_AGENT
#define LDS_WAIT() asm volatile("s_waitcnt lgkmcnt(0)" ::: "memory")
#define VM_WAIT() asm volatile("s_waitcnt vmcnt(0)" ::: "memory")

#define XB_TMO      128
#define XB_XCNT(j)  (256  + 64 * (j))
#define XB_XSUB(j)  (1280 + 64 * (j))
#define XB_XGEN(j)  (2304 + 64 * (j))
#define XB_TOP      3328
#define XB_TOPGEN   3392
#define XCD_BAR_WORDS 3456
#define XB_SPIN_CAP (1u << 22)
__device__ __forceinline__ unsigned xb_ld(unsigned* p)              { return __hip_atomic_load(p, __ATOMIC_RELAXED, __HIP_MEMORY_SCOPE_AGENT); }
__device__ __forceinline__ unsigned xb_add(unsigned* p, unsigned v) { return __hip_atomic_fetch_add(p, v, __ATOMIC_RELAXED, __HIP_MEMORY_SCOPE_AGENT); }
__device__ __forceinline__ unsigned xb_xcc_id() { return (unsigned)__builtin_amdgcn_s_getreg((3 << 11) | 20) & 0xFu; }
#define XB_SPIN(cond, bar) do { unsigned _sp = 0; while (cond) { __builtin_amdgcn_s_sleep(1); \
    if ((++_sp & 255u) == 0u) { if (xb_ld(&(bar)[XB_TMO])) break; if (_sp > XB_SPIN_CAP) { atomicAdd(&(bar)[XB_TMO], 1u); break; } } } } while (0)
struct XcdBarrier { unsigned* bar; unsigned x; volatile LAS unsigned* st; int wave; };
__device__ __forceinline__ XcdBarrier xcd_barrier_post(unsigned* bar, volatile LAS unsigned* st, int wave) {
    XcdBarrier b; b.bar = bar; b.x = xb_xcc_id(); b.st = st; b.wave = wave;
    if (wave == 0 && lane_id() == 0) (void)xb_add(&bar[XB_XCNT(b.x)], 1u);
    return b;
}
__device__ __forceinline__ void xcd_barrier_complete(unsigned* bar, unsigned x, unsigned& nloc, unsigned& nx) {
    const unsigned G = gridDim.x * gridDim.y * gridDim.z;
    unsigned sum, cnt, mine, sp = 0u;
    for (;;) {
        sum = 0u; cnt = 0u; mine = 0u;
#pragma unroll
        for (unsigned j = 0; j < 16; ++j) { const unsigned c = xb_ld(&bar[XB_XCNT(j)]); sum += c; cnt += (c > 0u) ? 1u : 0u; mine = (j == x) ? c : mine; }
        if (sum == G) break;
        __builtin_amdgcn_s_sleep(1);
        if ((++sp & 255u) == 0u) { if (xb_ld(&bar[XB_TMO])) break; if (sp > XB_SPIN_CAP) { atomicAdd(&bar[XB_TMO], 1u); break; } }
    }
    nloc = mine > 0u ? mine : 1u; nx = cnt > 0u ? cnt : 1u;
}
__device__ __forceinline__ void xcd_barrier(const XcdBarrier& b) {
    asm volatile("s_waitcnt vmcnt(0)" ::: "memory");
    __syncthreads();
    if (b.wave == 0 && lane_id() == 0) {
        unsigned* bar = b.bar;
        __builtin_amdgcn_s_waitcnt(0);
        unsigned nloc = b.st[0], nx = b.st[1];
        if (nloc == 0u) { xcd_barrier_complete(bar, b.x, nloc, nx); b.st[0] = nloc; b.st[1] = nx; }
        const unsigned old = xb_add(&bar[XB_XSUB(b.x)], 1u);
        const unsigned gen = old / nloc;
        if (old + 1u == (gen + 1u) * nloc) {
            __builtin_amdgcn_fence(__ATOMIC_RELEASE, "agent");
            asm volatile("s_waitcnt vmcnt(0)" ::: "memory");
            const unsigned og = xb_add(&bar[XB_TOP], 1u);
            const unsigned tg = og / nx;
            if (og + 1u == (tg + 1u) * nx) xb_add(&bar[XB_TOPGEN], 1u);
            else XB_SPIN(xb_ld(&bar[XB_TOPGEN]) == tg, bar);
            __builtin_amdgcn_fence(__ATOMIC_ACQUIRE, "agent");
            xb_add(&bar[XB_XGEN(b.x)], 1u);
            asm volatile("s_waitcnt vmcnt(0)" ::: "memory");
        } else {
            XB_SPIN(xb_ld(&bar[XB_XGEN(b.x)]) == gen, bar);
            __builtin_amdgcn_fence(__ATOMIC_ACQUIRE, "agent");
            asm volatile("s_waitcnt vmcnt(0)" ::: "memory");
        }
    }
    __syncthreads();
}

struct Args { const float* in[24]; float* out; unsigned char* ws; int ph_lo, ph_hi; };
struct Frame {
    LAS unsigned char* lds; volatile LAS unsigned* MISC;
    int wave, G, gw, NGW;
};
typedef const float* cfp_t;
__device__ __forceinline__ const float* inp(int i) { const __attribute__((address_space(4))) cfp_t* t = (const __attribute__((address_space(4))) cfp_t*)__builtin_amdgcn_kernarg_segment_ptr(); asm volatile("" : "+s"(t)); return t[i]; }
__device__ __forceinline__ float* outp() { const __attribute__((address_space(4))) char* t = (const __attribute__((address_space(4))) char*)__builtin_amdgcn_kernarg_segment_ptr(); asm volatile("" : "+s"(t)); return *(float* const __attribute__((address_space(4)))*)(t + 192); }
__device__ __forceinline__ unsigned char* wsp() { const __attribute__((address_space(4))) char* t = (const __attribute__((address_space(4))) char*)__builtin_amdgcn_kernarg_segment_ptr(); asm volatile("" : "+s"(t)); return *(unsigned char* const __attribute__((address_space(4)))*)(t + 200); }
#define TID (F.wave * 64 + lane_id())
#define LANE (lane_id())
__device__ __forceinline__ float wave_sum(float v) {
#pragma unroll
    for (int o = 1; o < 64; o <<= 1) v += __shfl_xor(v, o);
    return v;
}
__device__ __forceinline__ int row_pos(int row) {
    if (row >= SR0) return PAST + ((row - SR0) & 63);
    const int ri = row % BS; return ri >= PADR ? ri - PADR : 0;
}
__device__ __forceinline__ long row_kv(int row, bool& sample) {
    if (row >= SR0) { sample = true; return row - SR0; }
    sample = false; const int b = row / BS, ri = row - b * BS; return ri >= PADR ? (long)b * LP + (ri - PADR) : -1;
}
__device__ __forceinline__ const float* row_x(const Frame& F, int row, float*& y) {
    if (row >= SR0) { y = outp() + O_YS + (size_t)(row - SR0) * DM; return inp(1) + (size_t)(row - SR0) * DM; }
    const int b = row / BS, ri = row - b * BS;
    if (ri >= 256) { y = outp() + O_YP + ((size_t)b * SEQ + (ri - 256)) * DM; return inp(0) + ((size_t)b * SEQ + (ri - 256)) * DM; }
    y = nullptr; if (ri >= PADR) return inp(5) + (size_t)(ri - PADR) * DM; return nullptr;
}

__device__ __forceinline__ void transpose_item(const float* W, int ldw, int K, int c0, int ncv, int k0, bf16_t* WT, int n0, LAS float* scr, int lane) {
    const int n4 = 4 * (lane & 7);
#pragma unroll
    for (int i = 0; i < 8; ++i) { const int kk = (lane >> 3) + 8 * i;
        const f32x4 v = n4 < ncv ? *(const f32x4*)(W + (size_t)(k0 + kk) * ldw + c0 + n4) : (f32x4){0.f, 0.f, 0.f, 0.f};
        LAS float* d = scr + kk * 33 + n4; d[0] = v[0]; d[1] = v[1]; d[2] = v[2]; d[3] = v[3]; }
    LDS_WAIT(); asm volatile("" ::: "memory");
    const int c = lane & 7;
#pragma unroll
    for (int j = 0; j < 4; ++j) { const int n = (lane >> 3) + 8 * j; const LAS float* s = scr + (8 * c) * 33 + n;
        u32x4 o; o.x = cvt_pk_bf16(s[0 * 33], s[1 * 33]); o.y = cvt_pk_bf16(s[2 * 33], s[3 * 33]); o.z = cvt_pk_bf16(s[4 * 33], s[5 * 33]); o.w = cvt_pk_bf16(s[6 * 33], s[7 * 33]);
        *(GAS u32x4*)(WT + (size_t)(n0 + n) * K + k0 + 8 * c) = o; }
    LDS_WAIT(); asm volatile("" ::: "memory");
}
__device__ __forceinline__ int w1_src_col(int n) {
    if (n < 4096) return n;
    if (n < 10240) return n + 2064;
    if (n < 12288) return n - 6128;
    if (n < 12304) return n - 8192;
    return -1;
}
__device__ __forceinline__ void rms_row_to_bf16(const float* xrow, const float* g, bf16_t* orow, int lane) {
    GAS unsigned long long* o8 = (GAS unsigned long long*)orow + lane;
    if (!xrow) {
#pragma unroll
        for (int j = 0; j < 8; ++j) o8[64 * j] = 0ull;
        return; }
    const GAS f32x4* xr = (const GAS f32x4*)xrow + lane; const GAS f32x4* gr = (const GAS f32x4*)g + lane;
    f32x4 v[8]; float s = 0.f;
#pragma unroll
    for (int j = 0; j < 8; ++j) { v[j] = xr[64 * j]; s += (v[j].x * v[j].x + v[j].y * v[j].y) + (v[j].z * v[j].z + v[j].w * v[j].w); }
    const float rs = 1.0f / sqrtf(wave_sum(s) * (1.f / DM) + EPS);
#pragma unroll
    for (int j = 0; j < 8; ++j) { const f32x4 gg = gr[64 * j];
        o8[64 * j] = (unsigned long long)cvt_pk_bf16(v[j].x * rs * gg.x, v[j].y * rs * gg.y) | ((unsigned long long)cvt_pk_bf16(v[j].z * rs * gg.z, v[j].w * rs * gg.w) << 32); }
}
constexpr int CV_WG = 32 * 128, CV_SQ = 32 * 64, CV_F1 = 32 * 256, CV_F2 = 128 * 64, CV_TOTAL = CV_WG + 3 * CV_SQ + CV_F1 + CV_F2;
static_assert(CV_TOTAL % 32 == 0, "conv items");
__device__ __forceinline__ void conv_item(Frame& F, int r, LAS float* scr) {
    const float* W; int ldw, K, c0, k0, n0; size_t wt;
    if (r < CV_WG) { const int kb = r / 128, nb = r % 128; W = inp(7); ldw = 16400; K = DM; c0 = 12304 + nb * 32; k0 = kb * 64; wt = WS_WGATE; n0 = nb * 32; }
    else if (r < CV_WG + 3 * CV_SQ) { r -= CV_WG; const int which = r / CV_SQ; r -= which * CV_SQ; const int kb = r / 64, nb = r % 64;
        W = which == 0 ? inp(16) : (which == 1 ? inp(17) : inp(18)); ldw = DM; K = DM; c0 = nb * 32; k0 = kb * 64; wt = which == 0 ? WS_WBRG : (which == 1 ? WS_WBRD : WS_WO); n0 = nb * 32; }
    else if (r < CV_WG + 3 * CV_SQ + CV_F1) { r -= CV_WG + 3 * CV_SQ; const int kb = r / 256, nb = r % 256; W = inp(21); ldw = DFF; K = DM; c0 = nb * 32; k0 = kb * 64; wt = WS_WFF1; n0 = nb * 32; }
    else { r -= CV_WG + 3 * CV_SQ + CV_F1; const int kb = r / 64, nb = r % 64; W = inp(22); ldw = DM; K = DFF; c0 = nb * 32; k0 = kb * 64; wt = WS_WFF2; n0 = nb * 32; }
    transpose_item(W, ldw, K, c0, 32, k0, (bf16_t*)(wsp() + wt), n0, scr, LANE);
}
__device__ __forceinline__ void p0_prologue(Frame& F) {
    LAS float* scr = (LAS float*)(F.lds + RING_OFF + F.wave * 16384);
    const float* w_in = inp(7);
    constexpr int I_W1 = 32 * (N1 / 32);
    for (int it = F.gw; it < I_W1; it += F.NGW) {
        const int kb = it / (N1 / 32), nb = it % (N1 / 32), n0 = nb * 32; const int sc = w1_src_col(n0);
        const int ncv = sc < 0 ? 0 : (n0 == 12288 ? 16 : 32);
        transpose_item(w_in, 16400, DM, sc < 0 ? 0 : sc, ncv, kb * 64, (bf16_t*)(wsp() + WS_W1G), n0, scr, LANE); }
    { float2* tab = (float2*)(wsp() + WS_ROPE);
      for (int i = blockIdx.x * 512 + TID; i < LP * 16; i += F.G * 512) { const int pos = i >> 4, k = i & 15;
          const float invf = powf(500000.0f, -(float)(2 * k) / 32.0f); const float ang = (float)pos * invf; float sn, cs; sincosf(ang, &sn, &cs); tab[i] = make_float2(cs, sn); } }
    { bf16_t* U = (bf16_t*)(outp() + O_YP);
      for (int m = F.gw; m < TP; m += F.NGW) { float* y; const float* x = row_x(F, m, y); rms_row_to_bf16(x, inp(6), U + (size_t)m * DM, LANE); } }
}

struct EpiP1 {
    static constexpr bool PERM = true;
    unsigned char* ws; float* out;
    __device__ __forceinline__ bool operator()(f32x4 (&acc)[2][2][4][2], const pg8::Unit& u, int wr, int wc, int fr, int fq) const {
        const int pn = u.pn; const int row0 = u.pm * 256 + wr * 64 + fr;
        if (pn == 48) {
            if (wc == 0 && fq < 2) { float* A = (float*)(ws + WS_ALOW);
#pragma unroll
                for (int ai = 0; ai < 2; ++ai)
#pragma unroll
                    for (int m = 0; m < 4; ++m) { float* ap = A + (size_t)(row0 + ai * 128 + m * 16) * 16 + 8 * fq; *(f32x4*)ap = acc[ai][0][m][0]; *(f32x4*)(ap + 4) = acc[ai][0][m][1]; } }
            return false; }
        if (pn < 8) {
            const float sc = pn < 4 ? 0.0625f : 1.0f; bf16_t* base = (bf16_t*)(ws + WS_GQK) + (pn < 4 ? (size_t)0 : (size_t)TP * 1024); const int h = pn & 3;
#pragma unroll
            for (int ai = 0; ai < 2; ++ai)
#pragma unroll
                for (int m = 0; m < 4; ++m) { const int row = row0 + ai * 128 + m * 16; bf16_t* rp = base + ((size_t)((row >> 6) * 4 + h) * 64 + (row & 63)) * 256 + wc * 32 + 8 * fq;
#pragma unroll
                    for (int bj = 0; bj < 2; ++bj) { const f32x4 v0 = acc[ai][bj][m][0] * sc, v1 = acc[ai][bj][m][1] * sc;
                        *(u32x4*)(rp + bj * 128) = (u32x4){cvt_pk_bf16(v0[0], v0[1]), cvt_pk_bf16(v0[2], v0[3]), cvt_pk_bf16(v1[0], v1[1]), cvt_pk_bf16(v1[2], v1[3])}; } }
            return false; }
        const bool rope = (pn >= 16 && pn < 32) && wc == 0;
        const bool f32o = (pn >= 24 && pn < 40);
        bf16_t* base; int c0; size_t rpitch = DM, bjs = 128;
        if (pn < 16) { base = (bf16_t*)(ws + WS_GV); c0 = (pn - 8) * 256; }
        else if (pn < 24) { base = (bf16_t*)(ws + WS_DQ); c0 = (pn - 16) * 256; }
        else if (pn < 32) { base = (bf16_t*)(ws + WS_KB) + (size_t)(pn - 24) * 2 * TP * 128; c0 = (pn - 24) * 256; rpitch = 128; bjs = (size_t)TP * 128; }
        else if (pn < 40) { base = (bf16_t*)(ws + WS_VB) + (size_t)(pn - 32) * TP * 256; c0 = (pn - 32) * 256; rpitch = 256; }
        else { base = (bf16_t*)(ws + WS_RB); c0 = (pn - 40) * 256; }
        const bool silu = pn >= 40;
        const float2* tab = (const float2*)(ws + WS_ROPE);
        const bool up = fq >= 2;
#pragma unroll
        for (int ai = 0; ai < 2; ++ai)
#pragma unroll
            for (int m = 0; m < 4; ++m) { const int row = row0 + ai * 128 + m * 16;
                f32x4 v[2][2];
#pragma unroll
                for (int bj = 0; bj < 2; ++bj) { v[bj][0] = acc[ai][bj][m][0]; v[bj][1] = acc[ai][bj][m][1]; }
                if (rope) { const int pos = row_pos(row); const f32x4* tp = (const f32x4*)(tab + (size_t)pos * 16 + 8 * (fq & 1));
                    const f32x4 t0 = tp[0], t1 = tp[1], t2 = tp[2], t3 = tp[3];
                    const f32x4 cs[2] = {(f32x4){t0[0], t0[2], t1[0], t1[2]}, (f32x4){t2[0], t2[2], t3[0], t3[2]}}, sn[2] = {(f32x4){t0[1], t0[3], t1[1], t1[3]}, (f32x4){t2[1], t2[3], t3[1], t3[3]}};
#pragma unroll
                    for (int bj = 0; bj < 2; ++bj)
#pragma unroll
                        for (int n = 0; n < 2; ++n) { f32x4 o;
#pragma unroll
                            for (int j = 0; j < 4; ++j) { const float own = v[bj][n][j];
                                auto rr = __builtin_amdgcn_permlane32_swap(__float_as_uint(own), __float_as_uint(own), false, false);
                                const float oth = __uint_as_float(up ? rr[0] : rr[1]);
                                o[j] = own * cs[n][j] + (up ? oth : -oth) * sn[n][j]; }
                            v[bj][n] = o; } }
                if (silu) {
#pragma unroll
                    for (int bj = 0; bj < 2; ++bj)
#pragma unroll
                        for (int n = 0; n < 2; ++n)
#pragma unroll
                            for (int j = 0; j < 4; ++j) { const float x = v[bj][n][j]; v[bj][n][j] = x * sigmoidf_(x); } }
                bf16_t* rp = base + (size_t)row * rpitch + ((pn >= 24 && pn < 40) ? 0 : c0) + wc * 32 + 8 * fq;
                const bool vimg = pn >= 32 && pn < 40;
                if (pn >= 24 && pn < 32) rp = base + (size_t)row * rpitch + 8 * ((wc * 4 + fq) ^ (row & 7));
                bf16_t* vt = base + (size_t)(row >> 5) * 8192;
#pragma unroll
                for (int bj = 0; bj < 2; ++bj)
                    *(u32x4*)(vimg ? vt + (v_img_off(row & 31, bj * 128 + wc * 32 + 8 * fq) >> 1) : rp + bj * bjs) = (u32x4){cvt_pk_bf16(v[bj][0][0], v[bj][0][1]), cvt_pk_bf16(v[bj][0][2], v[bj][0][3]), cvt_pk_bf16(v[bj][1][0], v[bj][1][1]), cvt_pk_bf16(v[bj][1][2], v[bj][1][3])};
                if (f32o) { bool smp; const long kr = row_kv(row, smp);
                    if (kr >= 0) { float* op = out + (pn < 32 ? (smp ? O_KS : O_KP) : (smp ? O_VS : O_VP)) + (size_t)kr * DM + c0 + wc * 32 + 8 * fq;
#pragma unroll
                        for (int bj = 0; bj < 2; ++bj) { *(f32x4*)(op + bj * 128) = v[bj][0]; *(f32x4*)(op + bj * 128 + 4) = v[bj][1]; } } }
            }
        return false;
    }
};

__device__ __forceinline__ float logsigmoid_(float x) { const float e = __expf(-fabsf(x)); return fminf(x, 0.f) - __logf(1.0f + e); }
__device__ __forceinline__ int qperm32(int c32) { return 8 * ((c32 >> 2) & 3) + 4 * (c32 >> 4) + (c32 & 3); }
constexpr int P2_ALOW = 0, P2_TOT = 4096, P2_QS = 8192, P2_PITCH = 528, P2_KS = P2_QS + 64 * P2_PITCH;
__device__ __forceinline__ void p2_unit(Frame& F, int g, int h) {
    LAS unsigned char* L = F.lds + RING_OFF;
    LAS float* alow_s = (LAS float*)(L + P2_ALOW); LAS float* tot = (LAS float*)(L + P2_TOT);
    const int row0 = g * 64, tid = TID, c = tid & 255, hf = tid >> 8, ch = h * 256 + c;
    const int padn = (row0 < SR0 && (row0 % BS) == 192) ? 48 : 0;
    bf16_t* qimg = (bf16_t*)(wsp() + WS_GQK) + (size_t)(g * 4 + h) * 16384; bf16_t* kimg = qimg + (size_t)TP * 1024;
    if (tid < 256) *(LAS f32x4*)(alow_s + tid * 4) = *(const f32x4*)((const float*)(wsp() + WS_ALOW) + (size_t)row0 * 16 + tid * 4);
#pragma unroll
    for (int j = 0; j < 4; ++j) { const int q = tid + 512 * j;
        *(LAS u32x4*)(L + P2_QS + (q >> 5) * P2_PITCH + (q & 31) * 16) = *(const u32x4*)(qimg + (size_t)q * 8);
        *(LAS u32x4*)(L + P2_KS + (q >> 5) * P2_PITCH + (q & 31) * 16) = *(const u32x4*)(kimg + (size_t)q * 8); }
    float wa[16];
#pragma unroll
    for (int j = 0; j < 16; ++j) wa[j] = inp(8)[j * 1024 + ch];
    const float ba = inp(9)[ch];
    __syncthreads();
    float b[32]; float run = 0.f;
#pragma unroll
    for (int i = 0; i < 32; ++i) { const int t = 32 * hf + i; float x = ba;
#pragma unroll
        for (int j4 = 0; j4 < 4; ++j4) { const f32x4 av = *(const LAS f32x4*)(alow_s + t * 16 + 4 * j4); x = fmaf(av[0], wa[4 * j4], x); x = fmaf(av[1], wa[4 * j4 + 1], x); x = fmaf(av[2], wa[4 * j4 + 2], x); x = fmaf(av[3], wa[4 * j4 + 3], x); }
        const float la = t < padn ? 0.f : logsigmoid_(x) * 0.0625f; run += la; b[i] = run; }
    tot[hf * 256 + c] = run;
    __syncthreads();
    const float bmid = tot[c], blast = tot[c] + tot[256 + c];
    if (hf == 1) {
#pragma unroll
        for (int i = 0; i < 32; ++i) b[i] += bmid; }
    if (hf == 0) ((float*)(wsp() + WS_DECAY))[(size_t)g * 1024 + ch] = __expf(blast);
    LAS bf16_t* QS = (LAS bf16_t*)(L + P2_QS); LAS bf16_t* KS = (LAS bf16_t*)(L + P2_KS);
    const int cs = (c & ~31) + qperm32(c & 31);
    unsigned kd[16];
    const float ebm = __expf(bmid), elb = __expf(blast - bmid);
#pragma unroll
    for (int i = 0; i < 32; i += 2) {
        float kdv[2], qh[2], qsv[2], ksv[2];
#pragma unroll
        for (int e = 0; e < 2; ++e) { const int t = 32 * hf + i + e; const float q = bf2f(QS[t * (P2_PITCH / 2) + c]), k = bf2f(KS[t * (P2_PITCH / 2) + c]);
            const float e1 = __expf(b[i + e] - bmid), r1 = __builtin_amdgcn_rcpf(e1);
            qsv[e] = q * e1; ksv[e] = k * r1; qh[e] = qsv[e] * ebm; kdv[e] = ksv[e] * elb; }
        const unsigned wq = cvt_pk_bf16(qh[0], qh[1]), ws_ = cvt_pk_bf16(qsv[0], qsv[1]), wk = cvt_pk_bf16(ksv[0], ksv[1]);
        const int t0 = 32 * hf + i;
        qimg[t0 * 256 + cs] = (bf16_t)(wq & 0xffffu); qimg[(t0 + 1) * 256 + cs] = (bf16_t)(wq >> 16);
        QS[t0 * (P2_PITCH / 2) + c] = (bf16_t)(ws_ & 0xffffu); QS[(t0 + 1) * (P2_PITCH / 2) + c] = (bf16_t)(ws_ >> 16);
        KS[t0 * (P2_PITCH / 2) + c] = (bf16_t)(wk & 0xffffu); KS[(t0 + 1) * (P2_PITCH / 2) + c] = (bf16_t)(wk >> 16);
        kd[i >> 1] = cvt_pk_bf16(kdv[0], kdv[1]); }
    { u32x4* dst = (u32x4*)(kimg + (size_t)c * 64 + 32 * hf);
#pragma unroll
      for (int j = 0; j < 4; ++j) dst[j] = (u32x4){kd[4 * j], kd[4 * j + 1], kd[4 * j + 2], kd[4 * j + 3]}; }
    __syncthreads();
    { const int w = F.wave, fr = LANE & 15, fq = LANE >> 4, mt = w >> 1;
      f32x4 a2[2] = {(f32x4){0.f, 0.f, 0.f, 0.f}, (f32x4){0.f, 0.f, 0.f, 0.f}};
#pragma unroll
      for (int ks = 0; ks < 8; ++ks) { const bf16x8 qf = *(const LAS bf16x8*)(L + P2_QS + (16 * mt + fr) * P2_PITCH + (32 * ks + 8 * fq) * 2);
#pragma unroll
          for (int e = 0; e < 2; ++e) { const int nt = (w & 1) * 2 + e; const bf16x8 kf = *(const LAS bf16x8*)(L + P2_KS + (16 * nt + fr) * P2_PITCH + (32 * ks + 8 * fq) * 2);
              a2[e] = __builtin_amdgcn_mfma_f32_16x16x32_bf16(kf, qf, a2[e], 0, 0, 0); } }
      bf16_t* sc = (bf16_t*)(wsp() + WS_SCORE) + (size_t)(g * 4 + h) * 4096; const int t = 16 * mt + fr;
#pragma unroll
      for (int e = 0; e < 2; ++e) { const int s0 = ((w & 1) * 2 + e) * 16 + 4 * fq; float v[4];
#pragma unroll
          for (int i = 0; i < 4; ++i) v[i] = (s0 + i <= t) ? a2[e][i] : 0.f;
          *(u32x2*)(sc + t * 64 + s0) = (u32x2){cvt_pk_bf16(v[0], v[1]), cvt_pk_bf16(v[2], v[3])}; } }
    __syncthreads();
}
constexpr int SC_QH = 0, SC_QP = 528, SC_KD = SC_QH + 64 * SC_QP, SC_KP = 144, SC_VT = SC_KD + 256 * SC_KP, SC_SC = SC_VT + 64 * 144, SC_DC = SC_SC + 64 * 144, SC_PO = SC_DC + 1024, SC_END = SC_PO + 2 * 64 * 64 * 4;
static_assert(SC_END <= RING_BYTES, "scan LDS");
struct ScanRegs { u32x4 q[4], k[4], v, s; float d; };
__device__ __forceinline__ void scan_load(Frame& F, int g, int h, int vs, ScanRegs& R) {
    const int tid = TID;
    const bf16_t* qimg = (const bf16_t*)(wsp() + WS_GQK) + (size_t)(g * 4 + h) * 16384; const bf16_t* kimg = qimg + (size_t)TP * 1024;
#pragma unroll
    for (int j = 0; j < 4; ++j) { R.q[j] = *(const u32x4*)(qimg + (size_t)(tid + 512 * j) * 8); R.k[j] = *(const u32x4*)(kimg + (size_t)(tid + 512 * j) * 8); }
    R.v = *(const u32x4*)((const bf16_t*)(wsp() + WS_GV) + (size_t)(g * 64 + (tid >> 3)) * DM + h * 512 + vs * 64 + 8 * (tid & 7));
    R.s = *(const u32x4*)((const bf16_t*)(wsp() + WS_SCORE) + (size_t)(g * 4 + h) * 4096 + tid * 8);
    R.d = ((const float*)(wsp() + WS_DECAY))[(size_t)g * 1024 + h * 256 + (tid & 255)];
}
__device__ __forceinline__ void scan_stage(Frame& F, const ScanRegs& R) {
    LAS unsigned char* L = F.lds + RING_OFF; const int tid = TID;
#pragma unroll
    for (int j = 0; j < 4; ++j) { const int q = tid + 512 * j;
        *(LAS u32x4*)(L + SC_QH + (q >> 5) * SC_QP + (q & 31) * 16) = R.q[j];
        *(LAS u32x4*)(L + SC_KD + (q >> 3) * SC_KP + (q & 7) * 16) = R.k[j]; }
    { const int s = tid >> 3, v0 = 8 * (tid & 7); LAS bf16_t* vt = (LAS bf16_t*)(L + SC_VT);
#pragma unroll
      for (int j = 0; j < 4; ++j) { const unsigned w = R.v[j]; vt[(v0 + 2 * j) * 72 + s] = (bf16_t)(w & 0xffffu); vt[(v0 + 2 * j + 1) * 72 + s] = (bf16_t)(w >> 16); } }
    *(LAS u32x4*)(L + SC_SC + (tid >> 3) * 144 + (tid & 7) * 16) = R.s;
    if (tid < 256) ((LAS float*)(L + SC_DC))[tid] = R.d;
}
__device__ __forceinline__ void scan_unit(Frame& F, int seq, int h, int vs) {
    LAS unsigned char* L = F.lds + RING_OFF;
    int lane = LANE; asm volatile("" : "+v"(lane));
    const int w = F.wave, tid = w * 64 + lane, fr = lane & 15, fq = lane >> 4, vg = w & 3, chf = w >> 2;
    const bool smp = seq >= 2; const int s_i = seq - 2;
    const int g0 = smp ? 520 + s_i : 260 * seq + 3, ng = smp ? 1 : 257;
    const size_t st_off = smp ? O_SS + (size_t)(s_i * 4 + h) * 131072 : O_SP + (size_t)(seq * 4 + h) * 131072;
    const int vcol = vs * 64 + 16 * vg + fr;
    f32x4 Sa[8];
#pragma unroll
    for (int mt = 0; mt < 8; ++mt) {
        if (smp) { const float* sp = inp(4) + (size_t)(s_i * 4 + h) * 131072 + (size_t)(128 * chf + 16 * mt + 4 * fq) * 512 + vcol;
            Sa[mt] = (f32x4){sp[0], sp[512], sp[1024], sp[1536]}; }
        else Sa[mt] = (f32x4){0.f, 0.f, 0.f, 0.f}; }
    ScanRegs R; scan_load(F, g0, h, vs, R);
    for (int gi = 0; gi < ng; ++gi) {
        const int g = g0 + gi;
        scan_stage(F, R);
        __syncthreads();
        if (gi + 1 < ng) scan_load(F, g + 1, h, vs, R);
        f32x4 po[4];
#pragma unroll
        for (int mt = 0; mt < 4; ++mt) po[mt] = (f32x4){0.f, 0.f, 0.f, 0.f};
#pragma unroll
        for (int ks = 0; ks < 4; ++ks) {
            u32x4 bw = {cvt_pk_bf16(Sa[2 * ks][0], Sa[2 * ks][1]), cvt_pk_bf16(Sa[2 * ks][2], Sa[2 * ks][3]), cvt_pk_bf16(Sa[2 * ks + 1][0], Sa[2 * ks + 1][1]), cvt_pk_bf16(Sa[2 * ks + 1][2], Sa[2 * ks + 1][3])};
            const bf16x8 bfrag = __builtin_bit_cast(bf16x8, bw);
#pragma unroll
            for (int mt = 0; mt < 4; ++mt) { const bf16x8 af = *(const LAS bf16x8*)(L + SC_QH + (16 * mt + fr) * SC_QP + (128 * chf + 32 * ks + 8 * fq) * 2);
                po[mt] = __builtin_amdgcn_mfma_f32_16x16x32_bf16(af, bfrag, po[mt], 0, 0, 0); } }
        { const bf16x8 vf = *(const LAS bf16x8*)(L + SC_VT + (16 * vg + fr) * 144 + (32 * chf + 8 * fq) * 2);
#pragma unroll
          for (int mt = 0; mt < 4; ++mt) { const bf16x8 sf = *(const LAS bf16x8*)(L + SC_SC + (16 * mt + fr) * 144 + (32 * chf + 8 * fq) * 2);
              po[mt] = __builtin_amdgcn_mfma_f32_16x16x32_bf16(sf, vf, po[mt], 0, 0, 0); } }
        { LAS float* PO = (LAS float*)(L + SC_PO) + chf * 4096;
#pragma unroll
          for (int mt = 0; mt < 4; ++mt)
#pragma unroll
              for (int i = 0; i < 4; ++i) PO[(16 * mt + 4 * fq + i) * 64 + 16 * vg + fr] = po[mt][i]; }
        { bf16x8 vf[2];
#pragma unroll
          for (int ks = 0; ks < 2; ++ks) vf[ks] = *(const LAS bf16x8*)(L + SC_VT + (16 * vg + fr) * 144 + (32 * ks + 8 * fq) * 2);
#pragma unroll
          for (int mt = 0; mt < 8; ++mt) { const f32x4 dc = *(const LAS f32x4*)(L + SC_DC + (128 * chf + 16 * mt + 4 * fq) * 4); Sa[mt] = Sa[mt] * dc;
#pragma unroll
              for (int ks = 0; ks < 2; ++ks) { const bf16x8 kf = *(const LAS bf16x8*)(L + SC_KD + (128 * chf + 16 * mt + fr) * SC_KP + (32 * ks + 8 * fq) * 2);
                  Sa[mt] = __builtin_amdgcn_mfma_f32_16x16x32_bf16(kf, vf[ks], Sa[mt], 0, 0, 0); } } }
        __syncthreads();
        { const int t = tid >> 3, vc = 8 * (tid & 7); const LAS float* P0 = (const LAS float*)(L + SC_PO) + t * 64 + vc; const LAS float* P1 = P0 + 4096;
          const f32x4 a0 = *(const LAS f32x4*)P0, a1 = *(const LAS f32x4*)(P0 + 4), b0 = *(const LAS f32x4*)P1, b1 = *(const LAS f32x4*)(P1 + 4);
          const f32x4 s0 = a0 + b0, s1 = a1 + b1;
          *(u32x4*)((bf16_t*)(wsp() + WS_GV) + (size_t)(g * 64 + t) * DM + h * 512 + vs * 64 + vc) = (u32x4){cvt_pk_bf16(s0[0], s0[1]), cvt_pk_bf16(s0[2], s0[3]), cvt_pk_bf16(s1[0], s1[1]), cvt_pk_bf16(s1[2], s1[3])}; }
        __syncthreads();
    }
#pragma unroll
    for (int mt = 0; mt < 8; ++mt) { float* sp = outp() + st_off + (size_t)(128 * chf + 16 * mt + 4 * fq) * 512 + vcol;
#pragma unroll
        for (int i = 0; i < 4; ++i) sp[(size_t)i * 512] = Sa[mt][i]; }
}
__device__ __forceinline__ float diff_lambda(const Frame& F) {
    float s1 = 0.f, s2 = 0.f;
    for (int i = 0; i < 128; ++i) { s1 = fmaf(inp(11)[i], inp(12)[i], s1); s2 = fmaf(inp(13)[i], inp(14)[i], s2); }
    return expf(s1) - expf(s2) + 0.2f;
}
__device__ __forceinline__ void attn_item(Frame& F, int b, int h, int I, float lam) {
    const bf16_t* Dq = (const bf16_t*)(wsp() + WS_DQ); const bf16_t* Kb = (const bf16_t*)(wsp() + WS_KB); const bf16_t* Vb = (const bf16_t*)(wsp() + WS_VB);
    const size_t brow = (size_t)b * BS;
    att8::PassRef r0;
    r0.Q = Dq + (brow + (size_t)I * 256) * DM + h * 256; r0.K = Kb + ((size_t)(h * 2) * TP + brow) * 128; r0.V = Vb + ((size_t)h * TP + brow) * 256;
    r0.jlo = 7; r0.jhi = 8 * I + 8; r0.lastbase = I == 0 ? 7 : 8 * I + 1; r0.first = I == 0;
    float* stash = outp() + O_YP + (size_t)36700160 + (size_t)blockIdx.x * 65536;
    bf16_t* Oo = (bf16_t*)(wsp() + WS_OD) + (brow + (size_t)I * 256) * DM + h * 256;
    for (int map = 0; map < 2; ++map) {
        att8::attn_pass(map, r0, F.lds + RING_OFF, stash, Oo, lam, F.wave);
        r0.Q += 128; r0.K += (size_t)TP * 128; }
}
__device__ __forceinline__ void attn_sample_item(Frame& F, int b, int h, float lam) {
    using namespace att;
    char* lds = (char*)(F.lds + RING_OFF);
    int lane = LANE; asm volatile("" : "+v"(lane));
    const int wid = F.wave, tid = wid * 64 + lane, r32 = lane & 31, hi = lane >> 5;
    const int map = wid & 1, rh = (wid >> 1) & 1, vhf = wid >> 2;
    char* V_lds = lds; char* K_lds = lds + 2 * SHM_V;
    float* wsl = (float*)(lds + 2 * SHM_V + 2 * SHM_K) + wid * 64; float* li_l = wsl, * al_l = wsl + 32;
    const int sr = tid >> 4, sc = (tid & 15) * 8, vst0 = v_st(sr, sc), vst1 = v_st(32 + sr, sc), kws = KSWZ(sr, sc * 2);
    const int vb0 = (int)(uintptr_t)V_lds + vhf * SHM_V + v_rd_base(lane);
    const bf16_t* Dq = (const bf16_t*)(wsp() + WS_DQ); const bf16_t* Kb = (const bf16_t*)(wsp() + WS_KB); const bf16_t* Vb = (const bf16_t*)(wsp() + WS_VB);
    const size_t srow = (size_t)SR0 + (size_t)b * 64;
    bf16x8 qr[8];
#pragma unroll
    for (int d0 = 0; d0 < 8; ++d0) qr[d0] = load8(Dq + (srow + 32 * rh + r32) * DM + h * 256 + map * 128 + d0 * 16 + hi * 8);
    float m_reg = -1e30f, l_reg = 0.f; f32x16 o[4] = {};
    const float* ck = inp(2) + ((size_t)b * PAST * 8 + h) * 256; const float* cv = inp(3) + ((size_t)b * PAST * 8 + h) * 256;
    f32x4 R[16];
#define SMP_LOAD(jj) do { if ((jj) < 16) { _Pragma("unroll") for (int part = 0; part < 4; ++part) { const float* xp = (part < 2 ? ck : cv) + (size_t)(64 * (jj) + sr) * 2048 + (part & 1) * 128 + sc;   \
            R[4 * part] = *(const f32x4*)xp; R[4 * part + 1] = *(const f32x4*)(xp + 4); R[4 * part + 2] = *(const f32x4*)(xp + 32 * 2048); R[4 * part + 3] = *(const f32x4*)(xp + 32 * 2048 + 4); } }   \
        else { _Pragma("unroll") for (int part = 0; part < 4; ++part) { const bf16_t* xp = part < 2 ? Kb + ((size_t)(h * 2 + part) * TP + srow + sr) * 128 + 8 * ((sc >> 3) ^ (sr & 7)) : Vb + ((size_t)h * TP + srow) * 256 + (v_img_off(sr, (part & 1) * 128 + sc) >> 1);   \
            const u32x4 u0 = *(const u32x4*)xp, u1 = *(const u32x4*)(xp + (size_t)(part < 2 ? 32 * 128 : 8192));   \
            R[4 * part] = (f32x4){bf_lo(u0[0]), bf_hi(u0[0]), bf_lo(u0[1]), bf_hi(u0[1])}; R[4 * part + 1] = (f32x4){bf_lo(u0[2]), bf_hi(u0[2]), bf_lo(u0[3]), bf_hi(u0[3])};   \
            R[4 * part + 2] = (f32x4){bf_lo(u1[0]), bf_hi(u1[0]), bf_lo(u1[1]), bf_hi(u1[1])}; R[4 * part + 3] = (f32x4){bf_lo(u1[2]), bf_hi(u1[2]), bf_lo(u1[3]), bf_hi(u1[3])}; } } } while (0)
    SMP_LOAD(0);
    for (int j = 0; j < 17; ++j) {
#pragma unroll
        for (int part = 0; part < 4; ++part) { const int sub = part & 1;
            const f32x4 a0 = R[4 * part], a1 = R[4 * part + 1], a2 = R[4 * part + 2], a3 = R[4 * part + 3];
            u32x4 w0 = (u32x4){cvt_pk_bf16(a0[0], a0[1]), cvt_pk_bf16(a0[2], a0[3]), cvt_pk_bf16(a1[0], a1[1]), cvt_pk_bf16(a1[2], a1[3])};
            u32x4 w1 = (u32x4){cvt_pk_bf16(a2[0], a2[1]), cvt_pk_bf16(a2[2], a2[3]), cvt_pk_bf16(a3[0], a3[1]), cvt_pk_bf16(a3[2], a3[3])};
            const bf16x8 x0 = __builtin_bit_cast(bf16x8, w0), x1 = __builtin_bit_cast(bf16x8, w1);
            if (part < 2) { *(bf16x8*)(K_lds + sub * SHM_K + kws) = x0; *(bf16x8*)(K_lds + sub * SHM_K + kws + 32 * 256) = x1; }
            else { *(bf16x8*)(V_lds + sub * SHM_V + vst0) = x0; *(bf16x8*)(V_lds + sub * SHM_V + vst1) = x1; } }
        __syncthreads();
        if (j + 1 < 17) SMP_LOAD(j + 1);
        f32x16 p0, p1; float mn, al; bf16x8 pa0, pa1, pa2, pa3;
        qkt<0>(p0, p1, K_lds + map * SHM_K, r32, hi, qr, true);
        partialSM(p0, p1, m_reg, mn, al);
        finishSM(p0, p1, al, l_reg, pa0, pa1, pa2, pa3);
        if (__any(al < 1.f)) { if (hi == 0) al_l[r32] = al; asm volatile("s_waitcnt lgkmcnt(0)" ::: "memory");
            for (int d_ = 0; d_ < 4; ++d_) for (int r = 0; r < 16; ++r) o[d_][r] *= al_l[crow(r, hi)]; }
        pv_tile<0>(o, vb0, pa0, pa1, pa2, pa3, true);
        __syncthreads();
    }
#undef SMP_LOAD
    if (hi == 0) li_l[r32] = l_reg; asm volatile("s_waitcnt lgkmcnt(0)" ::: "memory");
    int hie = hi; asm volatile("" : "+v"(hie));
    float rli[16];
#pragma unroll
    for (int r = 0; r < 16; ++r) rli[r] = __builtin_amdgcn_rcpf(li_l[crow(r, hie)]);
    float* X = (float*)lds + ((vhf * 2 + rh) * 32 + 4 * hie) * 128 + r32;
    if (map == 1) {
#pragma unroll
        for (int r = 0; r < 16; ++r)
#pragma unroll
            for (int d0 = 0; d0 < 4; ++d0) X[((r & 3) + 8 * (r >> 2)) * 128 + d0 * 32] = lam * (o[d0][r] * rli[r]); }
    __syncthreads();
    if (map == 0) { bf16_t* Ow = (bf16_t*)(wsp() + WS_OD) + (srow + 32 * rh + 4 * hie) * DM + h * 256 + vhf * 128 + r32;
#pragma unroll
        for (int r = 0; r < 16; ++r) { const int ro = (r & 3) + 8 * (r >> 2);
#pragma unroll
            for (int d0 = 0; d0 < 4; ++d0) { const float v = o[d0][r] * rli[r] - X[ro * 128 + d0 * 32]; const float vn = xor1(v);
                if ((r32 & 1) == 0) *(unsigned*)(Ow + ro * DM + d0 * 32) = cvt_pk_bf16(v, vn); } } }
    __syncthreads();
}
constexpr int Q_SCAN_P = 64, Q_SCAN_S = 1024, Q_ATT_P = 1040, Q_ATT_S = 256, Q_TOTAL = Q_SCAN_P + Q_SCAN_S + Q_ATT_P + Q_ATT_S;
__device__ __forceinline__ int q_next(Frame& F, int slot) {
    __syncthreads();
    if (TID == 0) { gu32* qp = ((gu32*)wsp()) + CW_QUEUE + 64 * slot; unsigned old_, zero_ = 0u, one_ = 1u;
        asm volatile("global_atomic_add %0, %1, %2, %3 sc0\n\ts_waitcnt vmcnt(0)" : "=&v"(old_) : "v"(zero_), "v"(one_), "s"(qp) : "memory");
        F.MISC[4] = old_; }
    __syncthreads();
    volatile LAS unsigned* mp = F.MISC + 4; asm volatile("" : "+v"(mp));
    return __builtin_amdgcn_readfirstlane((int)*mp);
}
__device__ __forceinline__ void p3_run(Frame& F) {
    const float lam = __uint_as_float(__builtin_amdgcn_readfirstlane(__float_as_uint(diff_lambda(F))));
    for (;;) { const int it = q_next(F, 0); if (it >= Q_SCAN_P + Q_SCAN_S) break;
        if (it < Q_SCAN_P) scan_unit(F, (it & 7) >> 2, it & 3, it >> 3);
        else { const int j = it - Q_SCAN_P; scan_unit(F, 2 + (j >> 5), (j >> 3) & 3, j & 7); } }
    for (;;) { const int it = q_next(F, 2); if (it >= Q_ATT_S) break; attn_sample_item(F, it >> 3, it & 7, lam); }
    for (;;) { const int it = q_next(F, 1); if (it >= Q_ATT_P) break;
        const int bb = it >= 520 ? 1 : 0, r_ = it - 520 * bb, I = 64 - (r_ >> 3); attn_item(F, bb, r_ & 7, I, lam); }
    { LAS float* scr = (LAS float*)(F.lds + RING_OFF + F.wave * 16384);
      for (;;) { const int it = q_next(F, 3); if (it >= CV_TOTAL / 32) break;
          for (int s_ = 0; s_ < 4; ++s_) conv_item(F, it * 32 + s_ * 8 + F.wave, scr); } }
}

__device__ __forceinline__ void p4_row(Frame& F, int m) {
    const int lane = LANE;
    { u32x4* op = (u32x4*)((bf16_t*)(wsp() + WS_GV) + (size_t)m * DM) + lane; const u32x4* rp = (const u32x4*)((const bf16_t*)(wsp() + WS_RB) + (size_t)m * DM) + lane;
      const f32x4* gp = (const f32x4*)inp(10) + lane * 2;
      const f32x4 g0 = gp[0], g1 = gp[1];
      u32x4 ov[4], rv[4];
#pragma unroll
      for (int j = 0; j < 4; ++j) { ov[j] = op[64 * j]; rv[j] = rp[64 * j]; }
#pragma unroll
      for (int j = 0; j < 4; ++j) { float ss = 0.f;
#pragma unroll
          for (int e = 0; e < 4; ++e) { const float a = bf_lo(ov[j][e]), b = bf_hi(ov[j][e]); ss += a * a + b * b; }
          const float rs = 1.0f / sqrtf(wave_sum(ss) * (1.f / 512.f) + EPS);
          u32x4 w;
          w[0] = cvt_pk_bf16(bf_lo(ov[j][0]) * rs * g0[0] * bf_lo(rv[j][0]), bf_hi(ov[j][0]) * rs * g0[1] * bf_hi(rv[j][0]));
          w[1] = cvt_pk_bf16(bf_lo(ov[j][1]) * rs * g0[2] * bf_lo(rv[j][1]), bf_hi(ov[j][1]) * rs * g0[3] * bf_hi(rv[j][1]));
          w[2] = cvt_pk_bf16(bf_lo(ov[j][2]) * rs * g1[0] * bf_lo(rv[j][2]), bf_hi(ov[j][2]) * rs * g1[1] * bf_hi(rv[j][2]));
          w[3] = cvt_pk_bf16(bf_lo(ov[j][3]) * rs * g1[2] * bf_lo(rv[j][3]), bf_hi(ov[j][3]) * rs * g1[3] * bf_hi(rv[j][3]));
          op[64 * j] = w; } }
    { u32x4* op = (u32x4*)((bf16_t*)(wsp() + WS_OD) + (size_t)m * DM) + lane;
      const f32x4* gp = (const f32x4*)inp(15) + (lane & 31) * 2;
      const f32x4 g0 = gp[0], g1 = gp[1];
      u32x4 ov[4];
#pragma unroll
      for (int j = 0; j < 4; ++j) ov[j] = op[64 * j];
#pragma unroll
      for (int j = 0; j < 4; ++j) { float ss = 0.f;
#pragma unroll
          for (int e = 0; e < 4; ++e) { const float a = bf_lo(ov[j][e]), b = bf_hi(ov[j][e]); ss += a * a + b * b; }
          ss += __shfl_xor(ss, 1); ss += __shfl_xor(ss, 2); ss += __shfl_xor(ss, 4); ss += __shfl_xor(ss, 8); ss += __shfl_xor(ss, 16);
          const float rs = 0.8f / sqrtf(ss * (1.f / 256.f) + EPS);
          u32x4 w;
          w[0] = cvt_pk_bf16(bf_lo(ov[j][0]) * rs * g0[0], bf_hi(ov[j][0]) * rs * g0[1]);
          w[1] = cvt_pk_bf16(bf_lo(ov[j][1]) * rs * g0[2], bf_hi(ov[j][1]) * rs * g0[3]);
          w[2] = cvt_pk_bf16(bf_lo(ov[j][2]) * rs * g1[0], bf_hi(ov[j][2]) * rs * g1[1]);
          w[3] = cvt_pk_bf16(bf_lo(ov[j][3]) * rs * g1[2], bf_hi(ov[j][3]) * rs * g1[3]);
          op[64 * j] = w; } }
}

#define OPAQUE(p) asm volatile("" : "+v"(p))
template <int MODE> struct EpiGate {
    static constexpr bool PERM = true;
    u32x4* st0; const u32x4* st1; bf16_t* O;
    __device__ __forceinline__ bool operator()(f32x4 (&acc)[2][2][4][2], const pg8::Unit& u, int wr, int wc, int fr, int fq) const {
        int tid = (wr * 4 + wc) * 64 + lane_id(); OPAQUE(tid);
        const size_t tb = (size_t)(u.pm * 8 + u.pn) * 8192 + tid;
        u32x4* p0 = st0 + tb; const u32x4* p1 = st1 + tb;
        bf16_t* op = O + (size_t)(u.pm * 256 + wr * 64 + (tid & 15)) * DM + u.pn * 256 + wc * 32 + 8 * ((tid >> 4) & 3);
        constexpr int PD = 4;
        const u32x4* l1 = p1; const u32x4* l0 = p0; u32x4 rb[PD], qb[PD];
        if (MODE != 0) {
#pragma unroll
            for (int k = 0; k < PD; ++k) { rb[k] = *l1; if (MODE == 2) qb[k] = *l0; l1 += 512; l0 += 512; OPAQUE(l1); OPAQUE(l0); }
            __builtin_amdgcn_sched_barrier(0); }
#pragma unroll
        for (int g = 0; g < 16; ++g) { const int ai = g >> 3, bj = (g >> 2) & 1, m = g & 3; const f32x4 x = acc[ai][bj][m][0], y = acc[ai][bj][m][1];
            if (MODE == 0) { *p0 = (u32x4){cvt_pk_bf16(sigmoidf_(x[0]), sigmoidf_(x[1])), cvt_pk_bf16(sigmoidf_(x[2]), sigmoidf_(x[3])), cvt_pk_bf16(sigmoidf_(y[0]), sigmoidf_(y[1])), cvt_pk_bf16(sigmoidf_(y[2]), sigmoidf_(y[3]))}; }
            else { const u32x4 r = rb[g % PD]; const u32x4 q = MODE == 2 ? qb[g % PD] : r;
                if (g + PD < 16) { rb[g % PD] = *l1; if (MODE == 2) qb[g % PD] = *l0; l1 += 512; l0 += 512; OPAQUE(l1); OPAQUE(l0); }
                const f32x4 v0 = x * (f32x4){bf_lo(r[0]), bf_hi(r[0]), bf_lo(r[1]), bf_hi(r[1])}, v1 = y * (f32x4){bf_lo(r[2]), bf_hi(r[2]), bf_lo(r[3]), bf_hi(r[3])};
                if (MODE == 1) { *p0 = (u32x4){cvt_pk_bf16(v0[0], v0[1]), cvt_pk_bf16(v0[2], v0[3]), cvt_pk_bf16(v1[0], v1[1]), cvt_pk_bf16(v1[2], v1[3])}; }
                else { const f32x4 w0 = v0 + (f32x4){bf_lo(q[0]), bf_hi(q[0]), bf_lo(q[1]), bf_hi(q[1])}, w1 = v1 + (f32x4){bf_lo(q[2]), bf_hi(q[2]), bf_lo(q[3]), bf_hi(q[3])};
                    *(u32x4*)(op + (size_t)(ai * 128 + m * 16) * DM + bj * 128) = (u32x4){cvt_pk_bf16(w0[0], w0[1]), cvt_pk_bf16(w0[2], w0[3]), cvt_pk_bf16(w1[0], w1[1]), cvt_pk_bf16(w1[2], w1[3])}; } }
            p0 += 512; OPAQUE(p0); __builtin_amdgcn_sched_barrier(0); }
        return false;
    }
};
template <int ACT> struct EpiBf16 {
    static constexpr bool PERM = true;
    bf16_t* O; int ldc;
    __device__ __forceinline__ bool operator()(f32x4 (&acc)[2][2][4][2], const pg8::Unit& u, int wr, int wc, int fr, int fq) const {
        const int row0 = u.pm * 256 + wr * 64 + fr, col0 = u.pn * 256 + wc * 32 + 8 * fq;
#pragma unroll
        for (int ai = 0; ai < 2; ++ai)
#pragma unroll
            for (int m = 0; m < 4; ++m) { bf16_t* rowp = O + (size_t)(row0 + ai * 128 + m * 16) * ldc + col0;
#pragma unroll
                for (int bj = 0; bj < 2; ++bj) { f32x4 v0 = acc[ai][bj][m][0], v1 = acc[ai][bj][m][1];
                    if (ACT == 1) {
#pragma unroll
                        for (int j = 0; j < 4; ++j) { const float a = fmaxf(v0[j], 0.f), b = fmaxf(v1[j], 0.f); v0[j] = a * a; v1[j] = b * b; } }
                    *(u32x4*)(rowp + bj * 128) = (u32x4){cvt_pk_bf16(v0[0], v0[1]), cvt_pk_bf16(v0[2], v0[3]), cvt_pk_bf16(v1[0], v1[1]), cvt_pk_bf16(v1[2], v1[3])}; } }
        return false;
    }
};

__device__ __forceinline__ void p7_row(Frame& F, int m) {
    const int lane = LANE; float* y; const float* x = row_x(F, m, y);
    bf16_t* u2 = (bf16_t*)(wsp() + WS_GV) + (size_t)m * DM;
    if (!y) { rms_row_to_bf16(nullptr, nullptr, u2, lane); return; }
    const bf16_t* t = (const bf16_t*)(wsp() + WS_GQK) + (size_t)m * DM;
    const GAS f32x4* xr = (const GAS f32x4*)x + lane; const GAS u32x2* tr = (const GAS u32x2*)t + lane;
    f32x4 tv[8]; float s = 0.f;
#pragma unroll
    for (int j = 0; j < 8; ++j) { const u32x2 w = tr[64 * j]; tv[j] = (f32x4){bf_lo(w[0]), bf_hi(w[0]), bf_lo(w[1]), bf_hi(w[1])}; s += (tv[j].x * tv[j].x + tv[j].y * tv[j].y) + (tv[j].z * tv[j].z + tv[j].w * tv[j].w); }
    const float rs = 1.0f / sqrtf(wave_sum(s) * (1.f / DM) + EPS);
    const GAS f32x4* g1 = (const GAS f32x4*)inp(19) + lane; float s2 = 0.f;
#pragma unroll
    for (int j = 0; j < 8; ++j) { const f32x4 hv = xr[64 * j] + tv[j] * rs * g1[64 * j]; tv[j] = hv; s2 += (hv.x * hv.x + hv.y * hv.y) + (hv.z * hv.z + hv.w * hv.w); }
    const float rs2 = 1.0f / sqrtf(wave_sum(s2) * (1.f / DM) + EPS);
    GAS f32x4* yr = (GAS f32x4*)y + lane; const GAS f32x4* g2 = (const GAS f32x4*)inp(20) + lane; GAS unsigned long long* o8 = (GAS unsigned long long*)u2 + lane;
#pragma unroll
    for (int j = 0; j < 8; ++j) { yr[64 * j] = tv[j]; const f32x4 gg = g2[64 * j];
        o8[64 * j] = (unsigned long long)cvt_pk_bf16(tv[j].x * rs2 * gg.x, tv[j].y * rs2 * gg.y) | ((unsigned long long)cvt_pk_bf16(tv[j].z * rs2 * gg.z, tv[j].w * rs2 * gg.w) << 32); }
}
__device__ __forceinline__ void p10_row(Frame& F, int m) {
    const int lane = LANE; float* y; (void)row_x(F, m, y); if (!y) return;
    const bf16_t* t = (const bf16_t*)(wsp() + WS_GQK) + (size_t)m * DM; const GAS u32x2* tr = (const GAS u32x2*)t + lane;
    f32x4 tv[8]; float s = 0.f;
#pragma unroll
    for (int j = 0; j < 8; ++j) { const u32x2 w = tr[64 * j]; tv[j] = (f32x4){bf_lo(w[0]), bf_hi(w[0]), bf_lo(w[1]), bf_hi(w[1])}; s += (tv[j].x * tv[j].x + tv[j].y * tv[j].y) + (tv[j].z * tv[j].z + tv[j].w * tv[j].w); }
    const float rs = 1.0f / sqrtf(wave_sum(s) * (1.f / DM) + EPS);
    GAS f32x4* yr = (GAS f32x4*)y + lane; const GAS f32x4* g = (const GAS f32x4*)inp(23) + lane;
#pragma unroll
    for (int j = 0; j < 8; ++j) yr[64 * j] = yr[64 * j] + tv[j] * rs * g[64 * j];
}
#ifndef PH_MASK
#define PH_MASK 0x7ff
#endif
#ifndef MK_N_LAUNCHES
#define MK_N_LAUNCHES 1
#endif
constexpr int N_PHASES = 11;
constexpr int WGM_P1 = 4, WGM_P5 = 4, WGM_P6 = 4, WGM_P8 = 4, WGM_P9 = 4;
__global__ void __launch_bounds__(512, 2) fwd(Args args) {
    extern __shared__ __attribute__((aligned(16))) unsigned char lds[];
    Frame F;
    F.lds = (LAS unsigned char*)lds; F.MISC = (volatile LAS unsigned*)(F.lds + MISC_OFF);
    F.wave = __builtin_amdgcn_readfirstlane((int)threadIdx.x >> 6);
    F.G = gridDim.x; F.gw = blockIdx.x * 8 + F.wave; F.NGW = F.G * 8;
    for (int u = (int)threadIdx.x; u < (LDS_BYTES - RING_BYTES) / 4; u += 512) ((LAS unsigned*)(F.lds + RING_BYTES))[u] = 0u;
    __syncthreads();
    if (MK_N_LAUNCHES == 1) (void)xcd_barrier_post((unsigned*)(((gu32*)wsp()) + CW_BAR), F.MISC + 8, F.wave);
    const int lo = args.ph_lo, hi = args.ph_hi;
#define IN(k) (lo <= (k) && (k) < hi)
#define SEAM(k) do { if (IN(k) && IN((k) + 1)) { XcdBarrier bar_; bar_.bar = (unsigned*)(((gu32*)wsp()) + CW_BAR); bar_.x = xb_xcc_id(); bar_.st = F.MISC + 8; bar_.wave = F.wave; xcd_barrier(bar_); } } while (0)
    if (((PH_MASK >> 0) & 1) && IN(0)) { p0_prologue(F); } SEAM(0);
    if (((PH_MASK >> 1) & 1) && IN(1)) {
        pg8::StaticOrder S{(const bf16_t*)(outp() + O_YP), (const bf16_t*)(wsp() + WS_W1G), TP / 256, N1 / 256, F.G, (int)blockIdx.x, DM, WGM_P1};
        EpiP1 E{wsp(), outp()};
        pg8::gemm_phase<EpiP1, pg8::StaticOrder>(F.lds + RING_OFF, DM, S, E, F.wave);
    } SEAM(1);
    if (((PH_MASK >> 2) & 1) && IN(2)) {
        for (int un = blockIdx.x; un < NCHUNK * 4; un += F.G) { const int g = un >> 2, h = un & 3;
            if (g < 520 && (g % 260) < 3) continue;
            p2_unit(F, g, h); }
    } SEAM(2);
    if (((PH_MASK >> 3) & 1) && IN(3)) { p3_run(F); } SEAM(3);
    if (((PH_MASK >> 4) & 1) && IN(4)) { for (int m = F.gw; m < TP; m += F.NGW) p4_row(F, m); } SEAM(4);
    if (((PH_MASK >> 5) & 1) && IN(5)) {
        const bf16_t* U = (const bf16_t*)(outp() + O_YP);
        u32x4* sga = (u32x4*)(wsp() + WS_KB); u32x4* sgb = (u32x4*)(wsp() + WS_VB); u32x4* sp = (u32x4*)(wsp() + WS_GQK);
        { pg8::StaticOrder S{U, (const bf16_t*)(wsp() + WS_WGATE), TP / 256, 8, F.G, (int)blockIdx.x, DM, WGM_P5}; EpiGate<0> E{sga, sga, nullptr}; pg8::gemm_phase<EpiGate<0>, pg8::StaticOrder>(F.lds + RING_OFF, DM, S, E, F.wave); }
        { pg8::StaticOrder S{U, (const bf16_t*)(wsp() + WS_WGATE) + (size_t)2048 * DM, TP / 256, 8, F.G, (int)blockIdx.x, DM, WGM_P5}; EpiGate<0> E{sgb, sgb, nullptr}; pg8::gemm_phase<EpiGate<0>, pg8::StaticOrder>(F.lds + RING_OFF, DM, S, E, F.wave); }
        { pg8::StaticOrder S{(const bf16_t*)(wsp() + WS_GV), (const bf16_t*)(wsp() + WS_WBRG), TP / 256, 8, F.G, (int)blockIdx.x, DM, WGM_P5}; EpiGate<1> E{sp, sga, nullptr}; pg8::gemm_phase<EpiGate<1>, pg8::StaticOrder>(F.lds + RING_OFF, DM, S, E, F.wave); }
        { pg8::StaticOrder S{(const bf16_t*)(wsp() + WS_OD), (const bf16_t*)(wsp() + WS_WBRD), TP / 256, 8, F.G, (int)blockIdx.x, DM, WGM_P5}; EpiGate<2> E{sp, sgb, (bf16_t*)(wsp() + WS_DQ)}; pg8::gemm_phase<EpiGate<2>, pg8::StaticOrder>(F.lds + RING_OFF, DM, S, E, F.wave); }
    } SEAM(5);
    if (((PH_MASK >> 6) & 1) && IN(6)) {
        pg8::StaticOrder S{(const bf16_t*)(wsp() + WS_DQ), (const bf16_t*)(wsp() + WS_WO), TP / 256, 8, F.G, (int)blockIdx.x, DM, WGM_P6, true};
        EpiBf16<0> E{(bf16_t*)(wsp() + WS_GQK), DM};
        pg8::gemm_phase<EpiBf16<0>, pg8::StaticOrder>(F.lds + RING_OFF, DM, S, E, F.wave);
    } SEAM(6);
    if (((PH_MASK >> 7) & 1) && IN(7)) {
        for (int m = F.gw; m < TP; m += F.NGW) p7_row(F, m);
    } SEAM(7);
    if (((PH_MASK >> 8) & 1) && IN(8)) {
        pg8::StaticOrder S{(const bf16_t*)(wsp() + WS_GV), (const bf16_t*)(wsp() + WS_WFF1), TP / 256, DFF / 256, F.G, (int)blockIdx.x, DM, WGM_P8};
        EpiBf16<1> E{(bf16_t*)(wsp() + WS_DQ), DFF};
        pg8::gemm_phase<EpiBf16<1>, pg8::StaticOrder>(F.lds + RING_OFF, DM, S, E, F.wave);
    } SEAM(8);
    if (((PH_MASK >> 9) & 1) && IN(9)) {
        pg8::StaticOrder S{(const bf16_t*)(wsp() + WS_DQ), (const bf16_t*)(wsp() + WS_WFF2), TP / 256, 8, F.G, (int)blockIdx.x, DFF, WGM_P9, true};
        EpiBf16<0> E{(bf16_t*)(wsp() + WS_GQK), DM};
        pg8::gemm_phase<EpiBf16<0>, pg8::StaticOrder>(F.lds + RING_OFF, DFF, S, E, F.wave);
    } SEAM(9);
    if (((PH_MASK >> 10) & 1) && IN(10)) { for (int m = F.gw; m < TP; m += F.NGW) p10_row(F, m); }
#undef IN
#undef SEAM
}

extern "C" void kernel_launch(void* const* d_in, const int* in_sizes, int n_in, void* d_out, int out_size, void* d_ws, size_t ws_size, hipStream_t stream) {
    static int grid = 0;
    if (grid == 0) {
        if (n_in != 24 || (size_t)out_size != O_END || ws_size < WS_END) { fprintf(stderr, "kernel_launch: unexpected shapes (n_in %d out %d ws %zu)\n", n_in, out_size, ws_size); grid = -1; return; }
        int dev = 0, cus = 0, per_cu = 0;
        if (hipGetDevice(&dev) != hipSuccess || hipDeviceGetAttribute(&cus, hipDeviceAttributeMultiprocessorCount, dev) != hipSuccess) { grid = -1; return; }
        if (hipFuncSetAttribute((const void*)fwd, hipFuncAttributeMaxDynamicSharedMemorySize, LDS_BYTES) != hipSuccess) { grid = -1; return; }
        if (hipOccupancyMaxActiveBlocksPerMultiprocessor(&per_cu, (const void*)fwd, 512, LDS_BYTES) != hipSuccess || per_cu < 1) { fprintf(stderr, "kernel_launch: occupancy query says %d\n", per_cu); }
        (void)hipGetLastError();
        grid = cus > 256 ? 256 : cus;
    }
    if (grid < 0) return;
    (void)hipMemsetAsync((char*)d_ws + WS_CTL, 0, CTL_ZERO_BYTES, stream);
    Args a{};
    for (int i = 0; i < 24; ++i) a.in[i] = (const float*)d_in[i];
    a.out = (float*)d_out; a.ws = (unsigned char*)d_ws;
    if (MK_N_LAUNCHES == 1) { a.ph_lo = 0; a.ph_hi = N_PHASES; hipLaunchKernelGGL(fwd, dim3(grid), dim3(512), LDS_BYTES, stream, a); }
    else { for (int p = 0; p < N_PHASES; ++p) { a.ph_lo = p; a.ph_hi = p + 1; hipLaunchKernelGGL(fwd, dim3(grid), dim3(512), LDS_BYTES, stream, a); } }
}
```

```cpp
#include <hip/hip_runtime.h>
#include <cstdio>
#include <cstdint>

#define GAS __attribute__((address_space(1)))
#define LAS __attribute__((address_space(3)))
typedef unsigned short bf16_t;
typedef short bf16x8 __attribute__((ext_vector_type(8)));
typedef short s16x4 __attribute__((ext_vector_type(4)));
typedef float f32x4 __attribute__((ext_vector_type(4)));
typedef float f32x2 __attribute__((ext_vector_type(2)));
typedef float f32x16 __attribute__((ext_vector_type(16)));
typedef unsigned u32x4 __attribute__((ext_vector_type(4)));
typedef unsigned u32x2 __attribute__((ext_vector_type(2)));
typedef GAS unsigned gu32;

__device__ __forceinline__ unsigned cvt_pk_bf16(float lo, float hi) { unsigned r; asm volatile("v_cvt_pk_bf16_f32 %0, %1, %2" : "=v"(r) : "v"(lo), "v"(hi)); return r; }
__device__ __forceinline__ float bf_lo(unsigned w) { return __uint_as_float(w << 16); }
__device__ __forceinline__ float bf_hi(unsigned w) { return __uint_as_float(w & 0xffff0000u); }
__device__ __forceinline__ float bf2f(bf16_t b) { return __uint_as_float(((unsigned)b) << 16); }
__device__ __forceinline__ unsigned f2bf(float f) { unsigned u = __float_as_uint(f); return (u + 0x7fffu + ((u >> 16) & 1u)) >> 16; }
__device__ __forceinline__ int lane_id() { int l; asm volatile("v_mbcnt_lo_u32_b32 %0, -1, 0\n\tv_mbcnt_hi_u32_b32 %0, -1, %0" : "=v"(l) :: "memory"); return l; }
__device__ __forceinline__ float xor1(float v) { return __int_as_float(__builtin_amdgcn_update_dpp(0, __float_as_int(v), 0xB1, 0xf, 0xf, false)); }
__device__ __forceinline__ float sigmoidf_(float x) { return __builtin_amdgcn_rcpf(1.0f + __expf(-x)); }

constexpr int DM = 2048, NBATCH = 2, SEQ = 16384, NMETA = 16, LP = SEQ + NMETA;
constexpr int BS = 16640, PADR = 240;
constexpr int NSMP = 32, TSMP = 64, PAST = 1024;
constexpr int SR0 = NBATCH * BS;
constexpr int TP = SR0 + NSMP * TSMP;
constexpr int NCHUNK = TP / 64;
constexpr int DFF = 8192;
constexpr float EPS = 1e-6f;
constexpr int N1 = 12544;

constexpr size_t O_YP = 0, O_YS = 67108864, O_KP = 71303168, O_VP = 138477568, O_SP = 205651968, O_KS = 206700544, O_VS = 210894848, O_SS = 215089152, O_END = 231866368;

__host__ __device__ __forceinline__ int v_img_off(int key, int col) { const int sg = (key & 3) + 4 * ((key >> 4) & 1) + 8 * ((key >> 2) & 3);
    return ((col >> 5) * 32 + sg) * 64 + ((((col >> 4) & 1) ^ ((sg >> 2) & 1)) * 32) + (col & 15) * 2; }

namespace pg8 {
constexpr int BM = 256, BK = 64, HALF = 128, HTB = HALF * BK * 2, STAGE_BYTES = 8 * HTB, NXCD = 8;
__host__ __device__ __forceinline__ int lds_byte(int r, int c) { const int st = (r >> 4) * 2 + (c >> 5), rr = r & 15, cc = c & 31, ob = rr * 64 + cc * 2; return st * 1024 + (ob ^ (((ob >> 9) & 1) << 5)); }
__host__ __device__ __forceinline__ void stage_rc(int b, int& R, int& C) { const int st = b / 1024, sb = b % 1024, swz = sb ^ (((sb >> 9) & 1) << 5); R = (st >> 1) * 16 + swz / 64; C = (st & 1) * 32 + (swz % 64) / 2; }
__host__ __device__ __forceinline__ int perm32(int rho) { const int n = rho >> 4, i = rho & 15; return 8 * (i >> 2) + 4 * n + (i & 3); }

struct Unit { int pm, pn, sub; };
__host__ __device__ __forceinline__ size_t b_img_off(int n, int k, int K) { const int r = n & 255, rl = r & 127, g = rl & 31, R = (rl & ~31) + 16 * ((g >> 2) & 1) + 4 * (g >> 3) + (g & 3);
    return (size_t)(n >> 8) * 256 * K * 2 + (size_t)((k >> 6) * 2 + (r >> 7)) * 16384 + lds_byte(R, k & 63); }

__device__ __forceinline__ bool tile_of(long L, int nM, int nN, Unit& u, const int WGM, const bool rev = false) {
    const int nwg = nM * nN; if (L >= nwg) return false;
    int wgid = (int)L; { const int q = nwg / NXCD, r = nwg % NXCD, xcd = wgid % NXCD; int off = wgid / NXCD; if (rev) off = q + (xcd < r ? 1 : 0) - 1 - off;
      wgid = (xcd < r ? xcd * (q + 1) : r * (q + 1) + (xcd - r) * q) + off; }
    const int nig = WGM * nN, gid = wgid / nig, fm = gid * WGM, gsz = (nM - fm) < WGM ? (nM - fm) : WGM;
    u.pm = fm + ((wgid % nig) % gsz); u.pn = (wgid % nig) / gsz; u.sub = 0; return true;
}
struct StaticOrder {
    const bf16_t* A; const bf16_t* Bt; int nM, nN, G, c, K, wgm; bool rev = false;
    __device__ __forceinline__ bool next(int i, Unit& u) const { return tile_of((long)i * G + c, nM, nN, u, wgm, rev); }
    __device__ __forceinline__ void addr(const Unit& u, const char*& a, const char*& b) const { a = (const char*)A + (size_t)u.pm * 256 * K * 2; b = (const char*)Bt + (size_t)u.pn * 256 * K * 2; }
};

template <class Epi, class Sched>
__device__ __forceinline__ void gemm_phase(LAS unsigned char* lds, const int K, const Sched& S, const Epi& E, const int wid) {
    const int lane = lane_id(), tid = wid * 64 + lane, wr = wid >> 2, wc = wid & 3, fr = lane & 15, fq = lane >> 4;
    const int nt = K / BK;
    unsigned voffA[2], voffB[2];
#pragma unroll
    for (int i = 0; i < 2; ++i) { int R, C; stage_rc(tid * 16 + i * 8192, R, C); const int Rb = Epi::PERM ? ((R & ~31) + perm32(R & 31)) : R;
        voffA[i] = (unsigned)(R * K + C) * 2u; voffB[i] = (unsigned)(tid * 16 + i * 8192); (void)Rb; }
    static_assert(Epi::PERM, "the image-major B copies carry the PERM row order");
    const size_t kstepB = 32768, hstepB = 16384;
    const size_t kstep = (size_t)(BK * 2);
    const size_t hstep = (size_t)HALF * K * 2;
    const unsigned ldsw = (unsigned)wid * 1024u;
    const int aoff = lds_byte(wr * 64 + fr, fq * 8), boff = lds_byte(wc * 32 + fr, fq * 8);
#define PG8_SA(b, h) (((b) * 2 + (h)) * HTB)
#define PG8_SB(b, h) ((4 + (b) * 2 + (h)) * HTB)
#define PG8_STAGE(bufoff, gbase, voff) do { _Pragma("unroll") for (int _i = 0; _i < 2; ++_i) \
        __builtin_amdgcn_global_load_lds((const unsigned*)((const char*)(gbase) + (voff)[_i]), (LAS unsigned*)(lds + (bufoff) + ldsw + _i * 8192), 16, 0, 0); } while (0)
#define PG8_LDA(dst, b, h) do { _Pragma("unroll") for (int m = 0; m < 4; ++m) _Pragma("unroll") for (int k = 0; k < 2; ++k) dst[m][k] = *(const LAS bf16x8*)(lds + PG8_SA(b, h) + aoff + m * 2048 + k * 1024); } while (0)
#define PG8_LDB(dst, b, h) do { _Pragma("unroll") for (int n = 0; n < 2; ++n) _Pragma("unroll") for (int k = 0; k < 2; ++k) dst[n][k] = *(const LAS bf16x8*)(lds + PG8_SB(b, h) + boff + n * 2048 + k * 1024); } while (0)
#define PG8_MMA(ai, bj, At, Bt) do { __builtin_amdgcn_s_setprio(1); _Pragma("unroll") for (int m = 0; m < 4; ++m) _Pragma("unroll") for (int n = 0; n < 2; ++n) _Pragma("unroll") for (int k = 0; k < 2; ++k) \
        acc[ai][bj][m][n] = __builtin_amdgcn_mfma_f32_16x16x32_bf16(Bt[n][k], At[m][k], acc[ai][bj][m][n], 0, 0, 0); __builtin_amdgcn_s_setprio(0); } while (0)
#define PG8_WAIT_V(n) asm volatile("s_waitcnt vmcnt(" #n ")" ::: "memory")
#define PG8_WAIT_L(n) asm volatile("s_waitcnt lgkmcnt(" #n ")" ::: "memory")
#define PG8_BAR __builtin_amdgcn_s_barrier()
#define PG8_SCHED __builtin_amdgcn_sched_barrier(0)
    Unit cur, nxt; int ui = 0;
    if (!S.next(0, cur)) return;
    f32x4 acc[2][2][4][2];
#pragma unroll
    for (int a = 0; a < 2; ++a)
#pragma unroll
        for (int b = 0; b < 2; ++b)
#pragma unroll
            for (int m = 0; m < 4; ++m)
#pragma unroll
                for (int n = 0; n < 2; ++n) acc[a][b][m][n] = (f32x4){0.f, 0.f, 0.f, 0.f};
    bf16x8 At[4][2], B0[2][2], B1[2][2];
    const char* cA; const char* cB; S.addr(cur, cA, cB);
    PG8_STAGE(PG8_SB(0, 0), cB, voffB); PG8_STAGE(PG8_SB(0, 1), cB + hstepB, voffB); PG8_STAGE(PG8_SA(0, 0), cA, voffA); PG8_STAGE(PG8_SA(0, 1), cA + hstep, voffA);
    if (wr == 1) PG8_BAR;
    PG8_WAIT_V(2); PG8_BAR;
    PG8_STAGE(PG8_SB(1, 0), cB + kstepB, voffB); PG8_STAGE(PG8_SA(1, 0), cA + kstep, voffA); PG8_STAGE(PG8_SB(1, 1), cB + hstepB + kstepB, voffB);
    PG8_WAIT_V(6); PG8_BAR;
    for (;;) {
        const bool has_next = S.next(ui + 1, nxt);
        const char* nA = cA; const char* nB = cB; if (has_next) S.addr(nxt, nA, nB);
        for (int t = 0; t < nt; t += 2) {
            const bool last = (t == nt - 2);
            const char* a1 = cA + (size_t)(t + 1) * kstep;
            const char* a2 = last ? nA : cA + (size_t)(t + 2) * kstep; const char* b2 = last ? nB : cB + (size_t)(t + 2) * kstepB;
            const char* a3 = a2 + kstep; const char* b3 = b2 + kstepB;
            PG8_LDB(B0, 0, 0); PG8_LDB(B1, 0, 1); PG8_SCHED; PG8_LDA(At, 0, 0); PG8_STAGE(PG8_SA(1, 1), a1 + hstep, voffA);
            PG8_WAIT_V(8); PG8_WAIT_L(0); PG8_BAR; PG8_MMA(0, 0, At, B0); PG8_MMA(0, 1, At, B1); PG8_BAR; PG8_SCHED;
            PG8_LDA(At, 0, 1); PG8_STAGE(PG8_SB(0, 0), b2, voffB); PG8_STAGE(PG8_SB(0, 1), b2 + hstepB, voffB); PG8_STAGE(PG8_SA(0, 0), a2, voffA);
            PG8_WAIT_V(8); PG8_WAIT_L(0); PG8_BAR; PG8_MMA(1, 0, At, B0); PG8_MMA(1, 1, At, B1); PG8_BAR; PG8_SCHED;
            PG8_LDB(B0, 1, 0); PG8_LDB(B1, 1, 1); PG8_SCHED; PG8_LDA(At, 1, 0); PG8_STAGE(PG8_SA(0, 1), a2 + hstep, voffA);
            PG8_WAIT_V(8); PG8_WAIT_L(0); PG8_BAR; PG8_MMA(0, 0, At, B0); PG8_MMA(0, 1, At, B1); PG8_BAR; PG8_SCHED;
            PG8_LDA(At, 1, 1); PG8_STAGE(PG8_SB(1, 0), b3, voffB); PG8_STAGE(PG8_SB(1, 1), b3 + hstepB, voffB); PG8_STAGE(PG8_SA(1, 0), a3, voffA);
            PG8_WAIT_V(8); PG8_WAIT_L(0); PG8_BAR; PG8_MMA(1, 0, At, B0); PG8_MMA(1, 1, At, B1); PG8_BAR; PG8_SCHED;
        }
        if (wr == 0) PG8_BAR;
        const bool keep = E(acc, cur, wr, wc, fr, fq);
        if (!has_next) break;
        if (!keep) {
#pragma unroll
        for (int a = 0; a < 2; ++a)
#pragma unroll
            for (int b = 0; b < 2; ++b)
#pragma unroll
                for (int m = 0; m < 4; ++m)
#pragma unroll
                    for (int n = 0; n < 2; ++n) acc[a][b][m][n] = (f32x4){0.f, 0.f, 0.f, 0.f};
        }
        cur = nxt; cA = nA; cB = nB; ++ui;
        if (wr == 1) PG8_BAR;
    }
    PG8_WAIT_V(0);
    PG8_BAR;
#undef PG8_SA
#undef PG8_SB
#undef PG8_STAGE
#undef PG8_LDA
#undef PG8_LDB
#undef PG8_MMA
#undef PG8_WAIT_V
#undef PG8_WAIT_L
#undef PG8_BAR
#undef PG8_SCHED
}
}
namespace att {
constexpr float SCALE = 0.08838834764831845f;
constexpr float THR = 8.f;
constexpr int NW = 8, QBLK = 32, KVBLK = 64, QB = NW * QBLK, D = 128, PITCH = 2048;
constexpr int SHM_V = KVBLK * D * 2, SHM_K = KVBLK * D * 2;
constexpr int LDS_BYTES = 2 * SHM_V + 2 * SHM_K + NW * 64 * 4;

#define KSWZ(row, colB) ((row) * 256 + ((colB) ^ (((row) & 7) << 4)))
#define SBAR() __builtin_amdgcn_sched_barrier(0)
__device__ __forceinline__ int v_st(int k, int c) { const int kk = (k & ~0xC) | ((k & 4) << 1) | ((k & 8) >> 1); return ((kk >> 3) * 4 + (c >> 5)) * 512 + ((kk & 7) * 32 + (c & 31)) * 2; }
__device__ __forceinline__ int v_rd_base(int lane) { return ((lane & 3) << 3) | (((lane >> 2) & 3) << 6) | (((lane >> 4) & 1) << 5) | (((lane >> 5) & 1) << 8); }
constexpr int v_rd_off(int d0, int ks, int half) { return d0 * 512 + ks * 4096 + half * 2048; }
__device__ __forceinline__ int crow(int r, int hi) { return (r & 3) + 8 * (r >> 2) + 4 * hi; }
__device__ __forceinline__ bf16x8 load8(const bf16_t* p) { return *reinterpret_cast<const bf16x8*>(p); }

__device__ __forceinline__ void mask_tile_bc(f32x16& p0, f32x16& p1, bool all) {
    const float NEG = -__builtin_inff();
#pragma unroll
    for (int r = 0; r < 16; ++r) { p0[r] = NEG; if (r < 8) p1[r] = NEG; else p1[r] = all ? NEG : p1[r]; }
}
__device__ __forceinline__ void partialSM(f32x16& p0, f32x16& p1, float& m_reg, float& mn, float& alpha) {
    float pmax = p0[0]; for (int r = 1; r < 16; ++r) pmax = fmaxf(pmax, p0[r]); for (int r = 0; r < 16; ++r) pmax = fmaxf(pmax, p1[r]);
    { auto rr = __builtin_amdgcn_permlane32_swap(__float_as_uint(pmax), __float_as_uint(pmax), false, false);
      pmax = fmaxf(__uint_as_float(rr[0]), __uint_as_float(rr[1])); }
    constexpr float C2 = 1.4426950408889634f * SCALE;
    if (__builtin_expect(__all((pmax - m_reg) * SCALE <= THR), 1)) { mn = m_reg; alpha = 1.f; }
    else { mn = fmaxf(m_reg, pmax); alpha = __builtin_amdgcn_exp2f((m_reg - mn) * C2); m_reg = mn; }
    const float mnL = -mn * C2;
    for (int r = 0; r < 16; ++r) p0[r] = fmaf(p0[r], C2, mnL); for (int r = 0; r < 16; ++r) p1[r] = fmaf(p1[r], C2, mnL);
    for (int r = 0; r < 16; ++r) p0[r] = __builtin_amdgcn_exp2f(p0[r]);
}
__device__ __forceinline__ void finishSM(f32x16& p0, f32x16& p1, float alpha, float& l_reg, bf16x8& pa0, bf16x8& pa1, bf16x8& pa2, bf16x8& pa3) {
    for (int r = 0; r < 16; ++r) p1[r] = __builtin_amdgcn_exp2f(p1[r]);
    float ps = 0; for (int r = 0; r < 16; ++r) ps += p0[r]; for (int r = 0; r < 16; ++r) ps += p1[r];
    { auto rr = __builtin_amdgcn_permlane32_swap(__float_as_uint(ps), __float_as_uint(ps), false, false);
      ps = __uint_as_float(rr[0]) + __uint_as_float(rr[1]); }
    l_reg = l_reg * alpha + ps;
#define PK4(P, B_, OUT) do { unsigned a0 = cvt_pk_bf16(P[B_+0], P[B_+1]), a1 = cvt_pk_bf16(P[B_+2], P[B_+3]);                          \
        unsigned b0 = cvt_pk_bf16(P[B_+4], P[B_+5]), b1 = cvt_pk_bf16(P[B_+6], P[B_+7]);                                             \
        auto r0 = __builtin_amdgcn_permlane32_swap(a0, b0, false, false); auto r1 = __builtin_amdgcn_permlane32_swap(a1, b1, false, false); \
        u32x4 w = {r0[0], r1[0], r0[1], r1[1]}; OUT = *reinterpret_cast<bf16x8*>(&w); } while (0)
    PK4(p0, 0, pa0); PK4(p0, 8, pa1); PK4(p1, 0, pa2); PK4(p1, 8, pa3);
#undef PK4
}
template <int KB>
__device__ __forceinline__ void qkt(f32x16& p0, f32x16& p1, const char* K_lds, int r32, int hi, const bf16x8* qr, bool act) {
    if (!act) { const float NEG = -__builtin_inff();
#pragma unroll
        for (int r = 0; r < 16; ++r) { p0[r] = NEG; p1[r] = NEG; } return; }
    p0 = f32x16{}; p1 = f32x16{};
    const char* kb[4];
#pragma unroll
    for (int dd = 0; dd < 4; ++dd) kb[dd] = K_lds + KB * SHM_K + KSWZ(r32, (dd * 16 + hi * 8) * 2);
#pragma unroll
    for (int d0 = 0; d0 < 8; ++d0) { const char* a = kb[d0 & 3] + (d0 >> 2) * 128;
        bf16x8 b0 = *reinterpret_cast<const bf16x8*>(a);
        bf16x8 b1 = *reinterpret_cast<const bf16x8*>(a + 32 * 256);
        p0 = __builtin_amdgcn_mfma_f32_32x32x16_bf16(b0, qr[d0], p0, 0, 0, 0);
        p1 = __builtin_amdgcn_mfma_f32_32x32x16_bf16(b1, qr[d0], p1, 0, 0, 0); }
}
template <int VB>
__device__ __forceinline__ void pv_tile(f32x16* o, int vb0, bf16x8 pa0, bf16x8 pa1, bf16x8 pa2, bf16x8 pa3, bool act) {
    if (!act) return;
#define TRRD(dst, off) asm volatile("ds_read_b64_tr_b16 %0, %1 offset:%2" : "=&v"(dst) : "v"(vb0), "i"(off) : "memory")
#define PV_D0(d0) do { s16x4 l0, l1, l2, l3, h0, h1, h2, h3; constexpr int b_ = VB * SHM_V + v_rd_off(d0, 0, 0); \
        TRRD(l0, b_); TRRD(h0, b_ + 2048); TRRD(l1, b_ + 4096); TRRD(h1, b_ + 6144); TRRD(l2, b_ + 8192); TRRD(h2, b_ + 10240); TRRD(l3, b_ + 12288); TRRD(h3, b_ + 14336); \
        asm volatile("s_waitcnt lgkmcnt(0)" ::: "memory"); SBAR(); \
        o[d0] = __builtin_amdgcn_mfma_f32_32x32x16_bf16(pa0, (bf16x8){l0[0], l0[1], l0[2], l0[3], h0[0], h0[1], h0[2], h0[3]}, o[d0], 0, 0, 0);   \
        o[d0] = __builtin_amdgcn_mfma_f32_32x32x16_bf16(pa1, (bf16x8){l1[0], l1[1], l1[2], l1[3], h1[0], h1[1], h1[2], h1[3]}, o[d0], 0, 0, 0);   \
        o[d0] = __builtin_amdgcn_mfma_f32_32x32x16_bf16(pa2, (bf16x8){l2[0], l2[1], l2[2], l2[3], h2[0], h2[1], h2[2], h2[3]}, o[d0], 0, 0, 0);   \
        o[d0] = __builtin_amdgcn_mfma_f32_32x32x16_bf16(pa3, (bf16x8){l3[0], l3[1], l3[2], l3[3], h3[0], h3[1], h3[2], h3[3]}, o[d0], 0, 0, 0); } while (0)
    PV_D0(0); PV_D0(1); PV_D0(2); PV_D0(3);
#undef PV_D0
#undef TRRD
}

struct BlockRef { const bf16_t* Q; const bf16_t* K; const bf16_t* V; int jlo, jhi, lastbase, first; };
struct Seam { bf16x8 qr[8]; bf16x8 st_v0, st_v1, st_k0, st_k1; };
#define ROW(p, k0, rr) ((p) + (size_t)((k0) + (rr)) * PITCH + sc)
#define VMW() asm volatile("s_waitcnt vmcnt(0)" ::: "memory")
#define VMWN(n) asm volatile("s_waitcnt vmcnt(%0)" :: "i"(n) : "memory")
#define SLOAD_H(Kp, Vp, k0) do { S.st_v0 = load8(ROW(Vp, k0, sr)); S.st_v1 = load8(ROW(Vp, k0, 32 + sr));              \
                         S.st_k0 = load8(ROW(Kp, k0, sr)); S.st_k1 = load8(ROW(Kp, k0, 32 + sr)); } while (0)
#define SWRITE_HK(bf) do { *(bf16x8*)(K_lds + (bf) * SHM_K + kws) = S.st_k0; *(bf16x8*)(K_lds + (bf) * SHM_K + kws + 32 * 256) = S.st_k1; } while (0)
#define SWRITE_HV(bf) do { *(bf16x8*)(V_lds + (bf) * SHM_V + vst0) = S.st_v0; *(bf16x8*)(V_lds + (bf) * SHM_V + vst1) = S.st_v1; } while (0)
#define SWRITE_H(bf) do { SWRITE_HV(bf); SWRITE_HK(bf); } while (0)
__device__ __forceinline__ void attn_prime(const BlockRef& cur, char* lds, Seam& S, const int wid) {
    int lane = lane_id(); asm volatile("" : "+v"(lane));
    const int tid = wid * 64 + lane, r32 = lane & 31, hi = lane >> 5;
    const int sr = tid >> 4, sc = (tid & 15) * 8, kws = KSWZ(sr, sc * 2); char* K_lds = lds + 2 * SHM_V;
    const int kb0 = cur.jlo * KVBLK;
    for (int d0 = 0; d0 < 8; ++d0) S.qr[d0] = load8(cur.Q + (size_t)(wid * QBLK + r32) * PITCH + d0 * 16 + hi * 8);
    SLOAD_H(cur.K, cur.V, kb0); VMW(); SWRITE_HK(0);
    __syncthreads();
}
__device__ __forceinline__ void attn_block(const int MODE, const BlockRef& cur, const BlockRef& nxt, char* lds, Seam& S, float* stash, bf16_t* Oout, float lam, const int wid) {
    int lane = lane_id(); asm volatile("" : "+v"(lane));
    const int tid = wid * 64 + lane, r32 = lane & 31, hi = lane >> 5;
    const int j_lo = cur.jlo, j_hi = cur.jhi;
    const int NT = j_hi - j_lo;
    const int kbn = nxt.jlo * KVBLK;
    const int lastw = cur.first ? cur.lastbase : cur.lastbase + (wid >> 1);
    char* V_lds = lds; char* K_lds = lds + 2 * SHM_V;
    float* ws = (float*)(lds + 2 * SHM_V + 2 * SHM_K) + wid * 64; float* li_l = ws, * al_l = ws + 32;
    float m_reg = -1e30f, l_reg = 0; f32x16 o[4] = {};
    const int sr = tid >> 4, sc = (tid & 15) * 8, vst0 = v_st(sr, sc), vst1 = v_st(32 + sr, sc), kws = KSWZ(sr, sc * 2);
    const int vb0 = (int)(uintptr_t)V_lds + v_rd_base(lane);
    const bf16_t* Kh = cur.K; const bf16_t* Vh = cur.V;
#define RESC(a) do { if (__any((a) < 1.f)) { if (hi == 0) al_l[r32] = (a); asm volatile("s_waitcnt lgkmcnt(0)" ::: "memory");              \
                     for (int d_ = 0; d_ < 4; ++d_) for (int r = 0; r < 16; ++r) o[d_][r] *= al_l[crow(r, hi)]; } } while (0)
#define KBASE(t) ((j_lo + (t)) * KVBLK)
#define ACT(t) true
#define MASKT(P0_, P1_, t) do { const int jt_ = j_lo + (t); if (jt_ == 3 || jt_ > lastw) mask_tile_bc(P0_, P1_, jt_ > lastw); } while (0)
    constexpr int NQL = 8;
#define SEAM_K0() do { VMWN(NQL); SWRITE_HK(0); SBAR(); } while (0)
    f32x16 pA0, pA1, pB0, pB1; float mnA, mnB, alA, alB; bf16x8 pa0, pa1, pa2, pa3;
    SWRITE_HV(0); SBAR();
    if (NT > 1) { SLOAD_H(Kh, Vh, KBASE(1)); }
    SBAR(); qkt<0>(pA0, pA1, K_lds, r32, hi, S.qr, ACT(0));
    MASKT(pA0, pA1, 0); partialSM(pA0, pA1, m_reg, mnA, alA);
    if (NT > 1) { VMW(); SWRITE_H(1); }
    __syncthreads();
#define HALF_STEP(PX0, PX1, mnX, alX, PY0, PY1, alY, t, KB, VB, SB) do {                                                      \
        SBAR(); qkt<KB>(PX0, PX1, K_lds, r32, hi, S.qr, ACT(t));                                             \
        finishSM(PY0, PY1, alY, l_reg, pa0, pa1, pa2, pa3); SBAR();                                                           \
        if ((t) + 1 < NT) { SLOAD_H(Kh, Vh, KBASE((t) + 1)); SBAR(); }                                               \
        pv_tile<VB>(o, vb0, pa0, pa1, pa2, pa3, ACT((t) - 1)); MASKT(PX0, PX1, (t)); partialSM(PX0, PX1, m_reg, mnX, alX);                                        \
        __syncthreads();                                                                                                      \
        if ((t) + 1 < NT) { VMW(); SWRITE_H(SB); }                                                                          \
        RESC(alX); __syncthreads(); } while (0)
    for (int t = 1; t + 1 < NT; t += 2) {
        HALF_STEP(pB0, pB1, mnB, alB, pA0, pA1, alA, t, 1, 0, 0);
        HALF_STEP(pA0, pA1, mnA, alA, pB0, pB1, alB, t + 1, 0, 1, 1);
    }
    const bool even = (NT & 1) == 0;
    if (even) { SBAR(); qkt<1>(pB0, pB1, K_lds, r32, hi, S.qr, ACT(NT - 1)); SBAR(); }
    SLOAD_H(nxt.K, nxt.V, kbn); SBAR();
#pragma unroll
    for (int d0 = 0; d0 < 8; ++d0) S.qr[d0] = load8(nxt.Q + (size_t)(wid * QBLK + r32) * PITCH + d0 * 16 + hi * 8);
    SBAR();
    finishSM(pA0, pA1, alA, l_reg, pa0, pa1, pa2, pa3); SBAR();
    pv_tile<0>(o, vb0, pa0, pa1, pa2, pa3, ACT(even ? NT - 2 : NT - 1));
    if (even) { MASKT(pB0, pB1, NT - 1); partialSM(pB0, pB1, m_reg, mnB, alB); __syncthreads(); RESC(alB);
        finishSM(pB0, pB1, alB, l_reg, pa0, pa1, pa2, pa3); SBAR(); pv_tile<1>(o, vb0, pa0, pa1, pa2, pa3, ACT(NT - 1)); }
    SBAR(); SEAM_K0();
    if (hi == 0) li_l[r32] = l_reg; asm volatile("s_waitcnt lgkmcnt(0)" ::: "memory");
    int hie = hi; asm volatile("" : "+v"(hie));
    float rli[16];
#pragma unroll
    for (int r = 0; r < 16; ++r) rli[r] = __builtin_amdgcn_rcpf(li_l[crow(r, hie)]);
    if (MODE == 0) {
        float* Ow = stash + (wid * QBLK + 4 * hie) * D + r32;
#pragma unroll
        for (int r = 0; r < 16; ++r) {
#pragma unroll
            for (int d0 = 0; d0 < 4; ++d0) Ow[((r & 3) + 8 * (r >> 2)) * D + d0 * 32] = o[d0][r] * rli[r]; }
    } else {
        const float* Sw = stash + (wid * QBLK + 4 * hie) * D + r32;
        bf16_t* Ow = Oout + (size_t)((wid * QBLK + 4 * hie) * PITCH + r32);
#pragma unroll
        for (int rg = 0; rg < 4; ++rg) {
            float sv[4][4];
#pragma unroll
            for (int rr = 0; rr < 4; ++rr)
#pragma unroll
                for (int d0 = 0; d0 < 4; ++d0) sv[rr][d0] = Sw[(rr + 8 * rg) * D + d0 * 32];
#pragma unroll
            for (int rr = 0; rr < 4; ++rr) { const int r = 4 * rg + rr;
#pragma unroll
                for (int d0 = 0; d0 < 4; ++d0) { const float v = sv[rr][d0] - lam * (o[d0][r] * rli[r]);
                    const float vn = xor1(v);
                    if ((r32 & 1) == 0) *(unsigned*)(Ow + (rr + 8 * rg) * PITCH + d0 * 32) = cvt_pk_bf16(v, vn); } }
            SBAR(); }
    }
    __syncthreads();
#undef RESC
#undef KBASE
#undef ACT
#undef MASKT
#undef SEAM_K0
#undef HALF_STEP
}
#undef ROW
#undef VMWN
#undef SLOAD_H
#undef SWRITE_HK
#undef SWRITE_HV
#undef SWRITE_H
}
namespace att2 {
using att::crow; using att::load8; using att::v_rd_base; using att::SCALE; using att::THR;
constexpr int NW = 8, QBLK = 32, KV = 32, PITCH = 2048, DV = 256;
constexpr int SHM_V = KV * DV * 2, SHM_K = KV * 128 * 2;
constexpr int OFF_K = 2 * SHM_V, OFF_S = OFF_K + 2 * SHM_K, LDS_BYTES = OFF_S + NW * 64 * 4;
__device__ __forceinline__ int v_st(int k, int c) { const int kk = (k & ~0xC) | ((k & 4) << 1) | ((k & 8) >> 1); return ((kk >> 3) * 8 + (c >> 5)) * 512 + ((kk & 7) * 32 + (c & 31)) * 2; }
constexpr int v_rd_off(int d0, int ks, int half) { return d0 * 512 + ks * 8192 + half * 4096; }

__device__ __forceinline__ void mask1(f32x16& p, bool all) {
    const float NEG = -__builtin_inff();
#pragma unroll
    for (int r = 0; r < 16; ++r) { if (r < 8) p[r] = NEG; else p[r] = all ? NEG : p[r]; }
}
__device__ __forceinline__ void partialSM(f32x16& p, float& m_reg, float& mn, float& alpha) {
    float pmax = p[0]; for (int r = 1; r < 16; ++r) pmax = fmaxf(pmax, p[r]);
    { auto rr = __builtin_amdgcn_permlane32_swap(__float_as_uint(pmax), __float_as_uint(pmax), false, false);
      pmax = fmaxf(__uint_as_float(rr[0]), __uint_as_float(rr[1])); }
    constexpr float C2 = 1.4426950408889634f * SCALE;
    if (__builtin_expect(__all((pmax - m_reg) * SCALE <= THR), 1)) { mn = m_reg; alpha = 1.f; }
    else { mn = fmaxf(m_reg, pmax); alpha = __builtin_amdgcn_exp2f((m_reg - mn) * C2); m_reg = mn; }
    const float mnL = -mn * C2;
    for (int r = 0; r < 16; ++r) p[r] = fmaf(p[r], C2, mnL);
    for (int r = 0; r < 8; ++r) p[r] = __builtin_amdgcn_exp2f(p[r]);
}
__device__ __forceinline__ void finishSM(f32x16& p, float alpha, float& l_reg, bf16x8& pa0, bf16x8& pa1) {
    for (int r = 8; r < 16; ++r) p[r] = __builtin_amdgcn_exp2f(p[r]);
    float ps = 0; for (int r = 0; r < 16; ++r) ps += p[r];
    { auto rr = __builtin_amdgcn_permlane32_swap(__float_as_uint(ps), __float_as_uint(ps), false, false);
      ps = __uint_as_float(rr[0]) + __uint_as_float(rr[1]); }
    l_reg = l_reg * alpha + ps;
#define PK4(P, B_, OUT) do { unsigned a0 = cvt_pk_bf16(P[B_+0], P[B_+1]), a1 = cvt_pk_bf16(P[B_+2], P[B_+3]);                          \
        unsigned b0 = cvt_pk_bf16(P[B_+4], P[B_+5]), b1 = cvt_pk_bf16(P[B_+6], P[B_+7]);                                             \
        auto r0 = __builtin_amdgcn_permlane32_swap(a0, b0, false, false); auto r1 = __builtin_amdgcn_permlane32_swap(a1, b1, false, false); \
        u32x4 w = {r0[0], r1[0], r0[1], r1[1]}; OUT = *reinterpret_cast<bf16x8*>(&w); } while (0)
    PK4(p, 0, pa0); PK4(p, 8, pa1);
#undef PK4
}
template <int KB>
__device__ __forceinline__ void qkt(f32x16& p, const char* K_lds, int r32, int hi, const bf16x8* qr) {
    p = f32x16{};
    const char* kb[4];
#pragma unroll
    for (int dd = 0; dd < 4; ++dd) kb[dd] = K_lds + KB * SHM_K + KSWZ(r32, (dd * 16 + hi * 8) * 2);
#pragma unroll
    for (int d0 = 0; d0 < 8; ++d0) { const bf16x8 b0 = *reinterpret_cast<const bf16x8*>(kb[d0 & 3] + (d0 >> 2) * 128);
        p = __builtin_amdgcn_mfma_f32_32x32x16_bf16(b0, qr[d0], p, 0, 0, 0); }
}
template <int VB>
__device__ __forceinline__ void pv_tile(f32x16* o, int vb0, bf16x8 pa0, bf16x8 pa1) {
#define TRRD(dst, off) asm volatile("ds_read_b64_tr_b16 %0, %1 offset:%2" : "=&v"(dst) : "v"(vb0), "i"(off) : "memory")
#define PV_D0(d0) do { s16x4 l0, l1, h0, h1; constexpr int b_ = VB * SHM_V + v_rd_off(d0, 0, 0); \
        TRRD(l0, b_); TRRD(h0, b_ + 4096); TRRD(l1, b_ + 8192); TRRD(h1, b_ + 12288); \
        asm volatile("s_waitcnt lgkmcnt(0)" ::: "memory"); SBAR(); \
        o[d0] = __builtin_amdgcn_mfma_f32_32x32x16_bf16(pa0, (bf16x8){l0[0], l0[1], l0[2], l0[3], h0[0], h0[1], h0[2], h0[3]}, o[d0], 0, 0, 0);   \
        o[d0] = __builtin_amdgcn_mfma_f32_32x32x16_bf16(pa1, (bf16x8){l1[0], l1[1], l1[2], l1[3], h1[0], h1[1], h1[2], h1[3]}, o[d0], 0, 0, 0); } while (0)
    PV_D0(0); PV_D0(1); PV_D0(2); PV_D0(3); PV_D0(4); PV_D0(5); PV_D0(6); PV_D0(7);
#undef PV_D0
#undef TRRD
}
template <int VB>
__device__ __forceinline__ void pv_partial(f32x16* o, int vb0, bf16x8 pa0, bf16x8 pa1, f32x16& p, float& m_reg, float& mn, float& alpha) {
#define TRRD(dst, off) asm volatile("ds_read_b64_tr_b16 %0, %1 offset:%2" : "=&v"(dst) : "v"(vb0), "i"(off) : "memory")
#define PV_D0(d0) do { s16x4 l0, l1, h0, h1; constexpr int b_ = VB * SHM_V + v_rd_off(d0, 0, 0); \
        TRRD(l0, b_); TRRD(h0, b_ + 4096); TRRD(l1, b_ + 8192); TRRD(h1, b_ + 12288); \
        asm volatile("s_waitcnt lgkmcnt(0)" ::: "memory"); SBAR(); \
        o[d0] = __builtin_amdgcn_mfma_f32_32x32x16_bf16(pa0, (bf16x8){l0[0], l0[1], l0[2], l0[3], h0[0], h0[1], h0[2], h0[3]}, o[d0], 0, 0, 0);   \
        o[d0] = __builtin_amdgcn_mfma_f32_32x32x16_bf16(pa1, (bf16x8){l1[0], l1[1], l1[2], l1[3], h1[0], h1[1], h1[2], h1[3]}, o[d0], 0, 0, 0); } while (0)
    constexpr float C2 = 1.4426950408889634f * SCALE;
    PV_D0(0); float pmax = fmaxf(fmaxf(p[0], p[1]), fmaxf(p[2], p[3]));
    PV_D0(1); pmax = fmaxf(pmax, fmaxf(fmaxf(p[4], p[5]), fmaxf(p[6], p[7])));
    PV_D0(2); pmax = fmaxf(pmax, fmaxf(fmaxf(p[8], p[9]), fmaxf(p[10], p[11])));
    PV_D0(3); pmax = fmaxf(pmax, fmaxf(fmaxf(p[12], p[13]), fmaxf(p[14], p[15])));
    { auto rr = __builtin_amdgcn_permlane32_swap(__float_as_uint(pmax), __float_as_uint(pmax), false, false); pmax = fmaxf(__uint_as_float(rr[0]), __uint_as_float(rr[1])); }
    PV_D0(4);
    if (__builtin_expect(__all((pmax - m_reg) * SCALE <= THR), 1)) { mn = m_reg; alpha = 1.f; }
    else { mn = fmaxf(m_reg, pmax); alpha = __builtin_amdgcn_exp2f((m_reg - mn) * C2); m_reg = mn; }
    const float mnL = -mn * C2;
    PV_D0(5);
#pragma unroll
    for (int r = 0; r < 8; ++r) p[r] = fmaf(p[r], C2, mnL);
    PV_D0(6);
#pragma unroll
    for (int r = 8; r < 16; ++r) p[r] = fmaf(p[r], C2, mnL);
#pragma unroll
    for (int r = 0; r < 4; ++r) p[r] = __builtin_amdgcn_exp2f(p[r]);
    PV_D0(7);
#pragma unroll
    for (int r = 4; r < 8; ++r) p[r] = __builtin_amdgcn_exp2f(p[r]);
#undef PV_D0
#undef TRRD
}
struct BlockRef { const bf16_t* Q; const bf16_t* K; const bf16_t* V; int jlo, jhi, lastbase, first; };
struct Seam { bf16x8 qr[8]; bf16x8 st_v0, st_v1, st_k; };
#define ROW2(p, k0) ((p) + (size_t)((k0) + sr) * PITCH + sc)
#define VMW() asm volatile("s_waitcnt vmcnt(0)" ::: "memory")
#define VMWN(n) asm volatile("s_waitcnt vmcnt(%0)" :: "i"(n) : "memory")
#define SLOAD2(Kp, Vp, k0) do { S.st_v0 = load8(ROW2(Vp, k0)); S.st_v1 = load8(ROW2(Vp, k0) + 128); S.st_k = load8(ROW2(Kp, k0)); } while (0)
#define SWRITE2K(bf) do { *(bf16x8*)(K_lds + (bf) * SHM_K + kws) = S.st_k; } while (0)
#define SWRITE2V(bf) do { *(bf16x8*)(V_lds + (bf) * SHM_V + vst0) = S.st_v0; *(bf16x8*)(V_lds + (bf) * SHM_V + vst1) = S.st_v1; } while (0)
#define SWRITE2(bf) do { SWRITE2V(bf); SWRITE2K(bf); } while (0)
__device__ __forceinline__ void attn_prime(const BlockRef& cur, char* lds, Seam& S, const int wid) {
    int lane = lane_id(); asm volatile("" : "+v"(lane));
    const int tid = wid * 64 + lane, r32 = lane & 31, hi = lane >> 5;
    const int sr = tid >> 4, sc = (tid & 15) * 8, kws = KSWZ(sr, sc * 2); char* K_lds = lds + OFF_K;
    const int kb0 = cur.jlo * KV;
    for (int d0 = 0; d0 < 8; ++d0) S.qr[d0] = load8(cur.Q + (size_t)(wid * QBLK + r32) * PITCH + d0 * 16 + hi * 8);
    SLOAD2(cur.K, cur.V, kb0); VMW(); SWRITE2K(0);
    __syncthreads();
}
__device__ __forceinline__ void attn_block(const int MODE, const BlockRef& cur, const BlockRef& nxt, char* lds, Seam& S, float* stash, bf16_t* Oout, float lam, const int wid) {
    int lane = lane_id(); asm volatile("" : "+v"(lane));
    const int tid = wid * 64 + lane, r32 = lane & 31, hi = lane >> 5;
    const int j_lo = cur.jlo, NT = cur.jhi - cur.jlo;
    const int kbn = nxt.jlo * KV;
    const int lastw = cur.first ? cur.lastbase : cur.lastbase + 2 * (wid >> 1);
    char* V_lds = lds; char* K_lds = lds + OFF_K;
    float* ws = (float*)(lds + OFF_S) + wid * 64; float* li_l = ws, * al_l = ws + 32;
    float m_reg = -1e30f, l_reg = 0; f32x16 o[8] = {};
    const int sr = tid >> 4, sc = (tid & 15) * 8, vst0 = v_st(sr, sc), vst1 = v_st(sr, sc + 128), kws = KSWZ(sr, sc * 2);
    const int vb0 = (int)(uintptr_t)V_lds + v_rd_base(lane);
    const bf16_t* Kh = cur.K; const bf16_t* Vh = cur.V;
#define RESC(a) do { if (__any((a) < 1.f)) { if (hi == 0) al_l[r32] = (a); asm volatile("s_waitcnt lgkmcnt(0)" ::: "memory");              \
                     for (int d_ = 0; d_ < 8; ++d_) for (int r = 0; r < 16; ++r) o[d_][r] *= al_l[crow(r, hi)]; } } while (0)
#define KBASE(t) ((j_lo + (t)) * KV)
#define MASKT(P_, t) do { const int jt_ = j_lo + (t); if (jt_ == 7 || jt_ > lastw) mask1(P_, jt_ > lastw); } while (0)
#define SEAM_K0() do { VMWN(8); SWRITE2K(0); SBAR(); } while (0)
    f32x16 pA, pB; float mnA, mnB, alA, alB; bf16x8 pa0, pa1;
    SWRITE2V(0); SBAR();
    if (NT > 1) { SLOAD2(Kh, Vh, KBASE(1)); }
    SBAR(); qkt<0>(pA, K_lds, r32, hi, S.qr);
    MASKT(pA, 0); partialSM(pA, m_reg, mnA, alA);
    if (NT > 1) { VMW(); SWRITE2(1); }
    __syncthreads();
#define HALF_STEP(PX, mnX, alX, PY, alY, t, KB, VB, SB) do {                                                      \
        SBAR(); qkt<KB>(PX, K_lds, r32, hi, S.qr);                                             \
        finishSM(PY, alY, l_reg, pa0, pa1); SBAR();                                                           \
        if ((t) + 1 < NT) { SLOAD2(Kh, Vh, KBASE((t) + 1)); SBAR(); }                                               \
        MASKT(PX, (t)); pv_partial<VB>(o, vb0, pa0, pa1, PX, m_reg, mnX, alX);                                        \
        __syncthreads();                                                                                                      \
        if ((t) + 1 < NT) { VMW(); SWRITE2(SB); }                                                                          \
        RESC(alX); __syncthreads(); } while (0)
    for (int t = 1; t + 1 < NT; t += 2) {
        HALF_STEP(pB, mnB, alB, pA, alA, t, 1, 0, 0);
        HALF_STEP(pA, mnA, alA, pB, alB, t + 1, 0, 1, 1);
    }
    const bool even = (NT & 1) == 0;
    if (even) { SBAR(); qkt<1>(pB, K_lds, r32, hi, S.qr); SBAR(); }
    SLOAD2(nxt.K, nxt.V, kbn); SBAR();
#pragma unroll
    for (int d0 = 0; d0 < 8; ++d0) S.qr[d0] = load8(nxt.Q + (size_t)(wid * QBLK + r32) * PITCH + d0 * 16 + hi * 8);
    SBAR();
    finishSM(pA, alA, l_reg, pa0, pa1); SBAR();
    pv_tile<0>(o, vb0, pa0, pa1);
    if (even) { MASKT(pB, NT - 1); partialSM(pB, m_reg, mnB, alB); __syncthreads(); RESC(alB);
        finishSM(pB, alB, l_reg, pa0, pa1); SBAR(); pv_tile<1>(o, vb0, pa0, pa1); }
    SBAR(); SEAM_K0();
    if (hi == 0) li_l[r32] = l_reg; asm volatile("s_waitcnt lgkmcnt(0)" ::: "memory");
    int hie = hi; asm volatile("" : "+v"(hie));
    float rli[16];
#pragma unroll
    for (int r = 0; r < 16; ++r) rli[r] = __builtin_amdgcn_rcpf(li_l[crow(r, hie)]);
    if (MODE == 0) {
        float* Ow = stash + (wid * QBLK + 4 * hie) * DV + r32;
#pragma unroll
        for (int r = 0; r < 16; ++r) {
#pragma unroll
            for (int d0 = 0; d0 < 8; ++d0) Ow[((r & 3) + 8 * (r >> 2)) * DV + d0 * 32] = o[d0][r] * rli[r]; }
    } else {
        const float* Sw = stash + (wid * QBLK + 4 * hie) * DV + r32;
        bf16_t* Ow = Oout + (size_t)((wid * QBLK + 4 * hie) * PITCH + r32);
#pragma unroll
        for (int rg = 0; rg < 8; ++rg) {
            float sv[2][8];
#pragma unroll
            for (int rr = 0; rr < 2; ++rr)
#pragma unroll
                for (int d0 = 0; d0 < 8; ++d0) sv[rr][d0] = Sw[((2 * rg + rr) & 3) * DV + 8 * ((2 * rg + rr) >> 2) * DV + d0 * 32];
#pragma unroll
            for (int rr = 0; rr < 2; ++rr) { const int r = 2 * rg + rr;
#pragma unroll
                for (int d0 = 0; d0 < 8; ++d0) { const float v = sv[rr][d0] - lam * (o[d0][r] * rli[r]);
                    const float vn = xor1(v);
                    if ((r32 & 1) == 0) *(unsigned*)(Ow + ((r & 3) + 8 * (r >> 2)) * PITCH + d0 * 32) = cvt_pk_bf16(v, vn); } }
            SBAR(); }
    }
    __syncthreads();
#undef RESC
#undef KBASE
#undef MASKT
#undef SEAM_K0
#undef HALF_STEP
}
#undef ROW2
#undef VMW
#undef VMWN
#undef SLOAD2
#undef SWRITE2K
#undef SWRITE2V
#undef SWRITE2
}
namespace att4 {
using att::crow; using att::load8; using att::v_rd_base; using att::SCALE; using att::THR;
using att2::mask1; using att2::partialSM; using att2::finishSM; using att2::v_rd_off;
constexpr int NW = 8, QBLK = 32, KV = 32, PITCH = 2048, DV = 256;
constexpr int SHM_V = KV * DV * 2, SHM_K = KV * 128 * 2, NVB = 3;
constexpr int OFF_K = NVB * SHM_V, OFF_S = OFF_K + 2 * SHM_K, LDS_BYTES = OFF_S + NW * 64 * 4;
static_assert(SHM_K == att2::SHM_K && SHM_V == att2::SHM_V, "att4 reuses att2's tile readers");
struct PassRef { const bf16_t* Q; const bf16_t* K; const bf16_t* V; int jlo, jhi, lastbase, first; };
#define KRD(dst, addr, off) asm volatile("ds_read_b128 %0, %1 offset:%2" : "=&v"(dst) : "v"(addr), "i"(off) : "memory")
#define LGK0() asm volatile("s_waitcnt lgkmcnt(0)" ::: "memory")
#define MF(acc, a, b) acc = __builtin_amdgcn_mfma_f32_32x32x16_bf16(a, b, acc, 0, 0, 0)
template <int KB>
__device__ __forceinline__ void qkt_finish(f32x16& p, const int (&kb)[4], const bf16x8* qr, f32x16& py, float alY, float& l_reg, bf16x8& pa0, bf16x8& pa1) {
    constexpr int B = KB * SHM_K;
    bf16x8 f0, f1, f2, f3;
    p = f32x16{};
    KRD(f0, kb[0], B); KRD(f1, kb[1], B); LGK0(); SBAR();
    KRD(f2, kb[2], B); KRD(f3, kb[3], B); MF(p, f0, qr[0]); MF(p, f1, qr[1]);
#pragma unroll
    for (int r = 8; r < 12; ++r) py[r] = __builtin_amdgcn_exp2f(py[r]);
    LGK0(); SBAR();
    KRD(f0, kb[0], B + 128); KRD(f1, kb[1], B + 128); MF(p, f2, qr[2]); MF(p, f3, qr[3]);
#pragma unroll
    for (int r = 12; r < 16; ++r) py[r] = __builtin_amdgcn_exp2f(py[r]);
    LGK0(); SBAR();
    KRD(f2, kb[2], B + 128); KRD(f3, kb[3], B + 128); MF(p, f0, qr[4]); MF(p, f1, qr[5]);
    { float ps = 0;
#pragma unroll
      for (int r = 0; r < 16; ++r) ps += py[r];
      auto rr = __builtin_amdgcn_permlane32_swap(__float_as_uint(ps), __float_as_uint(ps), false, false);
      ps = __uint_as_float(rr[0]) + __uint_as_float(rr[1]); l_reg = l_reg * alY + ps; }
    LGK0(); SBAR();
    MF(p, f2, qr[6]); MF(p, f3, qr[7]);
#define PK4(P, B_, OUT) do { unsigned a0 = cvt_pk_bf16(P[B_+0], P[B_+1]), a1 = cvt_pk_bf16(P[B_+2], P[B_+3]);                          \
        unsigned b0 = cvt_pk_bf16(P[B_+4], P[B_+5]), b1 = cvt_pk_bf16(P[B_+6], P[B_+7]);                                             \
        auto r0 = __builtin_amdgcn_permlane32_swap(a0, b0, false, false); auto r1 = __builtin_amdgcn_permlane32_swap(a1, b1, false, false); \
        u32x4 w = {r0[0], r1[0], r0[1], r1[1]}; OUT = *reinterpret_cast<bf16x8*>(&w); } while (0)
    PK4(py, 0, pa0); PK4(py, 8, pa1);
#undef PK4
    SBAR();
}
template <bool WITH_P>
__device__ __forceinline__ void pv_partial(f32x16* o, int vbase, bf16x8 pa0, bf16x8 pa1, f32x16& p, float& m_reg, float& mn, float& alpha) {
#define TRRD(dst, off) asm volatile("ds_read_b64_tr_b16 %0, %1 offset:%2" : "=&v"(dst) : "v"(vbase), "i"(off) : "memory")
#define PV_RD(l0, h0, l1, h1, d0) do { constexpr int b_ = v_rd_off(d0, 0, 0); TRRD(l0, b_); TRRD(h0, b_ + 4096); TRRD(l1, b_ + 8192); TRRD(h1, b_ + 12288); } while (0)
#define PV_MM(l0, h0, l1, h1, d0) do { __builtin_amdgcn_s_setprio(1); \
        MF(o[d0], pa0, ((bf16x8){l0[0], l0[1], l0[2], l0[3], h0[0], h0[1], h0[2], h0[3]}));   \
        MF(o[d0], pa1, ((bf16x8){l1[0], l1[1], l1[2], l1[3], h1[0], h1[1], h1[2], h1[3]})); __builtin_amdgcn_s_setprio(0); } while (0)
    constexpr float C2 = 1.4426950408889634f * SCALE;
    s16x4 a0, a1, a2, a3, b0, b1, b2, b3; float pmax = 0.f, mnL = 0.f;
    PV_RD(a0, a1, a2, a3, 0); LGK0(); SBAR();
    PV_RD(b0, b1, b2, b3, 1); PV_MM(a0, a1, a2, a3, 0);
    if (WITH_P) pmax = fmaxf(fmaxf(fmaxf(p[0], p[1]), fmaxf(p[2], p[3])), fmaxf(fmaxf(p[4], p[5]), fmaxf(p[6], p[7])));
    LGK0(); SBAR();
    PV_RD(a0, a1, a2, a3, 2); PV_MM(b0, b1, b2, b3, 1);
    if (WITH_P) { pmax = fmaxf(pmax, fmaxf(fmaxf(fmaxf(p[8], p[9]), fmaxf(p[10], p[11])), fmaxf(fmaxf(p[12], p[13]), fmaxf(p[14], p[15]))));
        auto rr = __builtin_amdgcn_permlane32_swap(__float_as_uint(pmax), __float_as_uint(pmax), false, false); pmax = fmaxf(__uint_as_float(rr[0]), __uint_as_float(rr[1])); }
    LGK0(); SBAR();
    PV_RD(b0, b1, b2, b3, 3); PV_MM(a0, a1, a2, a3, 2);
    if (WITH_P) { if (__builtin_expect(__all((pmax - m_reg) * SCALE <= THR), 1)) { mn = m_reg; alpha = 1.f; }
        else { mn = fmaxf(m_reg, pmax); alpha = __builtin_amdgcn_exp2f((m_reg - mn) * C2); m_reg = mn; }
        mnL = -mn * C2; }
    LGK0(); SBAR();
    PV_RD(a0, a1, a2, a3, 4); PV_MM(b0, b1, b2, b3, 3);
    if (WITH_P) {
#pragma unroll
        for (int r = 0; r < 8; ++r) p[r] = fmaf(p[r], C2, mnL); }
    LGK0(); SBAR();
    PV_RD(b0, b1, b2, b3, 5); PV_MM(a0, a1, a2, a3, 4);
    if (WITH_P) {
#pragma unroll
        for (int r = 8; r < 16; ++r) p[r] = fmaf(p[r], C2, mnL); }
    LGK0(); SBAR();
    PV_RD(a0, a1, a2, a3, 6); PV_MM(b0, b1, b2, b3, 5);
    if (WITH_P) {
#pragma unroll
        for (int r = 0; r < 4; ++r) p[r] = __builtin_amdgcn_exp2f(p[r]); }
    LGK0(); SBAR();
    PV_RD(b0, b1, b2, b3, 7); PV_MM(a0, a1, a2, a3, 6);
    if (WITH_P) {
#pragma unroll
        for (int r = 4; r < 8; ++r) p[r] = __builtin_amdgcn_exp2f(p[r]); }
    LGK0(); SBAR();
    PV_MM(b0, b1, b2, b3, 7);
    SBAR();
#undef PV_MM
#undef PV_RD
#undef TRRD
}
__device__ __forceinline__ void attn_pass(const int MODE, const PassRef& cur, LAS unsigned char* ldsL, float* stash, bf16_t* Oout, float lam, const int wid) {
    int lane = lane_id(); asm volatile("" : "+v"(lane));
    const int r32 = lane & 31, hi = lane >> 5;
    const int j_lo = cur.jlo, NT = cur.jhi - cur.jlo;
    const int lastw = cur.first ? cur.lastbase : cur.lastbase + 2 * (wid >> 1);
    char* lds = (char*)ldsL;
    float* ws = (float*)(lds + OFF_S) + wid * 64; float* li_l = ws, * al_l = ws + 32;
    unsigned voffK, voffV0, voffV1;
    { const int o = wid * 1024 + lane * 16, row = o >> 8, c = ((o >> 4) & 15) ^ (row & 7); voffK = (unsigned)(row * PITCH * 2 + c * 16); }
    { const int o = wid * 1024 + lane * 16, st = o >> 9, kk = (st >> 3) * 8 + ((o & 511) >> 6), q = (o >> 4) & 3, c = (st & 7) * 32 + 8 * q, k = (kk & ~0xC) | ((kk & 4) << 1) | ((kk & 8) >> 1);
      voffV0 = (unsigned)(k * PITCH * 2 + c * 2); }
    { const int o = 8192 + wid * 1024 + lane * 16, st = o >> 9, kk = (st >> 3) * 8 + ((o & 511) >> 6), q = (o >> 4) & 3, c = (st & 7) * 32 + 8 * q, k = (kk & ~0xC) | ((kk & 4) << 1) | ((kk & 8) >> 1);
      voffV1 = (unsigned)(k * PITCH * 2 + c * 2); }
    const char* Kg = (const char*)cur.K + (size_t)j_lo * KV * PITCH * 2; const char* Vg = (const char*)cur.V + (size_t)j_lo * KV * PITCH * 2;
    constexpr size_t TSTEP = (size_t)KV * PITCH * 2;
#define DMA_K(t, kbuf) __builtin_amdgcn_global_load_lds((const unsigned*)(Kg + (size_t)(t) * TSTEP + voffK), (LAS unsigned*)(ldsL + OFF_K + (kbuf) * SHM_K + wid * 1024), 16, 0, 0)
#define DMA_V(t, vbuf) do { __builtin_amdgcn_global_load_lds((const unsigned*)(Vg + (size_t)(t) * TSTEP + voffV0), (LAS unsigned*)(ldsL + (vbuf) * SHM_V + wid * 1024), 16, 0, 0); \
                            __builtin_amdgcn_global_load_lds((const unsigned*)(Vg + (size_t)(t) * TSTEP + voffV1), (LAS unsigned*)(ldsL + (vbuf) * SHM_V + 8192 + wid * 1024), 16, 0, 0); } while (0)
#define VMC(n) asm volatile("s_waitcnt vmcnt(" #n ")" ::: "memory")
#define BAR() __builtin_amdgcn_s_barrier()
    bf16x8 qr[8];
#pragma unroll
    for (int d0 = 0; d0 < 8; ++d0) qr[d0] = load8(cur.Q + (size_t)(wid * QBLK + r32) * PITCH + d0 * 16 + hi * 8);
    DMA_K(0, 0); DMA_V(0, 0);
    if (NT > 1) { DMA_K(1, 1); DMA_V(1, 1); }
    const char* K_lds = lds + OFF_K;
    const int vb0 = (int)(uintptr_t)lds + v_rd_base(lane);
    float m_reg = -1e30f, l_reg = 0; f32x16 o[8] = {};
#define RESC(a) do { if (__any((a) < 1.f)) { if (hi == 0) al_l[r32] = (a); asm volatile("s_waitcnt lgkmcnt(0)" ::: "memory");              \
                     _Pragma("unroll") for (int d_ = 0; d_ < 8; ++d_) _Pragma("unroll") for (int r = 0; r < 16; ++r) o[d_][r] *= al_l[crow(r, hi)]; } } while (0)
#define MASKT(P_, t) do { const int jt_ = j_lo + (t); if (jt_ == 7 || jt_ > lastw) mask1(P_, jt_ > lastw); } while (0)
    f32x16 p; float mn, al; bf16x8 pa0, pa1;
    if (NT > 1) VMC(3); else VMC(0);
    BAR();
    att2::qkt<0>(p, K_lds, r32, hi, qr); MASKT(p, 0); partialSM(p, m_reg, mn, al);
    if (NT > 1) { VMC(2); BAR(); }
    int vslot = 0;
    for (int t = 1; t < NT; ++t) {
        SBAR();
        if (t + 1 < NT) { const int vn_ = vslot == 0 ? 2 : vslot - 1; DMA_K(t + 1, (t + 1) & 1); DMA_V(t + 1, vn_); }
        f32x16 pn; float aln;
        att2::qkt<0>(pn, K_lds + (t & 1) * SHM_K, r32, hi, qr); finishSM(p, al, l_reg, pa0, pa1); SBAR();
        MASKT(pn, t); pv_partial<true>(o, vb0 + vslot * SHM_V, pa0, pa1, pn, m_reg, mn, aln);
        RESC(aln);
        p = pn; al = aln;
        if (t + 1 < NT) VMC(2); else VMC(0);
        asm volatile("s_waitcnt lgkmcnt(0)" ::: "memory");
        BAR(); vslot = vslot == 2 ? 0 : vslot + 1;
    }
    finishSM(p, al, l_reg, pa0, pa1); SBAR();
    att2::pv_tile<0>(o, vb0 + vslot * SHM_V, pa0, pa1);
    if (hi == 0) li_l[r32] = l_reg; asm volatile("s_waitcnt lgkmcnt(0)" ::: "memory");
    int hie = hi; asm volatile("" : "+v"(hie));
    float rli[16];
#pragma unroll
    for (int r = 0; r < 16; ++r) rli[r] = __builtin_amdgcn_rcpf(li_l[crow(r, hie)]);
    if (MODE == 0) {
        float* Ow = stash + (wid * QBLK + 4 * hie) * DV + r32;
#pragma unroll
        for (int r = 0; r < 16; ++r) {
#pragma unroll
            for (int d0 = 0; d0 < 8; ++d0) Ow[((r & 3) + 8 * (r >> 2)) * DV + d0 * 32] = o[d0][r] * rli[r]; }
    } else {
        const float* Sw = stash + (wid * QBLK + 4 * hie) * DV + r32;
        bf16_t* Ow = Oout + (size_t)((wid * QBLK + 4 * hie) * PITCH + r32);
#pragma unroll
        for (int rg = 0; rg < 8; ++rg) {
            float sv[2][8];
#pragma unroll
            for (int rr = 0; rr < 2; ++rr)
#pragma unroll
                for (int d0 = 0; d0 < 8; ++d0) sv[rr][d0] = Sw[((2 * rg + rr) & 3) * DV + 8 * ((2 * rg + rr) >> 2) * DV + d0 * 32];
#pragma unroll
            for (int rr = 0; rr < 2; ++rr) { const int r = 2 * rg + rr;
#pragma unroll
                for (int d0 = 0; d0 < 8; ++d0) { const float v = sv[rr][d0] - lam * (o[d0][r] * rli[r]);
                    const float vn = xor1(v);
                    if ((r32 & 1) == 0) *(unsigned*)(Ow + ((r & 3) + 8 * (r >> 2)) * PITCH + d0 * 32) = cvt_pk_bf16(v, vn); } }
            SBAR(); }
    }
    VMC(0); BAR();
#undef RESC
#undef MASKT
#undef DMA_K
#undef DMA_V
#undef VMC
#undef BAR
}
#undef KRD
#undef LGK0
#undef MF
}
namespace att7 {
using att::crow; using att::load8; using att::v_rd_base; using att::SCALE; using att::THR;
using att2::mask1; using att2::v_rd_off;
constexpr int NW = 8, QBLK = 32, KV = 32, PITCH = 2048, DV = 256;
constexpr int SHM_V = KV * DV * 2, SHM_K = KV * 128 * 2, NVB = 3;
constexpr int OFF_K = NVB * SHM_V, OFF_Q = OFF_K + 2 * SHM_K, OFF_S = 132096, LDS_BYTES = OFF_S + NW * 64 * 4;
struct PassRef { const bf16_t* Q; const bf16_t* K; const bf16_t* V; int jlo, jhi, lastbase, first; };

#define KRD(dst, addr, off) asm volatile("ds_read_b128 %0, %1 offset:%2" : "=&v"(dst) : "v"(addr), "i"(off) : "memory")
#define LGK0() asm volatile("s_waitcnt lgkmcnt(0)" ::: "memory")
#define MF(acc, a, b) acc = __builtin_amdgcn_mfma_f32_32x32x16_bf16(a, b, acc, 0, 0, 0)
#define TRRD(dst, off) asm volatile("ds_read_b64_tr_b16 %0, %1 offset:%2" : "=&v"(dst) : "v"(vbase), "i"(off) : "memory")
#define PV_RD(l0, h0, l1, h1, d0) do { constexpr int b_ = v_rd_off(d0, 0, 0); TRRD(l0, b_); TRRD(h0, b_ + 4096); TRRD(l1, b_ + 8192); TRRD(h1, b_ + 12288); } while (0)
#define PV_MM(l0, h0, l1, h1, d0) do { \
        MF(o[d0], pa0, ((bf16x8){l0[0], l0[1], l0[2], l0[3], h0[0], h0[1], h0[2], h0[3]}));   \
        MF(o[d0], pa1, ((bf16x8){l1[0], l1[1], l1[2], l1[3], h1[0], h1[1], h1[2], h1[3]})); } while (0)
#define K_RD(dst, d0) KRD(dst, kbs[(d0) & 3], ((d0) >> 2) * 128)
#define Q_RD(dst, d0) KRD(dst, qb[(d0) & 3], ((d0) >> 2) * 128)

template <int N> __device__ __forceinline__ void lgk_wait() { asm volatile("s_waitcnt lgkmcnt(%0)" :: "n"(N) : "memory"); }
template <bool WITH_QK, bool WITH_PV>
__device__ __forceinline__ void fused_step(f32x16* o, int vbase, bf16x8& pa0, bf16x8& pa1, const int (&kbs)[4], const int (&qb)[4], f32x16& p, f32x16& pn, float& m_reg, float& l_reg, float& alpha,
                                           const bool mask_any, const bool mask_all) {
    constexpr float C2 = 1.4426950408889634f * SCALE;
    s16x4 lA, hA, lB, hB, lC, hC; bf16x8 kA, kB, kC, qA, qB, qC; float pmax = 0.f, mn = 0.f, mnL = 0.f, ps = 0.f; unsigned x0 = 0, x1 = 0, x2 = 0, x3 = 0, y0 = 0, y1 = 0, y2 = 0, y3 = 0;
    if (WITH_QK) pn = f32x16{};
#define WAITL(n) asm volatile("s_waitcnt lgkmcnt(" #n ")" ::: "memory")
#define RDV(l, h, g) do { constexpr int b_ = v_rd_off((g) >> 1, 0, 0) + ((g) & 1) * 8192; TRRD(l, b_); TRRD(h, b_ + 4096); } while (0)
#define MMV(l, h, g) MF(o[(g) >> 1], (((g) & 1) ? pa1 : pa0), ((bf16x8){l[0], l[1], l[2], l[3], h[0], h[1], h[2], h[3]}))
    if (WITH_PV) RDV(lA, hA, 0); if (WITH_PV) RDV(lB, hB, 1);
    if (WITH_PV) RDV(lC, hC, 2); lgk_wait<(WITH_PV ? 4 : 0) + (WITH_QK ? 0 : 0)>(); SBAR(); if (WITH_PV) MMV(lA, hA, 0); if (mask_any) mask1(p, mask_all); pmax = fmaxf(fmaxf(p[0], p[1]), fmaxf(p[2], p[3])); SBAR();
    if (WITH_PV) RDV(lA, hA, 3); lgk_wait<(WITH_PV ? 4 : 0) + (WITH_QK ? 0 : 0)>(); SBAR(); if (WITH_PV) MMV(lB, hB, 1); pmax = fmaxf(pmax, fmaxf(fmaxf(p[4], p[5]), fmaxf(p[6], p[7]))); SBAR();
    if (WITH_PV) RDV(lB, hB, 4); lgk_wait<(WITH_PV ? 4 : 0) + (WITH_QK ? 0 : 0)>(); SBAR(); if (WITH_PV) MMV(lC, hC, 2); pmax = fmaxf(pmax, fmaxf(fmaxf(p[8], p[9]), fmaxf(p[10], p[11]))); SBAR();
    if (WITH_PV) RDV(lC, hC, 5); lgk_wait<(WITH_PV ? 4 : 0) + (WITH_QK ? 0 : 0)>(); SBAR(); if (WITH_PV) MMV(lA, hA, 3); pmax = fmaxf(pmax, fmaxf(fmaxf(p[12], p[13]), fmaxf(p[14], p[15]))); SBAR();
    if (WITH_PV) RDV(lA, hA, 6); lgk_wait<(WITH_PV ? 4 : 0) + (WITH_QK ? 0 : 0)>(); SBAR(); if (WITH_PV) MMV(lB, hB, 4); { auto rr = __builtin_amdgcn_permlane32_swap(__float_as_uint(pmax), __float_as_uint(pmax), false, false); pmax = fmaxf(__uint_as_float(rr[0]), __uint_as_float(rr[1])); } SBAR();
    if (WITH_PV) RDV(lB, hB, 7); lgk_wait<(WITH_PV ? 4 : 0) + (WITH_QK ? 0 : 0)>(); SBAR(); if (WITH_PV) MMV(lC, hC, 5); if (__builtin_expect(__all((pmax - m_reg) * SCALE <= THR), 1)) { mn = m_reg; alpha = 1.f; } else { mn = fmaxf(m_reg, pmax); alpha = __builtin_amdgcn_exp2f((m_reg - mn) * C2); m_reg = mn; } mnL = -mn * C2; SBAR();
    if (WITH_PV) RDV(lC, hC, 8); lgk_wait<(WITH_PV ? 4 : 0) + (WITH_QK ? 0 : 0)>(); SBAR(); if (WITH_PV) MMV(lA, hA, 6); p[0] = fmaf(p[0], C2, mnL); p[1] = fmaf(p[1], C2, mnL); p[2] = fmaf(p[2], C2, mnL); p[3] = fmaf(p[3], C2, mnL); SBAR();
    if (WITH_PV) RDV(lA, hA, 9); lgk_wait<(WITH_PV ? 4 : 0) + (WITH_QK ? 0 : 0)>(); SBAR(); if (WITH_PV) MMV(lB, hB, 7); p[4] = fmaf(p[4], C2, mnL); p[5] = fmaf(p[5], C2, mnL); p[6] = fmaf(p[6], C2, mnL); p[7] = fmaf(p[7], C2, mnL); SBAR();
    if (WITH_PV) RDV(lB, hB, 10); lgk_wait<(WITH_PV ? 4 : 0) + (WITH_QK ? 0 : 0)>(); SBAR(); if (WITH_PV) MMV(lC, hC, 8); p[8] = fmaf(p[8], C2, mnL); p[9] = fmaf(p[9], C2, mnL); p[10] = fmaf(p[10], C2, mnL); p[11] = fmaf(p[11], C2, mnL); SBAR();
    if (WITH_PV) RDV(lC, hC, 11); lgk_wait<(WITH_PV ? 4 : 0) + (WITH_QK ? 0 : 0)>(); SBAR(); if (WITH_PV) MMV(lA, hA, 9); p[12] = fmaf(p[12], C2, mnL); p[13] = fmaf(p[13], C2, mnL); p[14] = fmaf(p[14], C2, mnL); p[15] = fmaf(p[15], C2, mnL); SBAR();
    if (WITH_PV) RDV(lA, hA, 12); lgk_wait<(WITH_PV ? 4 : 0) + (WITH_QK ? 0 : 0)>(); SBAR(); if (WITH_PV) MMV(lB, hB, 10); p[0] = __builtin_amdgcn_exp2f(p[0]); p[1] = __builtin_amdgcn_exp2f(p[1]); SBAR();
    if (WITH_PV) RDV(lB, hB, 13); lgk_wait<(WITH_PV ? 4 : 0) + (WITH_QK ? 0 : 0)>(); SBAR(); if (WITH_PV) MMV(lC, hC, 11); p[2] = __builtin_amdgcn_exp2f(p[2]); p[3] = __builtin_amdgcn_exp2f(p[3]); SBAR();
    if (WITH_PV) RDV(lC, hC, 14); lgk_wait<(WITH_PV ? 4 : 0) + (WITH_QK ? 0 : 0)>(); SBAR(); if (WITH_PV) MMV(lA, hA, 12); p[4] = __builtin_amdgcn_exp2f(p[4]); p[5] = __builtin_amdgcn_exp2f(p[5]); SBAR();
    if (WITH_PV) RDV(lA, hA, 15); lgk_wait<(WITH_PV ? 4 : 0) + (WITH_QK ? 0 : 0)>(); SBAR(); if (WITH_PV) MMV(lB, hB, 13); p[6] = __builtin_amdgcn_exp2f(p[6]); p[7] = __builtin_amdgcn_exp2f(p[7]); SBAR();
    if (WITH_QK) { K_RD(kB, 0); Q_RD(qB, 0); } lgk_wait<(WITH_PV ? 2 : 0) + (WITH_QK ? 2 : 0)>(); SBAR(); if (WITH_PV) MMV(lC, hC, 14); p[8] = __builtin_amdgcn_exp2f(p[8]); p[9] = __builtin_amdgcn_exp2f(p[9]); SBAR();
    if (WITH_QK) { K_RD(kC, 1); Q_RD(qC, 1); } lgk_wait<(WITH_PV ? 0 : 0) + (WITH_QK ? 4 : 0)>(); SBAR(); if (WITH_PV) MMV(lA, hA, 15); p[10] = __builtin_amdgcn_exp2f(p[10]); p[11] = __builtin_amdgcn_exp2f(p[11]); SBAR();
    if (WITH_QK) { K_RD(kA, 2); Q_RD(qA, 2); } lgk_wait<(WITH_PV ? 0 : 0) + (WITH_QK ? 4 : 0)>(); SBAR(); if (WITH_QK) MF(pn, kB, qB); p[12] = __builtin_amdgcn_exp2f(p[12]); p[13] = __builtin_amdgcn_exp2f(p[13]); SBAR();
    if (WITH_QK) { K_RD(kB, 3); Q_RD(qB, 3); } lgk_wait<(WITH_PV ? 0 : 0) + (WITH_QK ? 4 : 0)>(); SBAR(); if (WITH_QK) MF(pn, kC, qC); p[14] = __builtin_amdgcn_exp2f(p[14]); p[15] = __builtin_amdgcn_exp2f(p[15]); SBAR();
    if (WITH_QK) { K_RD(kC, 4); Q_RD(qC, 4); } lgk_wait<(WITH_PV ? 0 : 0) + (WITH_QK ? 4 : 0)>(); SBAR(); if (WITH_QK) MF(pn, kA, qA); ps = ((p[0] + p[1]) + (p[2] + p[3])) + ((p[4] + p[5]) + (p[6] + p[7])); SBAR();
    if (WITH_QK) { K_RD(kA, 5); Q_RD(qA, 5); } lgk_wait<(WITH_PV ? 0 : 0) + (WITH_QK ? 4 : 0)>(); SBAR(); if (WITH_QK) MF(pn, kB, qB); ps += ((p[8] + p[9]) + (p[10] + p[11])) + ((p[12] + p[13]) + (p[14] + p[15])); { auto rr = __builtin_amdgcn_permlane32_swap(__float_as_uint(ps), __float_as_uint(ps), false, false); ps = __uint_as_float(rr[0]) + __uint_as_float(rr[1]); } l_reg = l_reg * alpha + ps; SBAR();
    if (WITH_QK) { K_RD(kB, 6); Q_RD(qB, 6); } lgk_wait<(WITH_PV ? 0 : 0) + (WITH_QK ? 4 : 0)>(); SBAR(); if (WITH_QK) MF(pn, kC, qC); x0 = cvt_pk_bf16(p[0], p[1]); x1 = cvt_pk_bf16(p[2], p[3]); y0 = cvt_pk_bf16(p[4], p[5]); y1 = cvt_pk_bf16(p[6], p[7]); SBAR();
    if (WITH_QK) { K_RD(kC, 7); Q_RD(qC, 7); } lgk_wait<(WITH_PV ? 0 : 0) + (WITH_QK ? 4 : 0)>(); SBAR(); if (WITH_QK) MF(pn, kA, qA); x2 = cvt_pk_bf16(p[8], p[9]); x3 = cvt_pk_bf16(p[10], p[11]); y2 = cvt_pk_bf16(p[12], p[13]); y3 = cvt_pk_bf16(p[14], p[15]); SBAR();
     lgk_wait<(WITH_PV ? 0 : 0) + (WITH_QK ? 2 : 0)>(); SBAR(); if (WITH_QK) MF(pn, kB, qB); { auto r0 = __builtin_amdgcn_permlane32_swap(x0, y0, false, false); auto r1 = __builtin_amdgcn_permlane32_swap(x1, y1, false, false); u32x4 w = {r0[0], r1[0], r0[1], r1[1]}; pa0 = *reinterpret_cast<bf16x8*>(&w); } SBAR();
     lgk_wait<(WITH_PV ? 0 : 0) + (WITH_QK ? 0 : 0)>(); SBAR(); if (WITH_QK) MF(pn, kC, qC); { auto r0 = __builtin_amdgcn_permlane32_swap(x2, y2, false, false); auto r1 = __builtin_amdgcn_permlane32_swap(x3, y3, false, false); u32x4 w = {r0[0], r1[0], r0[1], r1[1]}; pa1 = *reinterpret_cast<bf16x8*>(&w); } SBAR();
#undef WAITL
#undef RDV
#undef MMV
}
__device__ __forceinline__ void attn_pass(const int MODE, const PassRef& cur, LAS unsigned char* ldsL, float* stash, bf16_t* Oout, float lam, const int wid) {
    int lane = lane_id(); asm volatile("" : "+v"(lane));
    const int r32 = lane & 31, hi = lane >> 5;
    const int j_lo = cur.jlo, NT = cur.jhi - cur.jlo;
    const int lastw = cur.first ? cur.lastbase : cur.lastbase + 2 * (wid >> 1);
    char* lds = (char*)ldsL;
    float* ws = (float*)(lds + OFF_S) + wid * 64; float* li_l = ws, * al_l = ws + 32;
    unsigned voffK, voffV0;
    { const int o = wid * 1024 + lane * 16, row = o >> 8, c = ((o >> 4) & 15) ^ (row & 7); voffK = (unsigned)(row * PITCH * 2 + c * 16); }
    { const int o = wid * 1024 + lane * 16, st = o >> 9, kk = (st >> 3) * 8 + ((o & 511) >> 6), q = (o >> 4) & 3, c = (st & 7) * 32 + 8 * q, k = (kk & ~0xC) | ((kk & 4) << 1) | ((kk & 8) >> 1);
      voffV0 = (unsigned)(k * PITCH * 2 + c * 2); }
    const char* Kg = (const char*)cur.K + (size_t)j_lo * KV * PITCH * 2; const char* Vg = (const char*)cur.V + (size_t)j_lo * KV * PITCH * 2;
    constexpr size_t TSTEP = (size_t)KV * PITCH * 2;
#define DMA_K(t, kbuf) __builtin_amdgcn_global_load_lds((const unsigned*)(Kg + (size_t)(t) * TSTEP + voffK), (LAS unsigned*)(ldsL + OFF_K + (kbuf) * SHM_K + wid * 1024), 16, 0, 0)
#define DMA_V(t, vbuf) do { __builtin_amdgcn_global_load_lds((const unsigned*)(Vg + (size_t)(t) * TSTEP + voffV0), (LAS unsigned*)(ldsL + (vbuf) * SHM_V + wid * 1024), 16, 0, 0); \
                            __builtin_amdgcn_global_load_lds((const unsigned*)(Vg + (size_t)(t) * TSTEP + (size_t)16 * PITCH * 2 + voffV0), (LAS unsigned*)(ldsL + (vbuf) * SHM_V + 8192 + wid * 1024), 16, 0, 0); } while (0)
#define VMC(n) asm volatile("s_waitcnt vmcnt(" #n ")" ::: "memory")
#define BAR() __builtin_amdgcn_s_barrier()
    { const int rq = lane >> 4;
#pragma unroll
      for (int i = 0; i < 8; ++i) { const int row = 4 * i + rq; const unsigned vq = (unsigned)(row * PITCH * 2 + (((lane & 15) ^ (row & 7)) * 16));
          __builtin_amdgcn_global_load_lds((const unsigned*)((const char*)cur.Q + (size_t)(wid * QBLK) * PITCH * 2 + vq), (LAS unsigned*)(ldsL + OFF_Q + wid * 8192 + i * 1024), 16, 0, 0); } }
    DMA_K(0, 0); DMA_V(0, 0);
    if (NT > 1) { DMA_K(1, 1); DMA_V(1, 1); }
    int kbs[4];
#pragma unroll
    for (int dd = 0; dd < 4; ++dd) kbs[dd] = (int)(uintptr_t)(lds + OFF_K) + KSWZ(r32, (dd * 16 + hi * 8) * 2);
    int qb[4];
#pragma unroll
    for (int dd = 0; dd < 4; ++dd) qb[dd] = kbs[dd] + (OFF_Q - OFF_K) + wid * 8192;
    const int vb0 = (int)(uintptr_t)lds + v_rd_base(lane);
    float m_reg = -1e30f, l_reg = 0; f32x16 o[8] = {};
#define RESC(a) do { if (__any((a) < 1.f)) { const int l_ = lane_id(), r_ = l_ & 31, h_ = l_ >> 5;   \
                     if (h_ == 0) al_l[r_] = (a); asm volatile("s_waitcnt lgkmcnt(0)" ::: "memory");              \
                     _Pragma("unroll") for (int d_ = 0; d_ < 8; ++d_) _Pragma("unroll") for (int r = 0; r < 16; ++r) o[d_][r] *= al_l[crow(r, h_)]; } } while (0)
#define KFLIP() { kbs[0] ^= SHM_K; kbs[1] ^= SHM_K; kbs[2] ^= SHM_K; kbs[3] ^= SHM_K; }
    f32x16 p, pn; float al = 1.f; bf16x8 pa0, pa1;
    if (NT > 1) VMC(3); else VMC(0);
    BAR();
    { p = f32x16{}; bf16x8 kf, qf;
#pragma unroll
      for (int d0 = 0; d0 < 8; ++d0) { K_RD(kf, d0); Q_RD(qf, d0); LGK0(); SBAR(); MF(p, kf, qf); } SBAR(); }
    if (NT > 1) { VMC(2); BAR(); }
    int vslot = 0;
    if (NT > 1) {
        if (NT > 2) DMA_K(2, 0);
        KFLIP();
        { const int jt_ = j_lo; fused_step<true, false>(o, vb0, pa0, pa1, kbs, qb, p, pn, m_reg, l_reg, al, jt_ == 7 || jt_ > lastw, jt_ > lastw); }
        p = pn;
        VMC(0); LGK0(); BAR();
        for (int t = 1; t + 1 < NT; ++t) {
            SBAR();
            { const int vn_ = vslot == 0 ? 2 : vslot - 1; if (t + 2 < NT) DMA_K(t + 2, t & 1); DMA_V(t + 1, vn_); }
            KFLIP();
            { const int jt_ = j_lo + t; fused_step<true, true>(o, vb0 + vslot * SHM_V, pa0, pa1, kbs, qb, p, pn, m_reg, l_reg, al, jt_ == 7 || jt_ > lastw, jt_ > lastw); }
            RESC(al);
            p = pn;
            VMC(2); LGK0();
            BAR(); vslot = vslot == 2 ? 0 : vslot + 1;
        }
        { const int jt_ = j_lo + NT - 1; fused_step<false, true>(o, vb0 + vslot * SHM_V, pa0, pa1, kbs, qb, p, pn, m_reg, l_reg, al, jt_ == 7 || jt_ > lastw, jt_ > lastw); }
        RESC(al);
        VMC(0); LGK0(); BAR();
        vslot = vslot == 2 ? 0 : vslot + 1;
    } else {
        { const int jt_ = j_lo; fused_step<false, false>(o, vb0, pa0, pa1, kbs, qb, p, pn, m_reg, l_reg, al, jt_ == 7 || jt_ > lastw, jt_ > lastw); }
    }
    att2::pv_tile<0>(o, vb0 + vslot * SHM_V, pa0, pa1);
    if (hi == 0) li_l[r32] = l_reg; asm volatile("s_waitcnt lgkmcnt(0)" ::: "memory");
    int hie = hi; asm volatile("" : "+v"(hie));
    float rli[16];
#pragma unroll
    for (int r = 0; r < 16; ++r) rli[r] = __builtin_amdgcn_rcpf(li_l[crow(r, hie)]);
    f32x4* st4 = (f32x4*)stash + (wid * 64 + lane);
    if (MODE == 0) {
#pragma unroll
        for (int k = 0; k < 32; ++k) { const int d0 = k >> 2, rq = k & 3;
            st4[k * 512] = (f32x4){o[d0][4 * rq] * rli[4 * rq], o[d0][4 * rq + 1] * rli[4 * rq + 1], o[d0][4 * rq + 2] * rli[4 * rq + 2], o[d0][4 * rq + 3] * rli[4 * rq + 3]}; }
    } else {
        bf16_t* Ow = Oout + (size_t)((wid * QBLK + 4 * hie) * PITCH + r32);
        f32x4 sa[8], sb[8];
#define ST_LD(buf, kg) do { _Pragma("unroll") for (int k_ = 0; k_ < 8; ++k_) buf[k_] = st4[((kg) * 8 + k_) * 512]; } while (0)
#define ST_USE(buf, kg) do { _Pragma("unroll") for (int k_ = 0; k_ < 8; ++k_) { const int k = (kg) * 8 + k_, d0 = k >> 2, rq = k & 3;                          \
            _Pragma("unroll") for (int j_ = 0; j_ < 4; ++j_) { const int r = 4 * rq + j_; const float v = buf[k_][j_] - lam * (o[d0][r] * rli[r]); const float vn = xor1(v);   \
                if ((r32 & 1) == 0) *(unsigned*)(Ow + ((r & 3) + 8 * (r >> 2)) * PITCH + d0 * 32) = cvt_pk_bf16(v, vn); } } } while (0)
        ST_LD(sa, 0); SBAR();
        ST_LD(sb, 1); SBAR(); ST_USE(sa, 0); SBAR();
        ST_LD(sa, 2); SBAR(); ST_USE(sb, 1); SBAR();
        ST_LD(sb, 3); SBAR(); ST_USE(sa, 2); SBAR();
        ST_USE(sb, 3);
#undef ST_LD
#undef ST_USE
    }
    VMC(0); BAR();
#undef RESC
#undef KFLIP
#undef DMA_K
#undef DMA_V
#undef VMC
#undef BAR
}
#undef KRD
#undef LGK0
#undef MF
#undef TRRD
#undef PV_RD
#undef PV_MM
#undef K_RD
}
namespace att8 {
using att::crow; using att::load8; using att::v_rd_base; using att::SCALE; using att::THR;
using att2::mask1; using att2::v_rd_off;
constexpr int NW = 8, QBLK = 32, KV = 32, PITCH = 2048, DV = 256, KP = 128, VP = 256;
constexpr int SHM_V = KV * DV * 2, SHM_K = KV * 128 * 2, NVB = 3;
constexpr int OFF_K = NVB * SHM_V, OFF_Q = OFF_K + 2 * SHM_K, OFF_S = 132096, LDS_BYTES = OFF_S + NW * 64 * 4;
struct PassRef { const bf16_t* Q; const bf16_t* K; const bf16_t* V; int jlo, jhi, lastbase, first; };

#define KRD(dst, addr, off) asm volatile("ds_read_b128 %0, %1 offset:%2" : "=&v"(dst) : "v"(addr), "i"(off) : "memory")
#define LGK0() asm volatile("s_waitcnt lgkmcnt(0)" ::: "memory")
#define TRRD2(dst, base, off) asm volatile("ds_read_b64_tr_b16 %0, %1 offset:%2" : "=&v"(dst) : "v"(base), "i"(off) : "memory")
#define MF16(a, b, c) __builtin_amdgcn_mfma_f32_16x16x32_bf16(a, b, c, 0, 0, 0)

#define MF(acc, a, b) acc = __builtin_amdgcn_mfma_f32_32x32x16_bf16(a, b, acc, 0, 0, 0)
#define TRRD(dst, off) asm volatile("ds_read_b64_tr_b16 %0, %1 offset:%2" : "=&v"(dst) : "v"(vbase), "i"(off) : "memory")
#define PV_RD(l0, h0, l1, h1, d0) do { constexpr int b_ = v_rd_off(d0, 0, 0); TRRD(l0, b_); TRRD(h0, b_ + 4096); TRRD(l1, b_ + 8192); TRRD(h1, b_ + 12288); } while (0)
#define PV_MM(l0, h0, l1, h1, d0) do { \
        MF(o[d0], pa0, ((bf16x8){l0[0], l0[1], l0[2], l0[3], h0[0], h0[1], h0[2], h0[3]}));   \
        MF(o[d0], pa1, ((bf16x8){l1[0], l1[1], l1[2], l1[3], h1[0], h1[1], h1[2], h1[3]})); } while (0)
#define K_RD(dst, d0) do { const int a_ = kbs[0] ^ (((d0) & 3) << 5); KRD(dst, a_, ((d0) >> 2) * 128); } while (0)
#define Q_RD(dst, d0) do { const int a_ = qb[0] ^ (((d0) & 3) << 5); KRD(dst, a_, ((d0) >> 2) * 128); } while (0)

template <int N> __device__ __forceinline__ void lgk_wait() { asm volatile("s_waitcnt lgkmcnt(%0)" :: "n"(N) : "memory"); }
template <bool WITH_QK, bool WITH_PV>
__device__ __forceinline__ void fused_step(f32x4 (&o)[32], const int vbE, bf16x8& pa0, bf16x8& pa1, const int (&kbs)[4], const int (&qb)[4], f32x16& p, f32x16& pn, float& m_reg, float& l_reg, float& alpha,
                                           const bool mask_any, const bool mask_all) {
    constexpr float C2 = 1.4426950408889634f * SCALE;
    s16x4 lA, hA, lB, hB, lC, hC; bf16x8 kA, kB, kC, qA, qB, qC; float pmax = 0.f, mn = 0.f, mnL = 0.f, ps = 0.f; unsigned x0 = 0, x1 = 0, x2 = 0, x3 = 0, y0 = 0, y1 = 0, y2 = 0, y3 = 0;
    if (WITH_QK) pn = f32x16{};
    int vb = vbE;
#define WAITL(n) asm volatile("s_waitcnt lgkmcnt(" #n ")" ::: "memory")
#define RDV(l, h, g) do { constexpr int b_ = ((g) & 7) * 2048; TRRD2(l, vb, b_); TRRD2(h, vb, b_ + 1024); } while (0)
#define MMV(l, h, g) do { constexpr int ct_ = (g) < 8 ? 2 * (g) : 2 * ((g) - 8) + 1; const bf16x8 vf_ = {l[0], l[1], l[2], l[3], h[0], h[1], h[2], h[3]}; o[ct_] = MF16(vf_, pa0, o[ct_]); o[16 + ct_] = MF16(vf_, pa1, o[16 + ct_]); } while (0)
    if (WITH_PV) RDV(lA, hA, 0); if (WITH_PV) RDV(lB, hB, 1);
    if (WITH_PV) RDV(lC, hC, 2); lgk_wait<(WITH_PV ? 4 : 0) + (WITH_QK ? 0 : 0)>(); SBAR(); if (WITH_PV) MMV(lA, hA, 0); if (mask_any) mask1(p, mask_all); pmax = fmaxf(fmaxf(p[0], p[1]), fmaxf(p[2], p[3])); SBAR();
    if (WITH_PV) RDV(lA, hA, 3); lgk_wait<(WITH_PV ? 4 : 0) + (WITH_QK ? 0 : 0)>(); SBAR(); if (WITH_PV) MMV(lB, hB, 1); pmax = fmaxf(pmax, fmaxf(fmaxf(p[4], p[5]), fmaxf(p[6], p[7]))); SBAR();
    if (WITH_PV) RDV(lB, hB, 4); lgk_wait<(WITH_PV ? 4 : 0) + (WITH_QK ? 0 : 0)>(); SBAR(); if (WITH_PV) MMV(lC, hC, 2); pmax = fmaxf(pmax, fmaxf(fmaxf(p[8], p[9]), fmaxf(p[10], p[11]))); SBAR();
    if (WITH_PV) RDV(lC, hC, 5); lgk_wait<(WITH_PV ? 4 : 0) + (WITH_QK ? 0 : 0)>(); SBAR(); if (WITH_PV) MMV(lA, hA, 3); pmax = fmaxf(pmax, fmaxf(fmaxf(p[12], p[13]), fmaxf(p[14], p[15]))); SBAR();
    if (WITH_PV) RDV(lA, hA, 6); lgk_wait<(WITH_PV ? 4 : 0) + (WITH_QK ? 0 : 0)>(); SBAR(); if (WITH_PV) MMV(lB, hB, 4); { auto rr = __builtin_amdgcn_permlane32_swap(__float_as_uint(pmax), __float_as_uint(pmax), false, false); pmax = fmaxf(__uint_as_float(rr[0]), __uint_as_float(rr[1])); } SBAR();
    if (WITH_PV) RDV(lB, hB, 7); lgk_wait<(WITH_PV ? 4 : 0) + (WITH_QK ? 0 : 0)>(); SBAR(); if (WITH_PV) MMV(lC, hC, 5); if (__builtin_expect(__all((pmax - m_reg) * SCALE <= THR), 1)) { mn = m_reg; alpha = 1.f; } else { mn = fmaxf(m_reg, pmax); alpha = __builtin_amdgcn_exp2f((m_reg - mn) * C2); m_reg = mn; } mnL = -mn * C2; SBAR();
    if (WITH_PV) vb ^= 32; if (WITH_PV) RDV(lC, hC, 8); lgk_wait<(WITH_PV ? 4 : 0) + (WITH_QK ? 0 : 0)>(); SBAR(); if (WITH_PV) MMV(lA, hA, 6); p[0] = fmaf(p[0], C2, mnL); p[1] = fmaf(p[1], C2, mnL); p[2] = fmaf(p[2], C2, mnL); p[3] = fmaf(p[3], C2, mnL); SBAR();
    if (WITH_PV) RDV(lA, hA, 9); lgk_wait<(WITH_PV ? 4 : 0) + (WITH_QK ? 0 : 0)>(); SBAR(); if (WITH_PV) MMV(lB, hB, 7); p[4] = fmaf(p[4], C2, mnL); p[5] = fmaf(p[5], C2, mnL); p[6] = fmaf(p[6], C2, mnL); p[7] = fmaf(p[7], C2, mnL); SBAR();
    if (WITH_PV) RDV(lB, hB, 10); lgk_wait<(WITH_PV ? 4 : 0) + (WITH_QK ? 0 : 0)>(); SBAR(); if (WITH_PV) MMV(lC, hC, 8); p[8] = fmaf(p[8], C2, mnL); p[9] = fmaf(p[9], C2, mnL); p[10] = fmaf(p[10], C2, mnL); p[11] = fmaf(p[11], C2, mnL); SBAR();
    if (WITH_PV) RDV(lC, hC, 11); lgk_wait<(WITH_PV ? 4 : 0) + (WITH_QK ? 0 : 0)>(); SBAR(); if (WITH_PV) MMV(lA, hA, 9); p[12] = fmaf(p[12], C2, mnL); p[13] = fmaf(p[13], C2, mnL); p[14] = fmaf(p[14], C2, mnL); p[15] = fmaf(p[15], C2, mnL); SBAR();
    if (WITH_PV) RDV(lA, hA, 12); lgk_wait<(WITH_PV ? 4 : 0) + (WITH_QK ? 0 : 0)>(); SBAR(); if (WITH_PV) MMV(lB, hB, 10); p[0] = __builtin_amdgcn_exp2f(p[0]); p[1] = __builtin_amdgcn_exp2f(p[1]); SBAR();
    if (WITH_PV) RDV(lB, hB, 13); lgk_wait<(WITH_PV ? 4 : 0) + (WITH_QK ? 0 : 0)>(); SBAR(); if (WITH_PV) MMV(lC, hC, 11); p[2] = __builtin_amdgcn_exp2f(p[2]); p[3] = __builtin_amdgcn_exp2f(p[3]); SBAR();
    if (WITH_PV) RDV(lC, hC, 14); lgk_wait<(WITH_PV ? 4 : 0) + (WITH_QK ? 0 : 0)>(); SBAR(); if (WITH_PV) MMV(lA, hA, 12); p[4] = __builtin_amdgcn_exp2f(p[4]); p[5] = __builtin_amdgcn_exp2f(p[5]); SBAR();
    if (WITH_PV) RDV(lA, hA, 15); lgk_wait<(WITH_PV ? 4 : 0) + (WITH_QK ? 0 : 0)>(); SBAR(); if (WITH_PV) MMV(lB, hB, 13); p[6] = __builtin_amdgcn_exp2f(p[6]); p[7] = __builtin_amdgcn_exp2f(p[7]); SBAR();
    if (WITH_QK) { K_RD(kB, 0); Q_RD(qB, 0); } lgk_wait<(WITH_PV ? 2 : 0) + (WITH_QK ? 2 : 0)>(); SBAR(); if (WITH_PV) MMV(lC, hC, 14); p[8] = __builtin_amdgcn_exp2f(p[8]); p[9] = __builtin_amdgcn_exp2f(p[9]); SBAR();
    if (WITH_QK) { K_RD(kC, 1); Q_RD(qC, 1); } lgk_wait<(WITH_PV ? 0 : 0) + (WITH_QK ? 4 : 0)>(); SBAR(); if (WITH_PV) MMV(lA, hA, 15); p[10] = __builtin_amdgcn_exp2f(p[10]); p[11] = __builtin_amdgcn_exp2f(p[11]); SBAR();
    if (WITH_QK) { K_RD(kA, 2); Q_RD(qA, 2); } lgk_wait<(WITH_PV ? 0 : 0) + (WITH_QK ? 4 : 0)>(); SBAR(); if (WITH_QK) MF(pn, kB, qB); p[12] = __builtin_amdgcn_exp2f(p[12]); p[13] = __builtin_amdgcn_exp2f(p[13]); SBAR();
    if (WITH_QK) { K_RD(kB, 3); Q_RD(qB, 3); } lgk_wait<(WITH_PV ? 0 : 0) + (WITH_QK ? 4 : 0)>(); SBAR(); if (WITH_QK) MF(pn, kC, qC); p[14] = __builtin_amdgcn_exp2f(p[14]); p[15] = __builtin_amdgcn_exp2f(p[15]); SBAR();
    if (WITH_QK) { K_RD(kC, 4); Q_RD(qC, 4); } lgk_wait<(WITH_PV ? 0 : 0) + (WITH_QK ? 4 : 0)>(); SBAR(); if (WITH_QK) MF(pn, kA, qA); ps = ((p[0] + p[1]) + (p[2] + p[3])) + ((p[4] + p[5]) + (p[6] + p[7])); SBAR();
    if (WITH_QK) { K_RD(kA, 5); Q_RD(qA, 5); } lgk_wait<(WITH_PV ? 0 : 0) + (WITH_QK ? 4 : 0)>(); SBAR(); if (WITH_QK) MF(pn, kB, qB); ps += ((p[8] + p[9]) + (p[10] + p[11])) + ((p[12] + p[13]) + (p[14] + p[15])); { auto rr = __builtin_amdgcn_permlane32_swap(__float_as_uint(ps), __float_as_uint(ps), false, false); ps = __uint_as_float(rr[0]) + __uint_as_float(rr[1]); } l_reg = l_reg * alpha + ps; SBAR();
    if (WITH_QK) { K_RD(kB, 6); Q_RD(qB, 6); } lgk_wait<(WITH_PV ? 0 : 0) + (WITH_QK ? 4 : 0)>(); SBAR(); if (WITH_QK) MF(pn, kC, qC); x0 = cvt_pk_bf16(p[0], p[1]); x1 = cvt_pk_bf16(p[2], p[3]); y0 = cvt_pk_bf16(p[4], p[5]); y1 = cvt_pk_bf16(p[6], p[7]); SBAR();
    if (WITH_QK) { K_RD(kC, 7); Q_RD(qC, 7); } lgk_wait<(WITH_PV ? 0 : 0) + (WITH_QK ? 4 : 0)>(); SBAR(); if (WITH_QK) MF(pn, kA, qA); x2 = cvt_pk_bf16(p[8], p[9]); x3 = cvt_pk_bf16(p[10], p[11]); y2 = cvt_pk_bf16(p[12], p[13]); y3 = cvt_pk_bf16(p[14], p[15]); SBAR();
     lgk_wait<(WITH_PV ? 0 : 0) + (WITH_QK ? 2 : 0)>(); SBAR(); if (WITH_QK) MF(pn, kB, qB); { auto r0 = __builtin_amdgcn_permlane16_swap(x0, x2, false, false); auto r1 = __builtin_amdgcn_permlane16_swap(x1, x3, false, false); u32x4 w0 = __builtin_bit_cast(u32x4, pa0), w1 = __builtin_bit_cast(u32x4, pa1); w0[0] = r0[0]; w0[1] = r1[0]; w1[0] = r0[1]; w1[1] = r1[1]; pa0 = __builtin_bit_cast(bf16x8, w0); pa1 = __builtin_bit_cast(bf16x8, w1); } SBAR();
     lgk_wait<(WITH_PV ? 0 : 0) + (WITH_QK ? 0 : 0)>(); SBAR(); if (WITH_QK) MF(pn, kC, qC); { auto r2 = __builtin_amdgcn_permlane16_swap(y0, y2, false, false); auto r3 = __builtin_amdgcn_permlane16_swap(y1, y3, false, false); u32x4 w0 = __builtin_bit_cast(u32x4, pa0), w1 = __builtin_bit_cast(u32x4, pa1); w0[2] = r2[0]; w0[3] = r3[0]; w1[2] = r2[1]; w1[3] = r3[1]; pa0 = __builtin_bit_cast(bf16x8, w0); pa1 = __builtin_bit_cast(bf16x8, w1); } SBAR();
#undef WAITL
#undef RDV
#undef MMV
}
__device__ __forceinline__ void attn_pass(const int MODE, const PassRef& cur, LAS unsigned char* ldsL, float* stash, bf16_t* Oout, float lam, const int wid) {
    int lane = lane_id(); asm volatile("" : "+v"(lane));
    const int r32 = lane & 31, hi = lane >> 5;
    const int j_lo = cur.jlo, NT = cur.jhi - cur.jlo;
    const int lastw = cur.first ? cur.lastbase : cur.lastbase + 2 * (wid >> 1);
    char* lds = (char*)ldsL;
    float* ws = (float*)(lds + OFF_S) + wid * 64; float* li_l = ws, * al_l = ws + 32;
    unsigned voffK, voffV0;
    voffK = (unsigned)(wid * 1024 + lane * 16);
    voffV0 = (unsigned)(wid * 1024 + lane * 16);
    const char* Kg = (const char*)cur.K + (size_t)j_lo * KV * KP * 2; const char* Vg = (const char*)cur.V + (size_t)j_lo * KV * VP * 2;
    constexpr size_t TSTEP_K = (size_t)KV * KP * 2, TSTEP_V = (size_t)KV * VP * 2;
#define DMA_K(t, kbuf) __builtin_amdgcn_global_load_lds((const unsigned*)(Kg + (size_t)(t) * TSTEP_K + voffK), (LAS unsigned*)(ldsL + OFF_K + (kbuf) * SHM_K + wid * 1024), 16, 0, 0)
#define DMA_V(t, vbuf) do { __builtin_amdgcn_global_load_lds((const unsigned*)(Vg + (size_t)(t) * TSTEP_V + voffV0), (LAS unsigned*)(ldsL + (vbuf) * SHM_V + wid * 1024), 16, 0, 0); \
                            __builtin_amdgcn_global_load_lds((const unsigned*)(Vg + (size_t)(t) * TSTEP_V + (size_t)8192 + voffV0), (LAS unsigned*)(ldsL + (vbuf) * SHM_V + 8192 + wid * 1024), 16, 0, 0); } while (0)
#define VMC(n) asm volatile("s_waitcnt vmcnt(" #n ")" ::: "memory")
#define BAR() __builtin_amdgcn_s_barrier()
    { const int rq = lane >> 4;
#pragma unroll
      for (int i = 0; i < 8; ++i) { const int row = 4 * i + rq; const unsigned vq = (unsigned)(row * PITCH * 2 + (((lane & 15) ^ (row & 7)) * 16));
          __builtin_amdgcn_global_load_lds((const unsigned*)((const char*)cur.Q + (size_t)(wid * QBLK) * PITCH * 2 + vq), (LAS unsigned*)(ldsL + OFF_Q + wid * 8192 + i * 1024), 16, 0, 0); } }
    DMA_K(0, 0); DMA_V(0, 0);
    if (NT > 1) { DMA_K(1, 1); DMA_V(1, 1); }
    int kbs[4];
#pragma unroll
    for (int dd = 0; dd < 4; ++dd) kbs[dd] = (int)(uintptr_t)(lds + OFF_K) + KSWZ(r32, (dd * 16 + hi * 8) * 2);
    int qb[4];
#pragma unroll
    for (int dd = 0; dd < 4; ++dd) qb[dd] = kbs[dd] + (OFF_Q - OFF_K) + wid * 8192;
    const int vb0 = (int)(uintptr_t)lds + (((lane >> 2) & 3) + 4 * ((lane >> 4) & 1) + 8 * ((lane >> 5) & 1)) * 64 + ((lane >> 4) & 1) * 32 + (lane & 3) * 8;
    float m_reg = -1e30f, l_reg = 0; f32x4 o[32];
#pragma unroll
    for (int k_ = 0; k_ < 32; ++k_) o[k_] = (f32x4){0.f, 0.f, 0.f, 0.f};
#define RESC(a) do { if (__any((a) < 1.f)) { const int l_ = lane_id();   \
                     if ((l_ >> 5) == 0) al_l[l_ & 31] = (a); asm volatile("s_waitcnt lgkmcnt(0)" ::: "memory");              \
                     const float a0_ = al_l[l_ & 15], a1_ = al_l[16 + (l_ & 15)];                                                \
                     _Pragma("unroll") for (int k_ = 0; k_ < 16; ++k_) { o[k_] *= a0_; o[16 + k_] *= a1_; } } } while (0)
#define KFLIP() { kbs[0] ^= SHM_K; kbs[1] ^= SHM_K; kbs[2] ^= SHM_K; kbs[3] ^= SHM_K; }
    f32x16 p, pn; float al = 1.f; bf16x8 pa0, pa1;
    if (NT > 1) VMC(3); else VMC(0);
    BAR();
    { p = f32x16{}; bf16x8 kf, qf;
#pragma unroll
      for (int d0 = 0; d0 < 8; ++d0) { K_RD(kf, d0); Q_RD(qf, d0); LGK0(); SBAR(); MF(p, kf, qf); } SBAR(); }
    if (NT > 1) { VMC(2); BAR(); }
    int vslot = 0;
    if (NT > 1) {
        if (NT > 2) DMA_K(2, 0);
        KFLIP();
        { const int jt_ = j_lo; fused_step<true, false>(o, vb0, pa0, pa1, kbs, qb, p, pn, m_reg, l_reg, al, jt_ == 7 || jt_ > lastw, jt_ > lastw); }
        p = pn;
        VMC(0); LGK0(); BAR();
        for (int t = 1; t + 1 < NT; ++t) {
            SBAR();
            { const int vn_ = vslot == 0 ? 2 : vslot - 1; if (t + 2 < NT) DMA_K(t + 2, t & 1); DMA_V(t + 1, vn_); }
            KFLIP();
            { const int jt_ = j_lo + t; fused_step<true, true>(o, vb0 + vslot * SHM_V, pa0, pa1, kbs, qb, p, pn, m_reg, l_reg, al, jt_ == 7 || jt_ > lastw, jt_ > lastw); }
            RESC(al);
            p = pn;
            VMC(2); LGK0();
            BAR(); vslot = vslot == 2 ? 0 : vslot + 1;
        }
        { const int jt_ = j_lo + NT - 1; fused_step<false, true>(o, vb0 + vslot * SHM_V, pa0, pa1, kbs, qb, p, pn, m_reg, l_reg, al, jt_ == 7 || jt_ > lastw, jt_ > lastw); }
        RESC(al);
        VMC(0); LGK0(); BAR();
        vslot = vslot == 2 ? 0 : vslot + 1;
    } else {
        { const int jt_ = j_lo; fused_step<false, false>(o, vb0, pa0, pa1, kbs, qb, p, pn, m_reg, l_reg, al, jt_ == 7 || jt_ > lastw, jt_ > lastw); }
    }
    { int vf_b = vb0 + vslot * SHM_V;
#pragma unroll
      for (int g = 0; g < 16; ++g) { s16x4 l_, h_; const int b_ = (g & 7) * 2048, ct_ = g < 8 ? 2 * g : 2 * (g - 8) + 1;
          if (g == 8) vf_b ^= 32;
          asm volatile("ds_read_b64_tr_b16 %0, %1 offset:%2" : "=&v"(l_) : "v"(vf_b), "i"(b_) : "memory"); asm volatile("ds_read_b64_tr_b16 %0, %1 offset:%2" : "=&v"(h_) : "v"(vf_b), "i"(b_ + 1024) : "memory");
          LGK0(); SBAR();
          const bf16x8 vf_ = {l_[0], l_[1], l_[2], l_[3], h_[0], h_[1], h_[2], h_[3]}; o[ct_] = MF16(vf_, pa0, o[ct_]); o[16 + ct_] = MF16(vf_, pa1, o[16 + ct_]); } }
    if (hi == 0) li_l[r32] = l_reg; asm volatile("s_waitcnt lgkmcnt(0)" ::: "memory");
    int l15 = lane & 15; asm volatile("" : "+v"(l15));
    const float rl0 = __builtin_amdgcn_rcpf(li_l[l15]), rl1 = __builtin_amdgcn_rcpf(li_l[16 + l15]);
    f32x4* st4 = (f32x4*)stash + (wid * 64 + lane);
    if (MODE == 0) {
#pragma unroll
        for (int k = 0; k < 32; ++k) st4[k * 512] = o[k] * (k < 16 ? rl0 : rl1);
    } else {
        bf16_t* Ow = Oout + (size_t)((wid * QBLK + l15) * PITCH + 4 * (lane >> 4));
        f32x4 sa[4], sb[4];
#define ST_LD(buf, kg) do { _Pragma("unroll") for (int k_ = 0; k_ < 4; ++k_) buf[k_] = st4[((kg) * 4 + k_) * 512]; } while (0)
#define ST_USE(buf, kg) do { _Pragma("unroll") for (int k_ = 0; k_ < 4; ++k_) { const int k = (kg) * 4 + k_, rt = k >> 4, ct = k & 15;                          \
            const f32x4 v = buf[k_] - o[k] * (lam * (rt ? rl1 : rl0));                                                                                     \
            *(u32x2*)(Ow + (size_t)(16 * rt) * PITCH + 16 * ct) = (u32x2){cvt_pk_bf16(v[0], v[1]), cvt_pk_bf16(v[2], v[3])}; } } while (0)
        ST_LD(sa, 0); SBAR();
        ST_LD(sb, 1); SBAR(); ST_USE(sa, 0); SBAR();
        ST_LD(sa, 2); SBAR(); ST_USE(sb, 1); SBAR();
        ST_LD(sb, 3); SBAR(); ST_USE(sa, 2); SBAR();
        ST_LD(sa, 4); SBAR(); ST_USE(sb, 3); SBAR();
        ST_LD(sb, 5); SBAR(); ST_USE(sa, 4); SBAR();
        ST_LD(sa, 6); SBAR(); ST_USE(sb, 5); SBAR();
        ST_LD(sb, 7); SBAR(); ST_USE(sa, 6); SBAR();
        ST_USE(sb, 7);
#undef ST_LD
#undef ST_USE
    }
    VMC(0); BAR();
#undef RESC
#undef KFLIP
#undef DMA_K
#undef DMA_V
#undef VMC
#undef BAR
}
#undef KRD
#undef LGK0
#undef MF
#undef TRRD
#undef PV_RD
#undef PV_MM
#undef TRRD2
#undef MF16
#undef K_RD
}
constexpr size_t MiB = 1u << 20;
constexpr size_t RB = (size_t)TP * DM * 2;
constexpr size_t WS_CTL = 0, CTL_ZERO_BYTES = 1 * MiB;
constexpr size_t WS_ROPE = 1 * MiB;
constexpr size_t WS_ALOW = 4 * MiB;
constexpr size_t WS_DECAY = 7 * MiB;
constexpr size_t WS_SCORE = 10 * MiB;
constexpr size_t WS_STASH = 28 * MiB;
constexpr size_t WS_W1G = 60 * MiB;
constexpr size_t WS_WGATE = 109 * MiB;
constexpr size_t WS_WBRG = 125 * MiB, WS_WBRD = 133 * MiB, WS_WO = 141 * MiB;
constexpr size_t WS_GV = 150 * MiB;
constexpr size_t WS_GQK = WS_GV + RB;
constexpr size_t WS_DQ = WS_GQK + RB;
constexpr size_t WS_KB = WS_DQ + RB;
constexpr size_t WS_VB = WS_KB + RB;
constexpr size_t WS_OD = WS_VB + RB;
constexpr size_t WS_RB = WS_OD + RB;
constexpr size_t WS_END = WS_RB + RB;
static_assert(WS_END == 1116 * MiB, "ws map");
constexpr size_t WS_WFF1 = WS_STASH, WS_WFF2 = WS_W1G;
constexpr int CW_BAR = 4096;
constexpr int CW_QUEUE = 64;

constexpr int RING_OFF = 0, RING_BYTES = 131072;
constexpr int MISC_OFF = RING_BYTES + 320;
constexpr int LDS_BYTES = 147456;

#define RLX_AGENT __ATOMIC_RELAXED, __HIP_MEMORY_SCOPE_AGENT
#define LDS_WAIT() asm volatile("s_waitcnt lgkmcnt(0)" ::: "memory")
#define VM_WAIT() asm volatile("s_waitcnt vmcnt(0)" ::: "memory")

#define XB_TMO      128
#define XB_XCNT(j)  (256  + 64 * (j))
#define XB_XSUB(j)  (1280 + 64 * (j))
#define XB_XGEN(j)  (2304 + 64 * (j))
#define XB_TOP      3328
#define XB_TOPGEN   3392
#define XCD_BAR_WORDS 3456
#define XB_SPIN_CAP (1u << 22)
__device__ __forceinline__ unsigned xb_ld(unsigned* p)              { return __hip_atomic_load(p, __ATOMIC_RELAXED, __HIP_MEMORY_SCOPE_AGENT); }
__device__ __forceinline__ unsigned xb_add(unsigned* p, unsigned v) { return __hip_atomic_fetch_add(p, v, __ATOMIC_RELAXED, __HIP_MEMORY_SCOPE_AGENT); }
__device__ __forceinline__ unsigned xb_xcc_id() { return (unsigned)__builtin_amdgcn_s_getreg((3 << 11) | 20) & 0xFu; }
#define XB_SPIN(cond, bar) do { unsigned _sp = 0; while (cond) { __builtin_amdgcn_s_sleep(1); \
    if ((++_sp & 255u) == 0u) { if (xb_ld(&(bar)[XB_TMO])) break; if (_sp > XB_SPIN_CAP) { atomicAdd(&(bar)[XB_TMO], 1u); break; } } } } while (0)
struct XcdBarrier { unsigned* bar; unsigned x; volatile LAS unsigned* st; int wave; };
__device__ __forceinline__ XcdBarrier xcd_barrier_post(unsigned* bar, volatile LAS unsigned* st, int wave) {
    XcdBarrier b; b.bar = bar; b.x = xb_xcc_id(); b.st = st; b.wave = wave;
    if (wave == 0 && lane_id() == 0) (void)xb_add(&bar[XB_XCNT(b.x)], 1u);
    return b;
}
__device__ __forceinline__ void xcd_barrier_complete(unsigned* bar, unsigned x, unsigned& nloc, unsigned& nx) {
    const unsigned G = gridDim.x * gridDim.y * gridDim.z;
    unsigned sum, cnt, mine, sp = 0u;
    for (;;) {
        sum = 0u; cnt = 0u; mine = 0u;
#pragma unroll
        for (unsigned j = 0; j < 16; ++j) { const unsigned c = xb_ld(&bar[XB_XCNT(j)]); sum += c; cnt += (c > 0u) ? 1u : 0u; mine = (j == x) ? c : mine; }
        if (sum == G) break;
        __builtin_amdgcn_s_sleep(1);
        if ((++sp & 255u) == 0u) { if (xb_ld(&bar[XB_TMO])) break; if (sp > XB_SPIN_CAP) { atomicAdd(&bar[XB_TMO], 1u); break; } }
    }
    nloc = mine > 0u ? mine : 1u; nx = cnt > 0u ? cnt : 1u;
}
__device__ __forceinline__ void xcd_barrier(const XcdBarrier& b) {
    asm volatile("s_waitcnt vmcnt(0)" ::: "memory");
    __syncthreads();
    if (b.wave == 0 && lane_id() == 0) {
        unsigned* bar = b.bar;
        __builtin_amdgcn_s_waitcnt(0);
        unsigned nloc = b.st[0], nx = b.st[1];
        if (nloc == 0u) { xcd_barrier_complete(bar, b.x, nloc, nx); b.st[0] = nloc; b.st[1] = nx; }
        const unsigned old = xb_add(&bar[XB_XSUB(b.x)], 1u);
        const unsigned gen = old / nloc;
        if (old + 1u == (gen + 1u) * nloc) {
            __builtin_amdgcn_fence(__ATOMIC_RELEASE, "agent");
            asm volatile("s_waitcnt vmcnt(0)" ::: "memory");
            const unsigned og = xb_add(&bar[XB_TOP], 1u);
            const unsigned tg = og / nx;
            if (og + 1u == (tg + 1u) * nx) xb_add(&bar[XB_TOPGEN], 1u);
            else XB_SPIN(xb_ld(&bar[XB_TOPGEN]) == tg, bar);
            __builtin_amdgcn_fence(__ATOMIC_ACQUIRE, "agent");
            xb_add(&bar[XB_XGEN(b.x)], 1u);
            asm volatile("s_waitcnt vmcnt(0)" ::: "memory");
        } else {
            XB_SPIN(xb_ld(&bar[XB_XGEN(b.x)]) == gen, bar);
            __builtin_amdgcn_fence(__ATOMIC_ACQUIRE, "agent");
            asm volatile("s_waitcnt vmcnt(0)" ::: "memory");
        }
    }
    __syncthreads();
}

struct Args { const float* in[24]; float* out; unsigned char* ws; int ph_lo, ph_hi; };
struct Frame {
    LAS unsigned char* lds; volatile LAS unsigned* MISC;
    int wave, G, gw, NGW;
};
typedef const float* cfp_t;
__device__ __forceinline__ const float* inp(int i) { const __attribute__((address_space(4))) cfp_t* t = (const __attribute__((address_space(4))) cfp_t*)__builtin_amdgcn_kernarg_segment_ptr(); asm volatile("" : "+s"(t)); return t[i]; }
__device__ __forceinline__ float* outp() { const __attribute__((address_space(4))) char* t = (const __attribute__((address_space(4))) char*)__builtin_amdgcn_kernarg_segment_ptr(); asm volatile("" : "+s"(t)); return *(float* const __attribute__((address_space(4)))*)(t + 192); }
__device__ __forceinline__ unsigned char* wsp() { const __attribute__((address_space(4))) char* t = (const __attribute__((address_space(4))) char*)__builtin_amdgcn_kernarg_segment_ptr(); asm volatile("" : "+s"(t)); return *(unsigned char* const __attribute__((address_space(4)))*)(t + 200); }
#define TID (F.wave * 64 + lane_id())
#define LANE (lane_id())
__device__ __forceinline__ float wave_sum(float v) {
#pragma unroll
    for (int o = 1; o < 64; o <<= 1) v += __shfl_xor(v, o);
    return v;
}
__device__ __forceinline__ int row_pos(int row) {
    if (row >= SR0) return PAST + ((row - SR0) & 63);
    const int ri = row % BS; return ri >= PADR ? ri - PADR : 0;
}
__device__ __forceinline__ long row_kv(int row, bool& sample) {
    if (row >= SR0) { sample = true; return row - SR0; }
    sample = false; const int b = row / BS, ri = row - b * BS; return ri >= PADR ? (long)b * LP + (ri - PADR) : -1;
}
__device__ __forceinline__ const float* row_x(const Frame& F, int row, float*& y) {
    if (row >= SR0) { y = outp() + O_YS + (size_t)(row - SR0) * DM; return inp(1) + (size_t)(row - SR0) * DM; }
    const int b = row / BS, ri = row - b * BS;
    if (ri >= 256) { y = outp() + O_YP + ((size_t)b * SEQ + (ri - 256)) * DM; return inp(0) + ((size_t)b * SEQ + (ri - 256)) * DM; }
    y = nullptr; if (ri >= PADR) return inp(5) + (size_t)(ri - PADR) * DM; return nullptr;
}

__device__ __forceinline__ void transpose_item(const float* W, int ldw, int K, int c0, int ncv, int k0, bf16_t* WT, int n0, LAS float* scr, int lane) {
    const int n4 = 4 * (lane & 7);
#pragma unroll
    for (int i = 0; i < 8; ++i) { const int kk = (lane >> 3) + 8 * i;
        const f32x4 v = n4 < ncv ? *(const f32x4*)(W + (size_t)(k0 + kk) * ldw + c0 + n4) : (f32x4){0.f, 0.f, 0.f, 0.f};
        LAS float* d = scr + kk * 33 + n4; d[0] = v[0]; d[1] = v[1]; d[2] = v[2]; d[3] = v[3]; }
    LDS_WAIT(); asm volatile("" ::: "memory");
    const int c = lane & 7;
#pragma unroll
    for (int j = 0; j < 4; ++j) { const int n = (lane >> 3) + 8 * j; const LAS float* s = scr + (8 * c) * 33 + n;
        u32x4 o; o.x = cvt_pk_bf16(s[0 * 33], s[1 * 33]); o.y = cvt_pk_bf16(s[2 * 33], s[3 * 33]); o.z = cvt_pk_bf16(s[4 * 33], s[5 * 33]); o.w = cvt_pk_bf16(s[6 * 33], s[7 * 33]);
        *(GAS u32x4*)((GAS char*)WT + pg8::b_img_off(n0 + n, k0 + 8 * c, K)) = o; }
    LDS_WAIT(); asm volatile("" ::: "memory");
}
__device__ __forceinline__ int w1_src_col(int n) {
    if (n < 4096) return n;
    if (n < 10240) return n + 2064;
    if (n < 12288) return n - 6128;
    if (n < 12304) return n - 8192;
    return -1;
}
__device__ __forceinline__ void rms_row_to_bf16(const float* xrow, const float* g, bf16_t* orow, int lane) {
    GAS unsigned long long* o8 = (GAS unsigned long long*)orow + lane;
    if (!xrow) {
#pragma unroll
        for (int j = 0; j < 8; ++j) o8[64 * j] = 0ull;
        return; }
    const GAS f32x4* xr = (const GAS f32x4*)xrow + lane; const GAS f32x4* gr = (const GAS f32x4*)g + lane;
    f32x4 v[8]; float s = 0.f;
#pragma unroll
    for (int j = 0; j < 8; ++j) { v[j] = xr[64 * j]; s += (v[j].x * v[j].x + v[j].y * v[j].y) + (v[j].z * v[j].z + v[j].w * v[j].w); }
    const float rs = 1.0f / sqrtf(wave_sum(s) * (1.f / DM) + EPS);
#pragma unroll
    for (int j = 0; j < 8; ++j) { const f32x4 gg = gr[64 * j];
        o8[64 * j] = (unsigned long long)cvt_pk_bf16(v[j].x * rs * gg.x, v[j].y * rs * gg.y) | ((unsigned long long)cvt_pk_bf16(v[j].z * rs * gg.z, v[j].w * rs * gg.w) << 32); }
}
constexpr int CV_WG = 32 * 128, CV_SQ = 32 * 64, CV_F1 = 32 * 256, CV_F2 = 128 * 64, CV_TOTAL = CV_WG + 3 * CV_SQ + CV_F1 + CV_F2;
static_assert(CV_TOTAL % 32 == 0, "conv items");
__device__ __forceinline__ void conv_item(Frame& F, int r, LAS float* scr) {
    const float* W; int ldw, K, c0, k0, n0; size_t wt;
    if (r < CV_WG) { const int kb = r / 128, nb = r % 128; W = inp(7); ldw = 16400; K = DM; c0 = 12304 + nb * 32; k0 = kb * 64; wt = WS_WGATE; n0 = nb * 32; }
    else if (r < CV_WG + 3 * CV_SQ) { r -= CV_WG; const int which = r / CV_SQ; r -= which * CV_SQ; const int kb = r / 64, nb = r % 64;
        W = which == 0 ? inp(16) : (which == 1 ? inp(17) : inp(18)); ldw = DM; K = DM; c0 = nb * 32; k0 = kb * 64; wt = which == 0 ? WS_WBRG : (which == 1 ? WS_WBRD : WS_WO); n0 = nb * 32; }
    else if (r < CV_WG + 3 * CV_SQ + CV_F1) { r -= CV_WG + 3 * CV_SQ; const int kb = r / 256, nb = r % 256; W = inp(21); ldw = DFF; K = DM; c0 = nb * 32; k0 = kb * 64; wt = WS_WFF1; n0 = nb * 32; }
    else { r -= CV_WG + 3 * CV_SQ + CV_F1; const int kb = r / 64, nb = r % 64; W = inp(22); ldw = DM; K = DFF; c0 = nb * 32; k0 = kb * 64; wt = WS_WFF2; n0 = nb * 32; }
    transpose_item(W, ldw, K, c0, 32, k0, (bf16_t*)(wsp() + wt), n0, scr, LANE);
}
__device__ __forceinline__ void p0_prologue(Frame& F) {
    LAS float* scr = (LAS float*)(F.lds + RING_OFF + F.wave * 16384);
    const float* w_in = inp(7);
    constexpr int I_W1 = 32 * (N1 / 32);
    for (int it = F.gw; it < I_W1; it += F.NGW) {
        const int kb = it / (N1 / 32), nb = it % (N1 / 32), n0 = nb * 32; const int sc = w1_src_col(n0);
        const int ncv = sc < 0 ? 0 : (n0 == 12288 ? 16 : 32);
        transpose_item(w_in, 16400, DM, sc < 0 ? 0 : sc, ncv, kb * 64, (bf16_t*)(wsp() + WS_W1G), n0, scr, LANE); }
    { float2* tab = (float2*)(wsp() + WS_ROPE);
      for (int i = blockIdx.x * 512 + TID; i < LP * 16; i += F.G * 512) { const int pos = i >> 4, k = i & 15;
          const float invf = powf(500000.0f, -(float)(2 * k) / 32.0f); const float ang = (float)pos * invf; float sn, cs; sincosf(ang, &sn, &cs); tab[i] = make_float2(cs, sn); } }
    { bf16_t* U = (bf16_t*)(outp() + O_YP);
      for (int m = F.gw; m < TP; m += F.NGW) { float* y; const float* x = row_x(F, m, y); rms_row_to_bf16(x, inp(6), U + (size_t)m * DM, LANE); } }
}

struct EpiP1 {
    static constexpr bool PERM = true;
    unsigned char* ws; float* out;
    __device__ __forceinline__ bool operator()(f32x4 (&acc)[2][2][4][2], const pg8::Unit& u, int wr, int wc, int fr, int fq) const {
        const int pn = u.pn; const int row0 = u.pm * 256 + wr * 64 + fr;
        if (pn == 48) {
            if (wc == 0 && fq < 2) { float* A = (float*)(ws + WS_ALOW);
#pragma unroll
                for (int ai = 0; ai < 2; ++ai)
#pragma unroll
                    for (int m = 0; m < 4; ++m) { float* ap = A + (size_t)(row0 + ai * 128 + m * 16) * 16 + 8 * fq; *(f32x4*)ap = acc[ai][0][m][0]; *(f32x4*)(ap + 4) = acc[ai][0][m][1]; } }
            return false; }
        if (pn < 8) {
            const float sc = pn < 4 ? 0.0625f : 1.0f; bf16_t* base = (bf16_t*)(ws + WS_GQK) + (pn < 4 ? (size_t)0 : (size_t)TP * 1024); const int h = pn & 3;
#pragma unroll
            for (int ai = 0; ai < 2; ++ai)
#pragma unroll
                for (int m = 0; m < 4; ++m) { const int row = row0 + ai * 128 + m * 16; bf16_t* rp = base + ((size_t)((row >> 6) * 4 + h) * 64 + (row & 63)) * 256 + wc * 32 + 8 * fq;
#pragma unroll
                    for (int bj = 0; bj < 2; ++bj) { const f32x4 v0 = acc[ai][bj][m][0] * sc, v1 = acc[ai][bj][m][1] * sc;
                        *(u32x4*)(rp + bj * 128) = (u32x4){cvt_pk_bf16(v0[0], v0[1]), cvt_pk_bf16(v0[2], v0[3]), cvt_pk_bf16(v1[0], v1[1]), cvt_pk_bf16(v1[2], v1[3])}; } }
            return false; }
        const bool rope = (pn >= 16 && pn < 32) && wc == 0;
        const bool f32o = (pn >= 24 && pn < 40);
        bf16_t* base; int c0; size_t rpitch = DM, bjs = 128;
        if (pn < 16) { base = (bf16_t*)(ws + WS_GV); c0 = (pn - 8) * 256; }
        else if (pn < 24) { base = (bf16_t*)(ws + WS_DQ); c0 = (pn - 16) * 256; }
        else if (pn < 32) { base = (bf16_t*)(ws + WS_KB) + (size_t)(pn - 24) * 2 * TP * 128; c0 = (pn - 24) * 256; rpitch = 128; bjs = (size_t)TP * 128; }
        else if (pn < 40) { base = (bf16_t*)(ws + WS_VB) + (size_t)(pn - 32) * TP * 256; c0 = (pn - 32) * 256; rpitch = 256; }
        else { base = (bf16_t*)(ws + WS_RB); c0 = (pn - 40) * 256; }
        const bool silu = pn >= 40;
        const float2* tab = (const float2*)(ws + WS_ROPE);
        const bool up = fq >= 2;
#pragma unroll
        for (int ai = 0; ai < 2; ++ai)
#pragma unroll
            for (int m = 0; m < 4; ++m) { const int row = row0 + ai * 128 + m * 16;
                f32x4 v[2][2];
#pragma unroll
                for (int bj = 0; bj < 2; ++bj) { v[bj][0] = acc[ai][bj][m][0]; v[bj][1] = acc[ai][bj][m][1]; }
                if (rope) { const int pos = row_pos(row); const f32x4* tp = (const f32x4*)(tab + (size_t)pos * 16 + 8 * (fq & 1));
                    const f32x4 t0 = tp[0], t1 = tp[1], t2 = tp[2], t3 = tp[3];
                    const f32x4 cs[2] = {(f32x4){t0[0], t0[2], t1[0], t1[2]}, (f32x4){t2[0], t2[2], t3[0], t3[2]}}, sn[2] = {(f32x4){t0[1], t0[3], t1[1], t1[3]}, (f32x4){t2[1], t2[3], t3[1], t3[3]}};
#pragma unroll
                    for (int bj = 0; bj < 2; ++bj)
#pragma unroll
                        for (int n = 0; n < 2; ++n) { f32x4 o;
#pragma unroll
                            for (int j = 0; j < 4; ++j) { const float own = v[bj][n][j];
                                auto rr = __builtin_amdgcn_permlane32_swap(__float_as_uint(own), __float_as_uint(own), false, false);
                                const float oth = __uint_as_float(up ? rr[0] : rr[1]);
                                o[j] = own * cs[n][j] + (up ? oth : -oth) * sn[n][j]; }
                            v[bj][n] = o; } }
                if (silu) {
#pragma unroll
                    for (int bj = 0; bj < 2; ++bj)
#pragma unroll
                        for (int n = 0; n < 2; ++n)
#pragma unroll
                            for (int j = 0; j < 4; ++j) { const float x = v[bj][n][j]; v[bj][n][j] = x * sigmoidf_(x); } }
                bf16_t* rp = base + (size_t)row * rpitch + ((pn >= 24 && pn < 40) ? 0 : c0) + wc * 32 + 8 * fq;
                const bool vimg = pn >= 32 && pn < 40;
                if (pn >= 24 && pn < 32) rp = base + (size_t)row * rpitch + 8 * ((wc * 4 + fq) ^ (row & 7));
                bf16_t* vt = base + (size_t)(row >> 5) * 8192;
#pragma unroll
                for (int bj = 0; bj < 2; ++bj)
                    *(u32x4*)(vimg ? vt + (v_img_off(row & 31, bj * 128 + wc * 32 + 8 * fq) >> 1) : rp + bj * bjs) = (u32x4){cvt_pk_bf16(v[bj][0][0], v[bj][0][1]), cvt_pk_bf16(v[bj][0][2], v[bj][0][3]), cvt_pk_bf16(v[bj][1][0], v[bj][1][1]), cvt_pk_bf16(v[bj][1][2], v[bj][1][3])};
                if (f32o) { bool smp; const long kr = row_kv(row, smp);
                    if (kr >= 0) { float* op = out + (pn < 32 ? (smp ? O_KS : O_KP) : (smp ? O_VS : O_VP)) + (size_t)kr * DM + c0 + wc * 32 + 8 * fq;
#pragma unroll
                        for (int bj = 0; bj < 2; ++bj) { *(f32x4*)(op + bj * 128) = v[bj][0]; *(f32x4*)(op + bj * 128 + 4) = v[bj][1]; } } }
            }
        return false;
    }
};

__device__ __forceinline__ float logsigmoid_(float x) { const float e = __expf(-fabsf(x)); return fminf(x, 0.f) - __logf(1.0f + e); }
__device__ __forceinline__ int qperm32(int c32) { return 8 * ((c32 >> 2) & 3) + 4 * (c32 >> 4) + (c32 & 3); }
constexpr int P2_ALOW = 0, P2_TOT = 4096, P2_QS = 8192, P2_PITCH = 528, P2_KS = P2_QS + 64 * P2_PITCH;
__device__ __forceinline__ void p2_unit(Frame& F, int g, int h) {
    LAS unsigned char* L = F.lds + RING_OFF;
    LAS float* alow_s = (LAS float*)(L + P2_ALOW); LAS float* tot = (LAS float*)(L + P2_TOT);
    const int row0 = g * 64, tid = TID, c = tid & 255, hf = tid >> 8, ch = h * 256 + c;
    const int padn = (row0 < SR0 && (row0 % BS) == 192) ? 48 : 0;
    bf16_t* qimg = (bf16_t*)(wsp() + WS_GQK) + (size_t)(g * 4 + h) * 16384; bf16_t* kimg = qimg + (size_t)TP * 1024;
    if (tid < 256) *(LAS f32x4*)(alow_s + tid * 4) = *(const f32x4*)((const float*)(wsp() + WS_ALOW) + (size_t)row0 * 16 + tid * 4);
#pragma unroll
    for (int j = 0; j < 4; ++j) { const int q = tid + 512 * j;
        *(LAS u32x4*)(L + P2_QS + (q >> 5) * P2_PITCH + (q & 31) * 16) = *(const u32x4*)(qimg + (size_t)q * 8);
        *(LAS u32x4*)(L + P2_KS + (q >> 5) * P2_PITCH + (q & 31) * 16) = *(const u32x4*)(kimg + (size_t)q * 8); }
    float wa[16];
#pragma unroll
    for (int j = 0; j < 16; ++j) wa[j] = inp(8)[j * 1024 + ch];
    const float ba = inp(9)[ch];
    __syncthreads();
    float b[32]; float run = 0.f;
#pragma unroll
    for (int i = 0; i < 32; ++i) { const int t = 32 * hf + i; float x = ba;
#pragma unroll
        for (int j4 = 0; j4 < 4; ++j4) { const f32x4 av = *(const LAS f32x4*)(alow_s + t * 16 + 4 * j4); x = fmaf(av[0], wa[4 * j4], x); x = fmaf(av[1], wa[4 * j4 + 1], x); x = fmaf(av[2], wa[4 * j4 + 2], x); x = fmaf(av[3], wa[4 * j4 + 3], x); }
        const float la = t < padn ? 0.f : logsigmoid_(x) * 0.0625f; run += la; b[i] = run; }
    tot[hf * 256 + c] = run;
    __syncthreads();
    const float bmid = tot[c], blast = tot[c] + tot[256 + c];
    if (hf == 1) {
#pragma unroll
        for (int i = 0; i < 32; ++i) b[i] += bmid; }
    if (hf == 0) ((float*)(wsp() + WS_DECAY))[(size_t)g * 1024 + ch] = __expf(blast);
    LAS bf16_t* QS = (LAS bf16_t*)(L + P2_QS); LAS bf16_t* KS = (LAS bf16_t*)(L + P2_KS);
    const int cs = (c & ~31) + qperm32(c & 31);
    unsigned kd[16];
    const float ebm = __expf(bmid), elb = __expf(blast - bmid);
#pragma unroll
    for (int i = 0; i < 32; i += 2) {
        float kdv[2], qh[2], qsv[2], ksv[2];
#pragma unroll
        for (int e = 0; e < 2; ++e) { const int t = 32 * hf + i + e; const float q = bf2f(QS[t * (P2_PITCH / 2) + c]), k = bf2f(KS[t * (P2_PITCH / 2) + c]);
            const float e1 = __expf(b[i + e] - bmid), r1 = __builtin_amdgcn_rcpf(e1);
            qsv[e] = q * e1; ksv[e] = k * r1; qh[e] = qsv[e] * ebm; kdv[e] = ksv[e] * elb; }
        const unsigned wq = cvt_pk_bf16(qh[0], qh[1]), ws_ = cvt_pk_bf16(qsv[0], qsv[1]), wk = cvt_pk_bf16(ksv[0], ksv[1]);
        const int t0 = 32 * hf + i;
        qimg[t0 * 256 + cs] = (bf16_t)(wq & 0xffffu); qimg[(t0 + 1) * 256 + cs] = (bf16_t)(wq >> 16);
        QS[t0 * (P2_PITCH / 2) + c] = (bf16_t)(ws_ & 0xffffu); QS[(t0 + 1) * (P2_PITCH / 2) + c] = (bf16_t)(ws_ >> 16);
        KS[t0 * (P2_PITCH / 2) + c] = (bf16_t)(wk & 0xffffu); KS[(t0 + 1) * (P2_PITCH / 2) + c] = (bf16_t)(wk >> 16);
        kd[i >> 1] = cvt_pk_bf16(kdv[0], kdv[1]); }
    { u32x4* dst = (u32x4*)(kimg + (size_t)c * 64 + 32 * hf);
#pragma unroll
      for (int j = 0; j < 4; ++j) dst[j] = (u32x4){kd[4 * j], kd[4 * j + 1], kd[4 * j + 2], kd[4 * j + 3]}; }
    __syncthreads();
    { const int w = F.wave, fr = LANE & 15, fq = LANE >> 4, mt = w >> 1;
      f32x4 a2[2] = {(f32x4){0.f, 0.f, 0.f, 0.f}, (f32x4){0.f, 0.f, 0.f, 0.f}};
#pragma unroll
      for (int ks = 0; ks < 8; ++ks) { const bf16x8 qf = *(const LAS bf16x8*)(L + P2_QS + (16 * mt + fr) * P2_PITCH + (32 * ks + 8 * fq) * 2);
#pragma unroll
          for (int e = 0; e < 2; ++e) { const int nt = (w & 1) * 2 + e; const bf16x8 kf = *(const LAS bf16x8*)(L + P2_KS + (16 * nt + fr) * P2_PITCH + (32 * ks + 8 * fq) * 2);
              a2[e] = __builtin_amdgcn_mfma_f32_16x16x32_bf16(kf, qf, a2[e], 0, 0, 0); } }
      bf16_t* sc = (bf16_t*)(wsp() + WS_SCORE) + (size_t)(g * 4 + h) * 4096; const int t = 16 * mt + fr;
#pragma unroll
      for (int e = 0; e < 2; ++e) { const int s0 = ((w & 1) * 2 + e) * 16 + 4 * fq; float v[4];
#pragma unroll
          for (int i = 0; i < 4; ++i) v[i] = (s0 + i <= t) ? a2[e][i] : 0.f;
          *(u32x2*)(sc + t * 64 + s0) = (u32x2){cvt_pk_bf16(v[0], v[1]), cvt_pk_bf16(v[2], v[3])}; } }
    __syncthreads();
}
constexpr int SC_QH = 0, SC_QP = 528, SC_KD = SC_QH + 64 * SC_QP, SC_KP = 144, SC_VT = SC_KD + 256 * SC_KP, SC_SC = SC_VT + 64 * 144, SC_DC = SC_SC + 64 * 144, SC_PO = SC_DC + 1024, SC_END = SC_PO + 2 * 64 * 64 * 4;
static_assert(SC_END <= RING_BYTES, "scan LDS");
struct ScanRegs { u32x4 q[4], k[4], v, s; float d; };
__device__ __forceinline__ void scan_load(Frame& F, int g, int h, int vs, ScanRegs& R) {
    const int tid = TID;
    const bf16_t* qimg = (const bf16_t*)(wsp() + WS_GQK) + (size_t)(g * 4 + h) * 16384; const bf16_t* kimg = qimg + (size_t)TP * 1024;
#pragma unroll
    for (int j = 0; j < 4; ++j) { R.q[j] = *(const u32x4*)(qimg + (size_t)(tid + 512 * j) * 8); R.k[j] = *(const u32x4*)(kimg + (size_t)(tid + 512 * j) * 8); }
    R.v = *(const u32x4*)((const bf16_t*)(wsp() + WS_GV) + (size_t)(g * 64 + (tid >> 3)) * DM + h * 512 + vs * 64 + 8 * (tid & 7));
    R.s = *(const u32x4*)((const bf16_t*)(wsp() + WS_SCORE) + (size_t)(g * 4 + h) * 4096 + tid * 8);
    R.d = ((const float*)(wsp() + WS_DECAY))[(size_t)g * 1024 + h * 256 + (tid & 255)];
}
__device__ __forceinline__ void scan_stage(Frame& F, const ScanRegs& R) {
    LAS unsigned char* L = F.lds + RING_OFF; const int tid = TID;
#pragma unroll
    for (int j = 0; j < 4; ++j) { const int q = tid + 512 * j;
        *(LAS u32x4*)(L + SC_QH + (q >> 5) * SC_QP + (q & 31) * 16) = R.q[j];
        *(LAS u32x4*)(L + SC_KD + (q >> 3) * SC_KP + (q & 7) * 16) = R.k[j]; }
    { const int s = tid >> 3, v0 = 8 * (tid & 7); LAS bf16_t* vt = (LAS bf16_t*)(L + SC_VT);
#pragma unroll
      for (int j = 0; j < 4; ++j) { const unsigned w = R.v[j]; vt[(v0 + 2 * j) * 72 + s] = (bf16_t)(w & 0xffffu); vt[(v0 + 2 * j + 1) * 72 + s] = (bf16_t)(w >> 16); } }
    *(LAS u32x4*)(L + SC_SC + (tid >> 3) * 144 + (tid & 7) * 16) = R.s;
    if (tid < 256) ((LAS float*)(L + SC_DC))[tid] = R.d;
}
__device__ __forceinline__ void scan_unit(Frame& F, int seq, int h, int vs) {
    LAS unsigned char* L = F.lds + RING_OFF;
    int lane = LANE; asm volatile("" : "+v"(lane));
    const int w = F.wave, tid = w * 64 + lane, fr = lane & 15, fq = lane >> 4, vg = w & 3, chf = w >> 2;
    const bool smp = seq >= 2; const int s_i = seq - 2;
    const int g0 = smp ? 520 + s_i : 260 * seq + 3, ng = smp ? 1 : 257;
    const size_t st_off = smp ? O_SS + (size_t)(s_i * 4 + h) * 131072 : O_SP + (size_t)(seq * 4 + h) * 131072;
    const int vcol = vs * 64 + 16 * vg + fr;
    f32x4 Sa[8];
#pragma unroll
    for (int mt = 0; mt < 8; ++mt) {
        if (smp) { const float* sp = inp(4) + (size_t)(s_i * 4 + h) * 131072 + (size_t)(128 * chf + 16 * mt + 4 * fq) * 512 + vcol;
            Sa[mt] = (f32x4){sp[0], sp[512], sp[1024], sp[1536]}; }
        else Sa[mt] = (f32x4){0.f, 0.f, 0.f, 0.f}; }
    ScanRegs R; scan_load(F, g0, h, vs, R);
    for (int gi = 0; gi < ng; ++gi) {
        const int g = g0 + gi;
        scan_stage(F, R);
        __syncthreads();
        if (gi + 1 < ng) scan_load(F, g + 1, h, vs, R);
        f32x4 po[4];
#pragma unroll
        for (int mt = 0; mt < 4; ++mt) po[mt] = (f32x4){0.f, 0.f, 0.f, 0.f};
#pragma unroll
        for (int ks = 0; ks < 4; ++ks) {
            u32x4 bw = {cvt_pk_bf16(Sa[2 * ks][0], Sa[2 * ks][1]), cvt_pk_bf16(Sa[2 * ks][2], Sa[2 * ks][3]), cvt_pk_bf16(Sa[2 * ks + 1][0], Sa[2 * ks + 1][1]), cvt_pk_bf16(Sa[2 * ks + 1][2], Sa[2 * ks + 1][3])};
            const bf16x8 bfrag = __builtin_bit_cast(bf16x8, bw);
#pragma unroll
            for (int mt = 0; mt < 4; ++mt) { const bf16x8 af = *(const LAS bf16x8*)(L + SC_QH + (16 * mt + fr) * SC_QP + (128 * chf + 32 * ks + 8 * fq) * 2);
                po[mt] = __builtin_amdgcn_mfma_f32_16x16x32_bf16(af, bfrag, po[mt], 0, 0, 0); } }
        { const bf16x8 vf = *(const LAS bf16x8*)(L + SC_VT + (16 * vg + fr) * 144 + (32 * chf + 8 * fq) * 2);
#pragma unroll
          for (int mt = 0; mt < 4; ++mt) { const bf16x8 sf = *(const LAS bf16x8*)(L + SC_SC + (16 * mt + fr) * 144 + (32 * chf + 8 * fq) * 2);
              po[mt] = __builtin_amdgcn_mfma_f32_16x16x32_bf16(sf, vf, po[mt], 0, 0, 0); } }
        { LAS float* PO = (LAS float*)(L + SC_PO) + chf * 4096;
#pragma unroll
          for (int mt = 0; mt < 4; ++mt)
#pragma unroll
              for (int i = 0; i < 4; ++i) PO[(16 * mt + 4 * fq + i) * 64 + 16 * vg + fr] = po[mt][i]; }
        { bf16x8 vf[2];
#pragma unroll
          for (int ks = 0; ks < 2; ++ks) vf[ks] = *(const LAS bf16x8*)(L + SC_VT + (16 * vg + fr) * 144 + (32 * ks + 8 * fq) * 2);
#pragma unroll
          for (int mt = 0; mt < 8; ++mt) { const f32x4 dc = *(const LAS f32x4*)(L + SC_DC + (128 * chf + 16 * mt + 4 * fq) * 4); Sa[mt] = Sa[mt] * dc;
#pragma unroll
              for (int ks = 0; ks < 2; ++ks) { const bf16x8 kf = *(const LAS bf16x8*)(L + SC_KD + (128 * chf + 16 * mt + fr) * SC_KP + (32 * ks + 8 * fq) * 2);
                  Sa[mt] = __builtin_amdgcn_mfma_f32_16x16x32_bf16(kf, vf[ks], Sa[mt], 0, 0, 0); } } }
        __syncthreads();
        { const int t = tid >> 3, vc = 8 * (tid & 7); const LAS float* P0 = (const LAS float*)(L + SC_PO) + t * 64 + vc; const LAS float* P1 = P0 + 4096;
          const f32x4 a0 = *(const LAS f32x4*)P0, a1 = *(const LAS f32x4*)(P0 + 4), b0 = *(const LAS f32x4*)P1, b1 = *(const LAS f32x4*)(P1 + 4);
          const f32x4 s0 = a0 + b0, s1 = a1 + b1;
          *(u32x4*)((bf16_t*)(wsp() + WS_GV) + (size_t)(g * 64 + t) * DM + h * 512 + vs * 64 + vc) = (u32x4){cvt_pk_bf16(s0[0], s0[1]), cvt_pk_bf16(s0[2], s0[3]), cvt_pk_bf16(s1[0], s1[1]), cvt_pk_bf16(s1[2], s1[3])}; }
        __syncthreads();
    }
#pragma unroll
    for (int mt = 0; mt < 8; ++mt) { float* sp = outp() + st_off + (size_t)(128 * chf + 16 * mt + 4 * fq) * 512 + vcol;
#pragma unroll
        for (int i = 0; i < 4; ++i) sp[(size_t)i * 512] = Sa[mt][i]; }
}
__device__ __forceinline__ float diff_lambda(const Frame& F) {
    float s1 = 0.f, s2 = 0.f;
    for (int i = 0; i < 128; ++i) { s1 = fmaf(inp(11)[i], inp(12)[i], s1); s2 = fmaf(inp(13)[i], inp(14)[i], s2); }
    return expf(s1) - expf(s2) + 0.2f;
}
__device__ __forceinline__ void attn_item(Frame& F, int b, int h, int I, float lam) {
    const bf16_t* Dq = (const bf16_t*)(wsp() + WS_DQ); const bf16_t* Kb = (const bf16_t*)(wsp() + WS_KB); const bf16_t* Vb = (const bf16_t*)(wsp() + WS_VB);
    const size_t brow = (size_t)b * BS;
    att8::PassRef r0;
    r0.Q = Dq + (brow + (size_t)I * 256) * DM + h * 256; r0.K = Kb + ((size_t)(h * 2) * TP + brow) * 128; r0.V = Vb + ((size_t)h * TP + brow) * 256;
    r0.jlo = 7; r0.jhi = 8 * I + 8; r0.lastbase = I == 0 ? 7 : 8 * I + 1; r0.first = I == 0;
    float* stash = outp() + O_YP + (size_t)36700160 + (size_t)blockIdx.x * 65536;
    bf16_t* Oo = (bf16_t*)(wsp() + WS_OD) + (brow + (size_t)I * 256) * DM + h * 256;
    for (int map = 0; map < 2; ++map) {
        att8::attn_pass(map, r0, F.lds + RING_OFF, stash, Oo, lam, F.wave);
        r0.Q += 128; r0.K += (size_t)TP * 128; }
}
__device__ __forceinline__ void attn_sample_item(Frame& F, int b, int h, float lam) {
    using namespace att;
    char* lds = (char*)(F.lds + RING_OFF);
    int lane = LANE; asm volatile("" : "+v"(lane));
    const int wid = F.wave, tid = wid * 64 + lane, r32 = lane & 31, hi = lane >> 5;
    const int map = wid & 1, rh = (wid >> 1) & 1, vhf = wid >> 2;
    char* V_lds = lds; char* K_lds = lds + 2 * SHM_V;
    float* wsl = (float*)(lds + 2 * SHM_V + 2 * SHM_K) + wid * 64; float* li_l = wsl, * al_l = wsl + 32;
    const int sr = tid >> 4, sc = (tid & 15) * 8, vst0 = v_st(sr, sc), vst1 = v_st(32 + sr, sc), kws = KSWZ(sr, sc * 2);
    const int vb0 = (int)(uintptr_t)V_lds + vhf * SHM_V + v_rd_base(lane);
    const bf16_t* Dq = (const bf16_t*)(wsp() + WS_DQ); const bf16_t* Kb = (const bf16_t*)(wsp() + WS_KB); const bf16_t* Vb = (const bf16_t*)(wsp() + WS_VB);
    const size_t srow = (size_t)SR0 + (size_t)b * 64;
    bf16x8 qr[8];
#pragma unroll
    for (int d0 = 0; d0 < 8; ++d0) qr[d0] = load8(Dq + (srow + 32 * rh + r32) * DM + h * 256 + map * 128 + d0 * 16 + hi * 8);
    float m_reg = -1e30f, l_reg = 0.f; f32x16 o[4] = {};
    const float* ck = inp(2) + ((size_t)b * PAST * 8 + h) * 256; const float* cv = inp(3) + ((size_t)b * PAST * 8 + h) * 256;
    f32x4 R[16];
#define SMP_LOAD(jj) do { if ((jj) < 16) { _Pragma("unroll") for (int part = 0; part < 4; ++part) { const float* xp = (part < 2 ? ck : cv) + (size_t)(64 * (jj) + sr) * 2048 + (part & 1) * 128 + sc;   \
            R[4 * part] = *(const f32x4*)xp; R[4 * part + 1] = *(const f32x4*)(xp + 4); R[4 * part + 2] = *(const f32x4*)(xp + 32 * 2048); R[4 * part + 3] = *(const f32x4*)(xp + 32 * 2048 + 4); } }   \
        else { _Pragma("unroll") for (int part = 0; part < 4; ++part) { const bf16_t* xp = part < 2 ? Kb + ((size_t)(h * 2 + part) * TP + srow + sr) * 128 + 8 * ((sc >> 3) ^ (sr & 7)) : Vb + ((size_t)h * TP + srow) * 256 + (v_img_off(sr, (part & 1) * 128 + sc) >> 1);   \
            const u32x4 u0 = *(const u32x4*)xp, u1 = *(const u32x4*)(xp + (size_t)(part < 2 ? 32 * 128 : 8192));   \
            R[4 * part] = (f32x4){bf_lo(u0[0]), bf_hi(u0[0]), bf_lo(u0[1]), bf_hi(u0[1])}; R[4 * part + 1] = (f32x4){bf_lo(u0[2]), bf_hi(u0[2]), bf_lo(u0[3]), bf_hi(u0[3])};   \
            R[4 * part + 2] = (f32x4){bf_lo(u1[0]), bf_hi(u1[0]), bf_lo(u1[1]), bf_hi(u1[1])}; R[4 * part + 3] = (f32x4){bf_lo(u1[2]), bf_hi(u1[2]), bf_lo(u1[3]), bf_hi(u1[3])}; } } } while (0)
    SMP_LOAD(0);
    for (int j = 0; j < 17; ++j) {
#pragma unroll
        for (int part = 0; part < 4; ++part) { const int sub = part & 1;
            const f32x4 a0 = R[4 * part], a1 = R[4 * part + 1], a2 = R[4 * part + 2], a3 = R[4 * part + 3];
            u32x4 w0 = (u32x4){cvt_pk_bf16(a0[0], a0[1]), cvt_pk_bf16(a0[2], a0[3]), cvt_pk_bf16(a1[0], a1[1]), cvt_pk_bf16(a1[2], a1[3])};
            u32x4 w1 = (u32x4){cvt_pk_bf16(a2[0], a2[1]), cvt_pk_bf16(a2[2], a2[3]), cvt_pk_bf16(a3[0], a3[1]), cvt_pk_bf16(a3[2], a3[3])};
            const bf16x8 x0 = __builtin_bit_cast(bf16x8, w0), x1 = __builtin_bit_cast(bf16x8, w1);
            if (part < 2) { *(bf16x8*)(K_lds + sub * SHM_K + kws) = x0; *(bf16x8*)(K_lds + sub * SHM_K + kws + 32 * 256) = x1; }
            else { *(bf16x8*)(V_lds + sub * SHM_V + vst0) = x0; *(bf16x8*)(V_lds + sub * SHM_V + vst1) = x1; } }
        __syncthreads();
        if (j + 1 < 17) SMP_LOAD(j + 1);
        f32x16 p0, p1; float mn, al; bf16x8 pa0, pa1, pa2, pa3;
        qkt<0>(p0, p1, K_lds + map * SHM_K, r32, hi, qr, true);
        partialSM(p0, p1, m_reg, mn, al);
        finishSM(p0, p1, al, l_reg, pa0, pa1, pa2, pa3);
        if (__any(al < 1.f)) { if (hi == 0) al_l[r32] = al; asm volatile("s_waitcnt lgkmcnt(0)" ::: "memory");
            for (int d_ = 0; d_ < 4; ++d_) for (int r = 0; r < 16; ++r) o[d_][r] *= al_l[crow(r, hi)]; }
        pv_tile<0>(o, vb0, pa0, pa1, pa2, pa3, true);
        __syncthreads();
    }
#undef SMP_LOAD
    if (hi == 0) li_l[r32] = l_reg; asm volatile("s_waitcnt lgkmcnt(0)" ::: "memory");
    int hie = hi; asm volatile("" : "+v"(hie));
    float rli[16];
#pragma unroll
    for (int r = 0; r < 16; ++r) rli[r] = __builtin_amdgcn_rcpf(li_l[crow(r, hie)]);
    float* X = (float*)lds + ((vhf * 2 + rh) * 32 + 4 * hie) * 128 + r32;
    if (map == 1) {
#pragma unroll
        for (int r = 0; r < 16; ++r)
#pragma unroll
            for (int d0 = 0; d0 < 4; ++d0) X[((r & 3) + 8 * (r >> 2)) * 128 + d0 * 32] = lam * (o[d0][r] * rli[r]); }
    __syncthreads();
    if (map == 0) { bf16_t* Ow = (bf16_t*)(wsp() + WS_OD) + (srow + 32 * rh + 4 * hie) * DM + h * 256 + vhf * 128 + r32;
#pragma unroll
        for (int r = 0; r < 16; ++r) { const int ro = (r & 3) + 8 * (r >> 2);
#pragma unroll
            for (int d0 = 0; d0 < 4; ++d0) { const float v = o[d0][r] * rli[r] - X[ro * 128 + d0 * 32]; const float vn = xor1(v);
                if ((r32 & 1) == 0) *(unsigned*)(Ow + ro * DM + d0 * 32) = cvt_pk_bf16(v, vn); } } }
    __syncthreads();
}
constexpr int Q_SCAN_P = 64, Q_SCAN_S = 1024, Q_ATT_P = 1040, Q_ATT_S = 256, Q_TOTAL = Q_SCAN_P + Q_SCAN_S + Q_ATT_P + Q_ATT_S;
__device__ __forceinline__ int q_next(Frame& F, int slot) {
    __syncthreads();
    if (TID == 0) { gu32* qp = ((gu32*)wsp()) + CW_QUEUE + 64 * slot; unsigned old_, zero_ = 0u, one_ = 1u;
        asm volatile("global_atomic_add %0, %1, %2, %3 sc0\n\ts_waitcnt vmcnt(0)" : "=&v"(old_) : "v"(zero_), "v"(one_), "s"(qp) : "memory");
        F.MISC[4] = old_; }
    __syncthreads();
    volatile LAS unsigned* mp = F.MISC + 4; asm volatile("" : "+v"(mp));
    return __builtin_amdgcn_readfirstlane((int)*mp);
}
__device__ __forceinline__ void p3_run(Frame& F) {
    const float lam = __uint_as_float(__builtin_amdgcn_readfirstlane(__float_as_uint(diff_lambda(F))));
    for (;;) { const int it = q_next(F, 0); if (it >= Q_SCAN_P + Q_SCAN_S) break;
        if (it < Q_SCAN_P) scan_unit(F, (it & 7) >> 2, it & 3, it >> 3);
        else { const int j = it - Q_SCAN_P; scan_unit(F, 2 + (j >> 5), (j >> 3) & 3, j & 7); } }
    for (;;) { const int it = q_next(F, 2); if (it >= Q_ATT_S) break; attn_sample_item(F, it >> 3, it & 7, lam); }
    for (;;) { const int it = q_next(F, 1); if (it >= Q_ATT_P) break;
        const int bb = it >= 520 ? 1 : 0, r_ = it - 520 * bb, I = 64 - (r_ >> 3); attn_item(F, bb, r_ & 7, I, lam); }
    { LAS float* scr = (LAS float*)(F.lds + RING_OFF + F.wave * 16384);
      for (;;) { const int it = q_next(F, 3); if (it >= CV_TOTAL / 32) break;
          for (int s_ = 0; s_ < 4; ++s_) conv_item(F, it * 32 + s_ * 8 + F.wave, scr); } }
}

__device__ __forceinline__ void p4_row(Frame& F, int m) {
    const int lane = LANE;
    { u32x4* op = (u32x4*)((bf16_t*)(wsp() + WS_GV) + (size_t)m * DM) + lane; const u32x4* rp = (const u32x4*)((const bf16_t*)(wsp() + WS_RB) + (size_t)m * DM) + lane;
      const f32x4* gp = (const f32x4*)inp(10) + lane * 2;
      const f32x4 g0 = gp[0], g1 = gp[1];
      u32x4 ov[4], rv[4];
#pragma unroll
      for (int j = 0; j < 4; ++j) { ov[j] = op[64 * j]; rv[j] = rp[64 * j]; }
#pragma unroll
      for (int j = 0; j < 4; ++j) { float ss = 0.f;
#pragma unroll
          for (int e = 0; e < 4; ++e) { const float a = bf_lo(ov[j][e]), b = bf_hi(ov[j][e]); ss += a * a + b * b; }
          const float rs = 1.0f / sqrtf(wave_sum(ss) * (1.f / 512.f) + EPS);
          u32x4 w;
          w[0] = cvt_pk_bf16(bf_lo(ov[j][0]) * rs * g0[0] * bf_lo(rv[j][0]), bf_hi(ov[j][0]) * rs * g0[1] * bf_hi(rv[j][0]));
          w[1] = cvt_pk_bf16(bf_lo(ov[j][1]) * rs * g0[2] * bf_lo(rv[j][1]), bf_hi(ov[j][1]) * rs * g0[3] * bf_hi(rv[j][1]));
          w[2] = cvt_pk_bf16(bf_lo(ov[j][2]) * rs * g1[0] * bf_lo(rv[j][2]), bf_hi(ov[j][2]) * rs * g1[1] * bf_hi(rv[j][2]));
          w[3] = cvt_pk_bf16(bf_lo(ov[j][3]) * rs * g1[2] * bf_lo(rv[j][3]), bf_hi(ov[j][3]) * rs * g1[3] * bf_hi(rv[j][3]));
          op[64 * j] = w; } }
    { u32x4* op = (u32x4*)((bf16_t*)(wsp() + WS_OD) + (size_t)m * DM) + lane;
      const f32x4* gp = (const f32x4*)inp(15) + (lane & 31) * 2;
      const f32x4 g0 = gp[0], g1 = gp[1];
      u32x4 ov[4];
#pragma unroll
      for (int j = 0; j < 4; ++j) ov[j] = op[64 * j];
#pragma unroll
      for (int j = 0; j < 4; ++j) { float ss = 0.f;
#pragma unroll
          for (int e = 0; e < 4; ++e) { const float a = bf_lo(ov[j][e]), b = bf_hi(ov[j][e]); ss += a * a + b * b; }
          ss += __shfl_xor(ss, 1); ss += __shfl_xor(ss, 2); ss += __shfl_xor(ss, 4); ss += __shfl_xor(ss, 8); ss += __shfl_xor(ss, 16);
          const float rs = 0.8f / sqrtf(ss * (1.f / 256.f) + EPS);
          u32x4 w;
          w[0] = cvt_pk_bf16(bf_lo(ov[j][0]) * rs * g0[0], bf_hi(ov[j][0]) * rs * g0[1]);
          w[1] = cvt_pk_bf16(bf_lo(ov[j][1]) * rs * g0[2], bf_hi(ov[j][1]) * rs * g0[3]);
          w[2] = cvt_pk_bf16(bf_lo(ov[j][2]) * rs * g1[0], bf_hi(ov[j][2]) * rs * g1[1]);
          w[3] = cvt_pk_bf16(bf_lo(ov[j][3]) * rs * g1[2], bf_hi(ov[j][3]) * rs * g1[3]);
          op[64 * j] = w; } }
}

#define OPAQUE(p) asm volatile("" : "+v"(p))
template <int MODE> struct EpiGate {
    static constexpr bool PERM = true;
    u32x4* st0; const u32x4* st1; bf16_t* O;
    __device__ __forceinline__ bool operator()(f32x4 (&acc)[2][2][4][2], const pg8::Unit& u, int wr, int wc, int fr, int fq) const {
        int tid = (wr * 4 + wc) * 64 + lane_id(); OPAQUE(tid);
        const size_t tb = (size_t)(u.pm * 8 + u.pn) * 8192 + tid;
        u32x4* p0 = st0 + tb; const u32x4* p1 = st1 + tb;
        bf16_t* op = O + (size_t)(u.pm * 256 + wr * 64 + (tid & 15)) * DM + u.pn * 256 + wc * 32 + 8 * ((tid >> 4) & 3);
        constexpr int PD = 4;
        const u32x4* l1 = p1; const u32x4* l0 = p0; u32x4 rb[PD], qb[PD];
        if (MODE != 0) {
#pragma unroll
            for (int k = 0; k < PD; ++k) { rb[k] = *l1; if (MODE == 2) qb[k] = *l0; l1 += 512; l0 += 512; OPAQUE(l1); OPAQUE(l0); }
            __builtin_amdgcn_sched_barrier(0); }
#pragma unroll
        for (int g = 0; g < 16; ++g) { const int ai = g >> 3, bj = (g >> 2) & 1, m = g & 3; const f32x4 x = acc[ai][bj][m][0], y = acc[ai][bj][m][1];
            if (MODE == 0) { *p0 = (u32x4){cvt_pk_bf16(sigmoidf_(x[0]), sigmoidf_(x[1])), cvt_pk_bf16(sigmoidf_(x[2]), sigmoidf_(x[3])), cvt_pk_bf16(sigmoidf_(y[0]), sigmoidf_(y[1])), cvt_pk_bf16(sigmoidf_(y[2]), sigmoidf_(y[3]))}; }
            else { const u32x4 r = rb[g % PD]; const u32x4 q = MODE == 2 ? qb[g % PD] : r;
                if (g + PD < 16) { rb[g % PD] = *l1; if (MODE == 2) qb[g % PD] = *l0; l1 += 512; l0 += 512; OPAQUE(l1); OPAQUE(l0); }
                const f32x4 v0 = x * (f32x4){bf_lo(r[0]), bf_hi(r[0]), bf_lo(r[1]), bf_hi(r[1])}, v1 = y * (f32x4){bf_lo(r[2]), bf_hi(r[2]), bf_lo(r[3]), bf_hi(r[3])};
                if (MODE == 1) { *p0 = (u32x4){cvt_pk_bf16(v0[0], v0[1]), cvt_pk_bf16(v0[2], v0[3]), cvt_pk_bf16(v1[0], v1[1]), cvt_pk_bf16(v1[2], v1[3])}; }
                else { const f32x4 w0 = v0 + (f32x4){bf_lo(q[0]), bf_hi(q[0]), bf_lo(q[1]), bf_hi(q[1])}, w1 = v1 + (f32x4){bf_lo(q[2]), bf_hi(q[2]), bf_lo(q[3]), bf_hi(q[3])};
                    *(u32x4*)(op + (size_t)(ai * 128 + m * 16) * DM + bj * 128) = (u32x4){cvt_pk_bf16(w0[0], w0[1]), cvt_pk_bf16(w0[2], w0[3]), cvt_pk_bf16(w1[0], w1[1]), cvt_pk_bf16(w1[2], w1[3])}; } }
            p0 += 512; OPAQUE(p0); __builtin_amdgcn_sched_barrier(0); }
        return false;
    }
};
template <int ACT> struct EpiBf16 {
    static constexpr bool PERM = true;
    bf16_t* O; int ldc;
    __device__ __forceinline__ bool operator()(f32x4 (&acc)[2][2][4][2], const pg8::Unit& u, int wr, int wc, int fr, int fq) const {
        const int row0 = u.pm * 256 + wr * 64 + fr, col0 = u.pn * 256 + wc * 32 + 8 * fq;
#pragma unroll
        for (int ai = 0; ai < 2; ++ai)
#pragma unroll
            for (int m = 0; m < 4; ++m) { bf16_t* rowp = O + (size_t)(row0 + ai * 128 + m * 16) * ldc + col0;
#pragma unroll
                for (int bj = 0; bj < 2; ++bj) { f32x4 v0 = acc[ai][bj][m][0], v1 = acc[ai][bj][m][1];
                    if (ACT == 1) {
#pragma unroll
                        for (int j = 0; j < 4; ++j) { const float a = fmaxf(v0[j], 0.f), b = fmaxf(v1[j], 0.f); v0[j] = a * a; v1[j] = b * b; } }
                    *(u32x4*)(rowp + bj * 128) = (u32x4){cvt_pk_bf16(v0[0], v0[1]), cvt_pk_bf16(v0[2], v0[3]), cvt_pk_bf16(v1[0], v1[1]), cvt_pk_bf16(v1[2], v1[3])}; } }
        return false;
    }
};

__device__ __forceinline__ void p7_row(Frame& F, int m) {
    const int lane = LANE; float* y; const float* x = row_x(F, m, y);
    bf16_t* u2 = (bf16_t*)(wsp() + WS_GV) + (size_t)m * DM;
    if (!y) { rms_row_to_bf16(nullptr, nullptr, u2, lane); return; }
    const bf16_t* t = (const bf16_t*)(wsp() + WS_GQK) + (size_t)m * DM;
    const GAS f32x4* xr = (const GAS f32x4*)x + lane; const GAS u32x2* tr = (const GAS u32x2*)t + lane;
    f32x4 tv[8]; float s = 0.f;
#pragma unroll
    for (int j = 0; j < 8; ++j) { const u32x2 w = tr[64 * j]; tv[j] = (f32x4){bf_lo(w[0]), bf_hi(w[0]), bf_lo(w[1]), bf_hi(w[1])}; s += (tv[j].x * tv[j].x + tv[j].y * tv[j].y) + (tv[j].z * tv[j].z + tv[j].w * tv[j].w); }
    const float rs = 1.0f / sqrtf(wave_sum(s) * (1.f / DM) + EPS);
    const GAS f32x4* g1 = (const GAS f32x4*)inp(19) + lane; float s2 = 0.f;
#pragma unroll
    for (int j = 0; j < 8; ++j) { const f32x4 hv = xr[64 * j] + tv[j] * rs * g1[64 * j]; tv[j] = hv; s2 += (hv.x * hv.x + hv.y * hv.y) + (hv.z * hv.z + hv.w * hv.w); }
    const float rs2 = 1.0f / sqrtf(wave_sum(s2) * (1.f / DM) + EPS);
    GAS f32x4* yr = (GAS f32x4*)y + lane; const GAS f32x4* g2 = (const GAS f32x4*)inp(20) + lane; GAS unsigned long long* o8 = (GAS unsigned long long*)u2 + lane;
#pragma unroll
    for (int j = 0; j < 8; ++j) { yr[64 * j] = tv[j]; const f32x4 gg = g2[64 * j];
        o8[64 * j] = (unsigned long long)cvt_pk_bf16(tv[j].x * rs2 * gg.x, tv[j].y * rs2 * gg.y) | ((unsigned long long)cvt_pk_bf16(tv[j].z * rs2 * gg.z, tv[j].w * rs2 * gg.w) << 32); }
}
__device__ __forceinline__ void p10_row(Frame& F, int m) {
    const int lane = LANE; float* y; (void)row_x(F, m, y); if (!y) return;
    const bf16_t* t = (const bf16_t*)(wsp() + WS_GQK) + (size_t)m * DM; const GAS u32x2* tr = (const GAS u32x2*)t + lane;
    f32x4 tv[8]; float s = 0.f;
#pragma unroll
    for (int j = 0; j < 8; ++j) { const u32x2 w = tr[64 * j]; tv[j] = (f32x4){bf_lo(w[0]), bf_hi(w[0]), bf_lo(w[1]), bf_hi(w[1])}; s += (tv[j].x * tv[j].x + tv[j].y * tv[j].y) + (tv[j].z * tv[j].z + tv[j].w * tv[j].w); }
    const float rs = 1.0f / sqrtf(wave_sum(s) * (1.f / DM) + EPS);
    GAS f32x4* yr = (GAS f32x4*)y + lane; const GAS f32x4* g = (const GAS f32x4*)inp(23) + lane;
#pragma unroll
    for (int j = 0; j < 8; ++j) yr[64 * j] = yr[64 * j] + tv[j] * rs * g[64 * j];
}
#ifndef PH_MASK
#define PH_MASK 0x7ff
#endif
#ifndef MK_N_LAUNCHES
#define MK_N_LAUNCHES 1
#endif
constexpr int N_PHASES = 11;
constexpr int WGM_P1 = 4, WGM_P5 = 4, WGM_P6 = 4, WGM_P8 = 4, WGM_P9 = 4;
__global__ void __launch_bounds__(512, 2) fwd(Args args) {
    extern __shared__ __attribute__((aligned(16))) unsigned char lds[];
    Frame F;
    F.lds = (LAS unsigned char*)lds; F.MISC = (volatile LAS unsigned*)(F.lds + MISC_OFF);
    F.wave = __builtin_amdgcn_readfirstlane((int)threadIdx.x >> 6);
    F.G = gridDim.x; F.gw = blockIdx.x * 8 + F.wave; F.NGW = F.G * 8;
    for (int u = (int)threadIdx.x; u < (LDS_BYTES - RING_BYTES) / 4; u += 512) ((LAS unsigned*)(F.lds + RING_BYTES))[u] = 0u;
    __syncthreads();
    if (MK_N_LAUNCHES == 1) (void)xcd_barrier_post((unsigned*)(((gu32*)wsp()) + CW_BAR), F.MISC + 8, F.wave);
    const int lo = args.ph_lo, hi = args.ph_hi;
#define IN(k) (lo <= (k) && (k) < hi)
#define SEAM(k) do { if (IN(k) && IN((k) + 1)) { XcdBarrier bar_; bar_.bar = (unsigned*)(((gu32*)wsp()) + CW_BAR); bar_.x = xb_xcc_id(); bar_.st = F.MISC + 8; bar_.wave = F.wave; xcd_barrier(bar_); } } while (0)
    if (((PH_MASK >> 0) & 1) && IN(0)) { p0_prologue(F); } SEAM(0);
    if (((PH_MASK >> 1) & 1) && IN(1)) {
        pg8::StaticOrder S{(const bf16_t*)(outp() + O_YP), (const bf16_t*)(wsp() + WS_W1G), TP / 256, N1 / 256, F.G, (int)blockIdx.x, DM, WGM_P1};
        EpiP1 E{wsp(), outp()};
        pg8::gemm_phase<EpiP1, pg8::StaticOrder>(F.lds + RING_OFF, DM, S, E, F.wave);
    } SEAM(1);
    if (((PH_MASK >> 2) & 1) && IN(2)) {
        for (int un = blockIdx.x; un < NCHUNK * 4; un += F.G) { const int g = un >> 2, h = un & 3;
            if (g < 520 && (g % 260) < 3) continue;
            p2_unit(F, g, h); }
    } SEAM(2);
    if (((PH_MASK >> 3) & 1) && IN(3)) { p3_run(F); } SEAM(3);
    if (((PH_MASK >> 4) & 1) && IN(4)) { for (int m = F.gw; m < TP; m += F.NGW) p4_row(F, m); } SEAM(4);
    if (((PH_MASK >> 5) & 1) && IN(5)) {
        const bf16_t* U = (const bf16_t*)(outp() + O_YP);
        u32x4* sga = (u32x4*)(wsp() + WS_KB); u32x4* sgb = (u32x4*)(wsp() + WS_VB); u32x4* sp = (u32x4*)(wsp() + WS_GQK);
        { pg8::StaticOrder S{U, (const bf16_t*)(wsp() + WS_WGATE), TP / 256, 8, F.G, (int)blockIdx.x, DM, WGM_P5}; EpiGate<0> E{sga, sga, nullptr}; pg8::gemm_phase<EpiGate<0>, pg8::StaticOrder>(F.lds + RING_OFF, DM, S, E, F.wave); }
        { pg8::StaticOrder S{U, (const bf16_t*)(wsp() + WS_WGATE) + (size_t)2048 * DM, TP / 256, 8, F.G, (int)blockIdx.x, DM, WGM_P5}; EpiGate<0> E{sgb, sgb, nullptr}; pg8::gemm_phase<EpiGate<0>, pg8::StaticOrder>(F.lds + RING_OFF, DM, S, E, F.wave); }
        { pg8::StaticOrder S{(const bf16_t*)(wsp() + WS_GV), (const bf16_t*)(wsp() + WS_WBRG), TP / 256, 8, F.G, (int)blockIdx.x, DM, WGM_P5}; EpiGate<1> E{sp, sga, nullptr}; pg8::gemm_phase<EpiGate<1>, pg8::StaticOrder>(F.lds + RING_OFF, DM, S, E, F.wave); }
        { pg8::StaticOrder S{(const bf16_t*)(wsp() + WS_OD), (const bf16_t*)(wsp() + WS_WBRD), TP / 256, 8, F.G, (int)blockIdx.x, DM, WGM_P5}; EpiGate<2> E{sp, sgb, (bf16_t*)(wsp() + WS_DQ)}; pg8::gemm_phase<EpiGate<2>, pg8::StaticOrder>(F.lds + RING_OFF, DM, S, E, F.wave); }
    } SEAM(5);
    if (((PH_MASK >> 6) & 1) && IN(6)) {
        pg8::StaticOrder S{(const bf16_t*)(wsp() + WS_DQ), (const bf16_t*)(wsp() + WS_WO), TP / 256, 8, F.G, (int)blockIdx.x, DM, WGM_P6, true};
        EpiBf16<0> E{(bf16_t*)(wsp() + WS_GQK), DM};
        pg8::gemm_phase<EpiBf16<0>, pg8::StaticOrder>(F.lds + RING_OFF, DM, S, E, F.wave);
    } SEAM(6);
    if (((PH_MASK >> 7) & 1) && IN(7)) {
        for (int m = F.gw; m < TP; m += F.NGW) p7_row(F, m);
    } SEAM(7);
    if (((PH_MASK >> 8) & 1) && IN(8)) {
        pg8::StaticOrder S{(const bf16_t*)(wsp() + WS_GV), (const bf16_t*)(wsp() + WS_WFF1), TP / 256, DFF / 256, F.G, (int)blockIdx.x, DM, WGM_P8};
        EpiBf16<1> E{(bf16_t*)(wsp() + WS_DQ), DFF};
        pg8::gemm_phase<EpiBf16<1>, pg8::StaticOrder>(F.lds + RING_OFF, DM, S, E, F.wave);
    } SEAM(8);
    if (((PH_MASK >> 9) & 1) && IN(9)) {
        pg8::StaticOrder S{(const bf16_t*)(wsp() + WS_DQ), (const bf16_t*)(wsp() + WS_WFF2), TP / 256, 8, F.G, (int)blockIdx.x, DFF, WGM_P9, true};
        EpiBf16<0> E{(bf16_t*)(wsp() + WS_GQK), DM};
        pg8::gemm_phase<EpiBf16<0>, pg8::StaticOrder>(F.lds + RING_OFF, DFF, S, E, F.wave);
    } SEAM(9);
    if (((PH_MASK >> 10) & 1) && IN(10)) { for (int m = F.gw; m < TP; m += F.NGW) p10_row(F, m); }
#undef IN
#undef SEAM
}

extern "C" void kernel_launch(void* const* d_in, const int* in_sizes, int n_in, void* d_out, int out_size, void* d_ws, size_t ws_size, hipStream_t stream) {
    static int grid = 0;
    if (grid == 0) {
        if (n_in != 24 || (size_t)out_size != O_END || ws_size < WS_END) { fprintf(stderr, "kernel_launch: unexpected shapes (n_in %d out %d ws %zu)\n", n_in, out_size, ws_size); grid = -1; return; }
        int dev = 0, cus = 0, per_cu = 0;
        if (hipGetDevice(&dev) != hipSuccess || hipDeviceGetAttribute(&cus, hipDeviceAttributeMultiprocessorCount, dev) != hipSuccess) { grid = -1; return; }
        if (hipFuncSetAttribute((const void*)fwd, hipFuncAttributeMaxDynamicSharedMemorySize, LDS_BYTES) != hipSuccess) { grid = -1; return; }
        if (hipOccupancyMaxActiveBlocksPerMultiprocessor(&per_cu, (const void*)fwd, 512, LDS_BYTES) != hipSuccess || per_cu < 1) { fprintf(stderr, "kernel_launch: occupancy query says %d\n", per_cu); }
        (void)hipGetLastError();
        grid = cus > 256 ? 256 : cus;
    }
    if (grid < 0) return;
    (void)hipMemsetAsync((char*)d_ws + WS_CTL, 0, CTL_ZERO_BYTES, stream);
    Args a{};
    for (int i = 0; i < 24; ++i) a.in[i] = (const float*)d_in[i];
    a.out = (float*)d_out; a.ws = (unsigned char*)d_ws;
    if (MK_N_LAUNCHES == 1) { a.ph_lo = 0; a.ph_hi = N_PHASES; hipLaunchKernelGGL(fwd, dim3(grid), dim3(512), LDS_BYTES, stream, a); }
    else { for (int p = 0; p < N_PHASES; ++p) { a.ph_lo = p; a.ph_hi = p + 1; hipLaunchKernelGGL(fwd, dim3(grid), dim3(512), LDS_BYTES, stream, a); } }
}
```

```cpp
#include <hip/hip_runtime.h>
#include <cstdio>
#include <cstdint>

#define GAS __attribute__((address_space(1)))
#define LAS __attribute__((address_space(3)))
typedef unsigned short bf16_t;
typedef short bf16x8 __attribute__((ext_vector_type(8)));
typedef short s16x4 __attribute__((ext_vector_type(4)));
typedef float f32x4 __attribute__((ext_vector_type(4)));
typedef float f32x2 __attribute__((ext_vector_type(2)));
typedef float f32x16 __attribute__((ext_vector_type(16)));
typedef unsigned u32x4 __attribute__((ext_vector_type(4)));
typedef unsigned u32x2 __attribute__((ext_vector_type(2)));
typedef GAS unsigned gu32;

__device__ __forceinline__ unsigned cvt_pk_bf16(float lo, float hi) { unsigned r; asm volatile("v_cvt_pk_bf16_f32 %0, %1, %2" : "=v"(r) : "v"(lo), "v"(hi)); return r; }
__device__ __forceinline__ float bf_lo(unsigned w) { return __uint_as_float(w << 16); }
__device__ __forceinline__ float bf_hi(unsigned w) { return __uint_as_float(w & 0xffff0000u); }
__device__ __forceinline__ float bf2f(bf16_t b) { return __uint_as_float(((unsigned)b) << 16); }
__device__ __forceinline__ unsigned f2bf(float f) { unsigned u = __float_as_uint(f); return (u + 0x7fffu + ((u >> 16) & 1u)) >> 16; }
__device__ __forceinline__ int lane_id() { int l; asm volatile("v_mbcnt_lo_u32_b32 %0, -1, 0\n\tv_mbcnt_hi_u32_b32 %0, -1, %0" : "=v"(l) :: "memory"); return l; }
__device__ __forceinline__ float xor1(float v) { return __int_as_float(__builtin_amdgcn_update_dpp(0, __float_as_int(v), 0xB1, 0xf, 0xf, false)); }
__device__ __forceinline__ float sigmoidf_(float x) { return __builtin_amdgcn_rcpf(1.0f + __expf(-x)); }

constexpr int DM = 2048, NBATCH = 2, SEQ = 16384, NMETA = 16, LP = SEQ + NMETA;
constexpr int BS = 16640, PADR = 240;
constexpr int NSMP = 32, TSMP = 64, PAST = 1024;
constexpr int SR0 = NBATCH * BS;
constexpr int TP = SR0 + NSMP * TSMP;
constexpr int NCHUNK = TP / 64;
constexpr int DFF = 8192;
constexpr float EPS = 1e-6f;
constexpr int N1 = 12544;

constexpr size_t O_YP = 0, O_YS = 67108864, O_KP = 71303168, O_VP = 138477568, O_SP = 205651968, O_KS = 206700544, O_VS = 210894848, O_SS = 215089152, O_END = 231866368;

__host__ __device__ __forceinline__ int v_img_off(int key, int col) { const int sg = (key & 3) + 4 * ((key >> 4) & 1) + 8 * ((key >> 2) & 3);
    return ((col >> 5) * 32 + sg) * 64 + ((((col >> 4) & 1) ^ ((sg >> 2) & 1)) * 32) + (col & 15) * 2; }

namespace pg8 {
constexpr int BM = 256, BK = 64, HALF = 128, HTB = HALF * BK * 2, STAGE_BYTES = 8 * HTB, NXCD = 8;
__host__ __device__ __forceinline__ int lds_byte(int r, int c) { const int st = (r >> 4) * 2 + (c >> 5), rr = r & 15, cc = c & 31, ob = rr * 64 + cc * 2; return st * 1024 + (ob ^ (((ob >> 9) & 1) << 5)); }
__host__ __device__ __forceinline__ void stage_rc(int b, int& R, int& C) { const int st = b / 1024, sb = b % 1024, swz = sb ^ (((sb >> 9) & 1) << 5); R = (st >> 1) * 16 + swz / 64; C = (st & 1) * 32 + (swz % 64) / 2; }
__host__ __device__ __forceinline__ int perm32(int rho) { const int n = rho >> 4, i = rho & 15; return 8 * (i >> 2) + 4 * n + (i & 3); }

struct Unit { int pm, pn, sub; };
__host__ __device__ __forceinline__ size_t b_img_off(int n, int k, int K) { const int r = n & 255, rl = r & 127, g = rl & 31, R = (rl & ~31) + 16 * ((g >> 2) & 1) + 4 * (g >> 3) + (g & 3);
    return (size_t)(n >> 8) * 256 * K * 2 + (size_t)((k >> 6) * 2 + (r >> 7)) * 16384 + lds_byte(R, k & 63); }
__host__ __device__ __forceinline__ size_t a_img_off(int r, int k, int K) { return (size_t)(r >> 8) * 256 * K * 2 + (size_t)((k >> 6) * 2 + ((r & 255) >> 7)) * 16384 + lds_byte(r & 127, k & 63); }

__device__ __forceinline__ bool tile_of(long L, int nM, int nN, Unit& u, const int WGM, const bool rev = false) {
    const int nwg = nM * nN; if (L >= nwg) return false;
    int wgid = (int)L; { const int q = nwg / NXCD, r = nwg % NXCD, xcd = wgid % NXCD; int off = wgid / NXCD; if (rev) off = q + (xcd < r ? 1 : 0) - 1 - off;
      wgid = (xcd < r ? xcd * (q + 1) : r * (q + 1) + (xcd - r) * q) + off; }
    const int nig = WGM * nN, gid = wgid / nig, fm = gid * WGM, gsz = (nM - fm) < WGM ? (nM - fm) : WGM;
    u.pm = fm + ((wgid % nig) % gsz); u.pn = (wgid % nig) / gsz; u.sub = 0; return true;
}
template <bool AI> struct StaticOrderT {
    static constexpr bool A_IMG = AI;
    const bf16_t* A; const bf16_t* Bt; int nM, nN, G, c, K, wgm; bool rev = false;
    __device__ __forceinline__ bool next(int i, Unit& u) const { return tile_of((long)i * G + c, nM, nN, u, wgm, rev); }
    __device__ __forceinline__ void addr(const Unit& u, const char*& a, const char*& b) const { a = (const char*)A + (size_t)u.pm * 256 * K * 2; b = (const char*)Bt + (size_t)u.pn * 256 * K * 2; }
};
using StaticOrder = StaticOrderT<false>; using StaticOrderAI = StaticOrderT<true>;

template <class Epi, class Sched>
__device__ __forceinline__ void gemm_phase(LAS unsigned char* lds, const int K, const Sched& S, const Epi& E, const int wid) {
    const int lane = lane_id(), tid = wid * 64 + lane, wr = wid >> 2, wc = wid & 3, fr = lane & 15, fq = lane >> 4;
    const int nt = K / BK;
    unsigned voffA[2], voffB[2];
#pragma unroll
    for (int i = 0; i < 2; ++i) { int R, C; stage_rc(tid * 16 + i * 8192, R, C); const int Rb = Epi::PERM ? ((R & ~31) + perm32(R & 31)) : R;
        voffA[i] = Sched::A_IMG ? (unsigned)(tid * 16 + i * 8192) : (unsigned)(R * K + C) * 2u; voffB[i] = (unsigned)(tid * 16 + i * 8192); (void)Rb; }
    static_assert(Epi::PERM, "the image-major B copies carry the PERM row order");
    const size_t kstepB = 32768, hstepB = 16384;
    const size_t kstep = Sched::A_IMG ? (size_t)32768 : (size_t)(BK * 2);
    const size_t hstep = Sched::A_IMG ? (size_t)16384 : (size_t)HALF * K * 2;
    const unsigned ldsw = (unsigned)wid * 1024u;
    const int aoff = lds_byte(wr * 64 + fr, fq * 8), boff = lds_byte(wc * 32 + fr, fq * 8);
#define PG8_SA(b, h) (((b) * 2 + (h)) * HTB)
#define PG8_SB(b, h) ((4 + (b) * 2 + (h)) * HTB)
#define PG8_STAGE(bufoff, gbase, voff) do { _Pragma("unroll") for (int _i = 0; _i < 2; ++_i) \
        __builtin_amdgcn_global_load_lds((const unsigned*)((const char*)(gbase) + (voff)[_i]), (LAS unsigned*)(lds + (bufoff) + ldsw + _i * 8192), 16, 0, 0); } while (0)
#define PG8_LDA(dst, b, h) do { _Pragma("unroll") for (int m = 0; m < 4; ++m) _Pragma("unroll") for (int k = 0; k < 2; ++k) dst[m][k] = *(const LAS bf16x8*)(lds + PG8_SA(b, h) + aoff + m * 2048 + k * 1024); } while (0)
#define PG8_LDB(dst, b, h) do { _Pragma("unroll") for (int n = 0; n < 2; ++n) _Pragma("unroll") for (int k = 0; k < 2; ++k) dst[n][k] = *(const LAS bf16x8*)(lds + PG8_SB(b, h) + boff + n * 2048 + k * 1024); } while (0)
#define PG8_MMA(ai, bj, At, Bt) do { __builtin_amdgcn_s_setprio(1); _Pragma("unroll") for (int m = 0; m < 4; ++m) _Pragma("unroll") for (int n = 0; n < 2; ++n) _Pragma("unroll") for (int k = 0; k < 2; ++k) \
        acc[ai][bj][m][n] = __builtin_amdgcn_mfma_f32_16x16x32_bf16(Bt[n][k], At[m][k], acc[ai][bj][m][n], 0, 0, 0); __builtin_amdgcn_s_setprio(0); } while (0)
#define PG8_WAIT_V(n) asm volatile("s_waitcnt vmcnt(" #n ")" ::: "memory")
#define PG8_WAIT_L(n) asm volatile("s_waitcnt lgkmcnt(" #n ")" ::: "memory")
#define PG8_BAR __builtin_amdgcn_s_barrier()
#define PG8_SCHED __builtin_amdgcn_sched_barrier(0)
    Unit cur, nxt; int ui = 0;
    if (!S.next(0, cur)) return;
    f32x4 acc[2][2][4][2];
#pragma unroll
    for (int a = 0; a < 2; ++a)
#pragma unroll
        for (int b = 0; b < 2; ++b)
#pragma unroll
            for (int m = 0; m < 4; ++m)
#pragma unroll
                for (int n = 0; n < 2; ++n) acc[a][b][m][n] = (f32x4){0.f, 0.f, 0.f, 0.f};
    bf16x8 At[4][2], B0[2][2], B1[2][2];
    const char* cA; const char* cB; S.addr(cur, cA, cB);
    PG8_STAGE(PG8_SB(0, 0), cB, voffB); PG8_STAGE(PG8_SB(0, 1), cB + hstepB, voffB); PG8_STAGE(PG8_SA(0, 0), cA, voffA); PG8_STAGE(PG8_SA(0, 1), cA + hstep, voffA);
    if (wr == 1) PG8_BAR;
    PG8_WAIT_V(2); PG8_BAR;
    PG8_STAGE(PG8_SB(1, 0), cB + kstepB, voffB); PG8_STAGE(PG8_SA(1, 0), cA + kstep, voffA); PG8_STAGE(PG8_SB(1, 1), cB + hstepB + kstepB, voffB);
    PG8_WAIT_V(6); PG8_BAR;
    for (;;) {
        const bool has_next = S.next(ui + 1, nxt);
        const char* nA = cA; const char* nB = cB; if (has_next) S.addr(nxt, nA, nB);
        for (int t = 0; t < nt; t += 2) {
            const bool last = (t == nt - 2);
            const char* a1 = cA + (size_t)(t + 1) * kstep;
            const char* a2 = last ? nA : cA + (size_t)(t + 2) * kstep; const char* b2 = last ? nB : cB + (size_t)(t + 2) * kstepB;
            const char* a3 = a2 + kstep; const char* b3 = b2 + kstepB;
            PG8_LDB(B0, 0, 0); PG8_LDB(B1, 0, 1); PG8_SCHED; PG8_LDA(At, 0, 0); PG8_STAGE(PG8_SA(1, 1), a1 + hstep, voffA);
            PG8_WAIT_V(8); PG8_WAIT_L(0); PG8_BAR; PG8_MMA(0, 0, At, B0); PG8_MMA(0, 1, At, B1); PG8_BAR; PG8_SCHED;
            PG8_LDA(At, 0, 1); PG8_STAGE(PG8_SB(0, 0), b2, voffB); PG8_STAGE(PG8_SB(0, 1), b2 + hstepB, voffB); PG8_STAGE(PG8_SA(0, 0), a2, voffA);
            PG8_WAIT_V(8); PG8_WAIT_L(0); PG8_BAR; PG8_MMA(1, 0, At, B0); PG8_MMA(1, 1, At, B1); PG8_BAR; PG8_SCHED;
            PG8_LDB(B0, 1, 0); PG8_LDB(B1, 1, 1); PG8_SCHED; PG8_LDA(At, 1, 0); PG8_STAGE(PG8_SA(0, 1), a2 + hstep, voffA);
            PG8_WAIT_V(8); PG8_WAIT_L(0); PG8_BAR; PG8_MMA(0, 0, At, B0); PG8_MMA(0, 1, At, B1); PG8_BAR; PG8_SCHED;
            PG8_LDA(At, 1, 1); PG8_STAGE(PG8_SB(1, 0), b3, voffB); PG8_STAGE(PG8_SB(1, 1), b3 + hstepB, voffB); PG8_STAGE(PG8_SA(1, 0), a3, voffA);
            PG8_WAIT_V(8); PG8_WAIT_L(0); PG8_BAR; PG8_MMA(1, 0, At, B0); PG8_MMA(1, 1, At, B1); PG8_BAR; PG8_SCHED;
        }
        if (wr == 0) PG8_BAR;
        const bool keep = E(acc, cur, wr, wc, fr, fq);
        if (!has_next) break;
        if (!keep) {
#pragma unroll
        for (int a = 0; a < 2; ++a)
#pragma unroll
            for (int b = 0; b < 2; ++b)
#pragma unroll
                for (int m = 0; m < 4; ++m)
#pragma unroll
                    for (int n = 0; n < 2; ++n) acc[a][b][m][n] = (f32x4){0.f, 0.f, 0.f, 0.f};
        }
        cur = nxt; cA = nA; cB = nB; ++ui;
        if (wr == 1) PG8_BAR;
    }
    PG8_WAIT_V(0);
    PG8_BAR;
#undef PG8_SA
#undef PG8_SB
#undef PG8_STAGE
#undef PG8_LDA
#undef PG8_LDB
#undef PG8_MMA
#undef PG8_WAIT_V
#undef PG8_WAIT_L
#undef PG8_BAR
#undef PG8_SCHED
}
}
namespace att {
constexpr float SCALE = 0.08838834764831845f;
constexpr float THR = 8.f;
constexpr int NW = 8, QBLK = 32, KVBLK = 64, QB = NW * QBLK, D = 128, PITCH = 2048;
constexpr int SHM_V = KVBLK * D * 2, SHM_K = KVBLK * D * 2;
constexpr int LDS_BYTES = 2 * SHM_V + 2 * SHM_K + NW * 64 * 4;

#define KSWZ(row, colB) ((row) * 256 + ((colB) ^ (((row) & 7) << 4)))
#define SBAR() __builtin_amdgcn_sched_barrier(0)
__device__ __forceinline__ int v_st(int k, int c) { const int kk = (k & ~0xC) | ((k & 4) << 1) | ((k & 8) >> 1); return ((kk >> 3) * 4 + (c >> 5)) * 512 + ((kk & 7) * 32 + (c & 31)) * 2; }
__device__ __forceinline__ int v_rd_base(int lane) { return ((lane & 3) << 3) | (((lane >> 2) & 3) << 6) | (((lane >> 4) & 1) << 5) | (((lane >> 5) & 1) << 8); }
constexpr int v_rd_off(int d0, int ks, int half) { return d0 * 512 + ks * 4096 + half * 2048; }
__device__ __forceinline__ int crow(int r, int hi) { return (r & 3) + 8 * (r >> 2) + 4 * hi; }
__device__ __forceinline__ bf16x8 load8(const bf16_t* p) { return *reinterpret_cast<const bf16x8*>(p); }

__device__ __forceinline__ void mask_tile_bc(f32x16& p0, f32x16& p1, bool all) {
    const float NEG = -__builtin_inff();
#pragma unroll
    for (int r = 0; r < 16; ++r) { p0[r] = NEG; if (r < 8) p1[r] = NEG; else p1[r] = all ? NEG : p1[r]; }
}
__device__ __forceinline__ void partialSM(f32x16& p0, f32x16& p1, float& m_reg, float& mn, float& alpha) {
    float pmax = p0[0]; for (int r = 1; r < 16; ++r) pmax = fmaxf(pmax, p0[r]); for (int r = 0; r < 16; ++r) pmax = fmaxf(pmax, p1[r]);
    { auto rr = __builtin_amdgcn_permlane32_swap(__float_as_uint(pmax), __float_as_uint(pmax), false, false);
      pmax = fmaxf(__uint_as_float(rr[0]), __uint_as_float(rr[1])); }
    constexpr float C2 = 1.4426950408889634f * SCALE;
    if (__builtin_expect(__all((pmax - m_reg) * SCALE <= THR), 1)) { mn = m_reg; alpha = 1.f; }
    else { mn = fmaxf(m_reg, pmax); alpha = __builtin_amdgcn_exp2f((m_reg - mn) * C2); m_reg = mn; }
    const float mnL = -mn * C2;
    for (int r = 0; r < 16; ++r) p0[r] = fmaf(p0[r], C2, mnL); for (int r = 0; r < 16; ++r) p1[r] = fmaf(p1[r], C2, mnL);
    for (int r = 0; r < 16; ++r) p0[r] = __builtin_amdgcn_exp2f(p0[r]);
}
__device__ __forceinline__ void finishSM(f32x16& p0, f32x16& p1, float alpha, float& l_reg, bf16x8& pa0, bf16x8& pa1, bf16x8& pa2, bf16x8& pa3) {
    for (int r = 0; r < 16; ++r) p1[r] = __builtin_amdgcn_exp2f(p1[r]);
    float ps = 0; for (int r = 0; r < 16; ++r) ps += p0[r]; for (int r = 0; r < 16; ++r) ps += p1[r];
    { auto rr = __builtin_amdgcn_permlane32_swap(__float_as_uint(ps), __float_as_uint(ps), false, false);
      ps = __uint_as_float(rr[0]) + __uint_as_float(rr[1]); }
    l_reg = l_reg * alpha + ps;
#define PK4(P, B_, OUT) do { unsigned a0 = cvt_pk_bf16(P[B_+0], P[B_+1]), a1 = cvt_pk_bf16(P[B_+2], P[B_+3]);                          \
        unsigned b0 = cvt_pk_bf16(P[B_+4], P[B_+5]), b1 = cvt_pk_bf16(P[B_+6], P[B_+7]);                                             \
        auto r0 = __builtin_amdgcn_permlane32_swap(a0, b0, false, false); auto r1 = __builtin_amdgcn_permlane32_swap(a1, b1, false, false); \
        u32x4 w = {r0[0], r1[0], r0[1], r1[1]}; OUT = *reinterpret_cast<bf16x8*>(&w); } while (0)
    PK4(p0, 0, pa0); PK4(p0, 8, pa1); PK4(p1, 0, pa2); PK4(p1, 8, pa3);
#undef PK4
}
template <int KB>
__device__ __forceinline__ void qkt(f32x16& p0, f32x16& p1, const char* K_lds, int r32, int hi, const bf16x8* qr, bool act) {
    if (!act) { const float NEG = -__builtin_inff();
#pragma unroll
        for (int r = 0; r < 16; ++r) { p0[r] = NEG; p1[r] = NEG; } return; }
    p0 = f32x16{}; p1 = f32x16{};
    const char* kb[4];
#pragma unroll
    for (int dd = 0; dd < 4; ++dd) kb[dd] = K_lds + KB * SHM_K + KSWZ(r32, (dd * 16 + hi * 8) * 2);
#pragma unroll
    for (int d0 = 0; d0 < 8; ++d0) { const char* a = kb[d0 & 3] + (d0 >> 2) * 128;
        bf16x8 b0 = *reinterpret_cast<const bf16x8*>(a);
        bf16x8 b1 = *reinterpret_cast<const bf16x8*>(a + 32 * 256);
        p0 = __builtin_amdgcn_mfma_f32_32x32x16_bf16(b0, qr[d0], p0, 0, 0, 0);
        p1 = __builtin_amdgcn_mfma_f32_32x32x16_bf16(b1, qr[d0], p1, 0, 0, 0); }
}
template <int VB>
__device__ __forceinline__ void pv_tile(f32x16* o, int vb0, bf16x8 pa0, bf16x8 pa1, bf16x8 pa2, bf16x8 pa3, bool act) {
    if (!act) return;
#define TRRD(dst, off) asm volatile("ds_read_b64_tr_b16 %0, %1 offset:%2" : "=&v"(dst) : "v"(vb0), "i"(off) : "memory")
#define PV_D0(d0) do { s16x4 l0, l1, l2, l3, h0, h1, h2, h3; constexpr int b_ = VB * SHM_V + v_rd_off(d0, 0, 0); \
        TRRD(l0, b_); TRRD(h0, b_ + 2048); TRRD(l1, b_ + 4096); TRRD(h1, b_ + 6144); TRRD(l2, b_ + 8192); TRRD(h2, b_ + 10240); TRRD(l3, b_ + 12288); TRRD(h3, b_ + 14336); \
        asm volatile("s_waitcnt lgkmcnt(0)" ::: "memory"); SBAR(); \
        o[d0] = __builtin_amdgcn_mfma_f32_32x32x16_bf16(pa0, (bf16x8){l0[0], l0[1], l0[2], l0[3], h0[0], h0[1], h0[2], h0[3]}, o[d0], 0, 0, 0);   \
        o[d0] = __builtin_amdgcn_mfma_f32_32x32x16_bf16(pa1, (bf16x8){l1[0], l1[1], l1[2], l1[3], h1[0], h1[1], h1[2], h1[3]}, o[d0], 0, 0, 0);   \
        o[d0] = __builtin_amdgcn_mfma_f32_32x32x16_bf16(pa2, (bf16x8){l2[0], l2[1], l2[2], l2[3], h2[0], h2[1], h2[2], h2[3]}, o[d0], 0, 0, 0);   \
        o[d0] = __builtin_amdgcn_mfma_f32_32x32x16_bf16(pa3, (bf16x8){l3[0], l3[1], l3[2], l3[3], h3[0], h3[1], h3[2], h3[3]}, o[d0], 0, 0, 0); } while (0)
    PV_D0(0); PV_D0(1); PV_D0(2); PV_D0(3);
#undef PV_D0
#undef TRRD
}

struct BlockRef { const bf16_t* Q; const bf16_t* K; const bf16_t* V; int jlo, jhi, lastbase, first; };
struct Seam { bf16x8 qr[8]; bf16x8 st_v0, st_v1, st_k0, st_k1; };
#define ROW(p, k0, rr) ((p) + (size_t)((k0) + (rr)) * PITCH + sc)
#define VMW() asm volatile("s_waitcnt vmcnt(0)" ::: "memory")
#define VMWN(n) asm volatile("s_waitcnt vmcnt(%0)" :: "i"(n) : "memory")
#define SLOAD_H(Kp, Vp, k0) do { S.st_v0 = load8(ROW(Vp, k0, sr)); S.st_v1 = load8(ROW(Vp, k0, 32 + sr));              \
                         S.st_k0 = load8(ROW(Kp, k0, sr)); S.st_k1 = load8(ROW(Kp, k0, 32 + sr)); } while (0)
#define SWRITE_HK(bf) do { *(bf16x8*)(K_lds + (bf) * SHM_K + kws) = S.st_k0; *(bf16x8*)(K_lds + (bf) * SHM_K + kws + 32 * 256) = S.st_k1; } while (0)
#define SWRITE_HV(bf) do { *(bf16x8*)(V_lds + (bf) * SHM_V + vst0) = S.st_v0; *(bf16x8*)(V_lds + (bf) * SHM_V + vst1) = S.st_v1; } while (0)
#define SWRITE_H(bf) do { SWRITE_HV(bf); SWRITE_HK(bf); } while (0)
__device__ __forceinline__ void attn_prime(const BlockRef& cur, char* lds, Seam& S, const int wid) {
    int lane = lane_id(); asm volatile("" : "+v"(lane));
    const int tid = wid * 64 + lane, r32 = lane & 31, hi = lane >> 5;
    const int sr = tid >> 4, sc = (tid & 15) * 8, kws = KSWZ(sr, sc * 2); char* K_lds = lds + 2 * SHM_V;
    const int kb0 = cur.jlo * KVBLK;
    for (int d0 = 0; d0 < 8; ++d0) S.qr[d0] = load8(cur.Q + (size_t)(wid * QBLK + r32) * PITCH + d0 * 16 + hi * 8);
    SLOAD_H(cur.K, cur.V, kb0); VMW(); SWRITE_HK(0);
    __syncthreads();
}
__device__ __forceinline__ void attn_block(const int MODE, const BlockRef& cur, const BlockRef& nxt, char* lds, Seam& S, float* stash, bf16_t* Oout, float lam, const int wid) {
    int lane = lane_id(); asm volatile("" : "+v"(lane));
    const int tid = wid * 64 + lane, r32 = lane & 31, hi = lane >> 5;
    const int j_lo = cur.jlo, j_hi = cur.jhi;
    const int NT = j_hi - j_lo;
    const int kbn = nxt.jlo * KVBLK;
    const int lastw = cur.first ? cur.lastbase : cur.lastbase + (wid >> 1);
    char* V_lds = lds; char* K_lds = lds + 2 * SHM_V;
    float* ws = (float*)(lds + 2 * SHM_V + 2 * SHM_K) + wid * 64; float* li_l = ws, * al_l = ws + 32;
    float m_reg = -1e30f, l_reg = 0; f32x16 o[4] = {};
    const int sr = tid >> 4, sc = (tid & 15) * 8, vst0 = v_st(sr, sc), vst1 = v_st(32 + sr, sc), kws = KSWZ(sr, sc * 2);
    const int vb0 = (int)(uintptr_t)V_lds + v_rd_base(lane);
    const bf16_t* Kh = cur.K; const bf16_t* Vh = cur.V;
#define RESC(a) do { if (__any((a) < 1.f)) { if (hi == 0) al_l[r32] = (a); asm volatile("s_waitcnt lgkmcnt(0)" ::: "memory");              \
                     for (int d_ = 0; d_ < 4; ++d_) for (int r = 0; r < 16; ++r) o[d_][r] *= al_l[crow(r, hi)]; } } while (0)
#define KBASE(t) ((j_lo + (t)) * KVBLK)
#define ACT(t) true
#define MASKT(P0_, P1_, t) do { const int jt_ = j_lo + (t); if (jt_ == 3 || jt_ > lastw) mask_tile_bc(P0_, P1_, jt_ > lastw); } while (0)
    constexpr int NQL = 8;
#define SEAM_K0() do { VMWN(NQL); SWRITE_HK(0); SBAR(); } while (0)
    f32x16 pA0, pA1, pB0, pB1; float mnA, mnB, alA, alB; bf16x8 pa0, pa1, pa2, pa3;
    SWRITE_HV(0); SBAR();
    if (NT > 1) { SLOAD_H(Kh, Vh, KBASE(1)); }
    SBAR(); qkt<0>(pA0, pA1, K_lds, r32, hi, S.qr, ACT(0));
    MASKT(pA0, pA1, 0); partialSM(pA0, pA1, m_reg, mnA, alA);
    if (NT > 1) { VMW(); SWRITE_H(1); }
    __syncthreads();
#define HALF_STEP(PX0, PX1, mnX, alX, PY0, PY1, alY, t, KB, VB, SB) do {                                                      \
        SBAR(); qkt<KB>(PX0, PX1, K_lds, r32, hi, S.qr, ACT(t));                                             \
        finishSM(PY0, PY1, alY, l_reg, pa0, pa1, pa2, pa3); SBAR();                                                           \
        if ((t) + 1 < NT) { SLOAD_H(Kh, Vh, KBASE((t) + 1)); SBAR(); }                                               \
        pv_tile<VB>(o, vb0, pa0, pa1, pa2, pa3, ACT((t) - 1)); MASKT(PX0, PX1, (t)); partialSM(PX0, PX1, m_reg, mnX, alX);                                        \
        __syncthreads();                                                                                                      \
        if ((t) + 1 < NT) { VMW(); SWRITE_H(SB); }                                                                          \
        RESC(alX); __syncthreads(); } while (0)
    for (int t = 1; t + 1 < NT; t += 2) {
        HALF_STEP(pB0, pB1, mnB, alB, pA0, pA1, alA, t, 1, 0, 0);
        HALF_STEP(pA0, pA1, mnA, alA, pB0, pB1, alB, t + 1, 0, 1, 1);
    }
    const bool even = (NT & 1) == 0;
    if (even) { SBAR(); qkt<1>(pB0, pB1, K_lds, r32, hi, S.qr, ACT(NT - 1)); SBAR(); }
    SLOAD_H(nxt.K, nxt.V, kbn); SBAR();
#pragma unroll
    for (int d0 = 0; d0 < 8; ++d0) S.qr[d0] = load8(nxt.Q + (size_t)(wid * QBLK + r32) * PITCH + d0 * 16 + hi * 8);
    SBAR();
    finishSM(pA0, pA1, alA, l_reg, pa0, pa1, pa2, pa3); SBAR();
    pv_tile<0>(o, vb0, pa0, pa1, pa2, pa3, ACT(even ? NT - 2 : NT - 1));
    if (even) { MASKT(pB0, pB1, NT - 1); partialSM(pB0, pB1, m_reg, mnB, alB); __syncthreads(); RESC(alB);
        finishSM(pB0, pB1, alB, l_reg, pa0, pa1, pa2, pa3); SBAR(); pv_tile<1>(o, vb0, pa0, pa1, pa2, pa3, ACT(NT - 1)); }
    SBAR(); SEAM_K0();
    if (hi == 0) li_l[r32] = l_reg; asm volatile("s_waitcnt lgkmcnt(0)" ::: "memory");
    int hie = hi; asm volatile("" : "+v"(hie));
    float rli[16];
#pragma unroll
    for (int r = 0; r < 16; ++r) rli[r] = __builtin_amdgcn_rcpf(li_l[crow(r, hie)]);
    if (MODE == 0) {
        float* Ow = stash + (wid * QBLK + 4 * hie) * D + r32;
#pragma unroll
        for (int r = 0; r < 16; ++r) {
#pragma unroll
            for (int d0 = 0; d0 < 4; ++d0) Ow[((r & 3) + 8 * (r >> 2)) * D + d0 * 32] = o[d0][r] * rli[r]; }
    } else {
        const float* Sw = stash + (wid * QBLK + 4 * hie) * D + r32;
        bf16_t* Ow = Oout + (size_t)((wid * QBLK + 4 * hie) * PITCH + r32);
#pragma unroll
        for (int rg = 0; rg < 4; ++rg) {
            float sv[4][4];
#pragma unroll
            for (int rr = 0; rr < 4; ++rr)
#pragma unroll
                for (int d0 = 0; d0 < 4; ++d0) sv[rr][d0] = Sw[(rr + 8 * rg) * D + d0 * 32];
#pragma unroll
            for (int rr = 0; rr < 4; ++rr) { const int r = 4 * rg + rr;
#pragma unroll
                for (int d0 = 0; d0 < 4; ++d0) { const float v = sv[rr][d0] - lam * (o[d0][r] * rli[r]);
                    const float vn = xor1(v);
                    if ((r32 & 1) == 0) *(unsigned*)(Ow + (rr + 8 * rg) * PITCH + d0 * 32) = cvt_pk_bf16(v, vn); } }
            SBAR(); }
    }
    __syncthreads();
#undef RESC
#undef KBASE
#undef ACT
#undef MASKT
#undef SEAM_K0
#undef HALF_STEP
}
#undef ROW
#undef VMWN
#undef SLOAD_H
#undef SWRITE_HK
#undef SWRITE_HV
#undef SWRITE_H
}
namespace att2 {
using att::crow; using att::load8; using att::v_rd_base; using att::SCALE; using att::THR;
constexpr int NW = 8, QBLK = 32, KV = 32, PITCH = 2048, DV = 256;
constexpr int SHM_V = KV * DV * 2, SHM_K = KV * 128 * 2;
constexpr int OFF_K = 2 * SHM_V, OFF_S = OFF_K + 2 * SHM_K, LDS_BYTES = OFF_S + NW * 64 * 4;
__device__ __forceinline__ int v_st(int k, int c) { const int kk = (k & ~0xC) | ((k & 4) << 1) | ((k & 8) >> 1); return ((kk >> 3) * 8 + (c >> 5)) * 512 + ((kk & 7) * 32 + (c & 31)) * 2; }
constexpr int v_rd_off(int d0, int ks, int half) { return d0 * 512 + ks * 8192 + half * 4096; }

__device__ __forceinline__ void mask1(f32x16& p, bool all) {
    const float NEG = -__builtin_inff();
#pragma unroll
    for (int r = 0; r < 16; ++r) { if (r < 8) p[r] = NEG; else p[r] = all ? NEG : p[r]; }
}
__device__ __forceinline__ void partialSM(f32x16& p, float& m_reg, float& mn, float& alpha) {
    float pmax = p[0]; for (int r = 1; r < 16; ++r) pmax = fmaxf(pmax, p[r]);
    { auto rr = __builtin_amdgcn_permlane32_swap(__float_as_uint(pmax), __float_as_uint(pmax), false, false);
      pmax = fmaxf(__uint_as_float(rr[0]), __uint_as_float(rr[1])); }
    constexpr float C2 = 1.4426950408889634f * SCALE;
    if (__builtin_expect(__all((pmax - m_reg) * SCALE <= THR), 1)) { mn = m_reg; alpha = 1.f; }
    else { mn = fmaxf(m_reg, pmax); alpha = __builtin_amdgcn_exp2f((m_reg - mn) * C2); m_reg = mn; }
    const float mnL = -mn * C2;
    for (int r = 0; r < 16; ++r) p[r] = fmaf(p[r], C2, mnL);
    for (int r = 0; r < 8; ++r) p[r] = __builtin_amdgcn_exp2f(p[r]);
}
__device__ __forceinline__ void finishSM(f32x16& p, float alpha, float& l_reg, bf16x8& pa0, bf16x8& pa1) {
    for (int r = 8; r < 16; ++r) p[r] = __builtin_amdgcn_exp2f(p[r]);
    float ps = 0; for (int r = 0; r < 16; ++r) ps += p[r];
    { auto rr = __builtin_amdgcn_permlane32_swap(__float_as_uint(ps), __float_as_uint(ps), false, false);
      ps = __uint_as_float(rr[0]) + __uint_as_float(rr[1]); }
    l_reg = l_reg * alpha + ps;
#define PK4(P, B_, OUT) do { unsigned a0 = cvt_pk_bf16(P[B_+0], P[B_+1]), a1 = cvt_pk_bf16(P[B_+2], P[B_+3]);                          \
        unsigned b0 = cvt_pk_bf16(P[B_+4], P[B_+5]), b1 = cvt_pk_bf16(P[B_+6], P[B_+7]);                                             \
        auto r0 = __builtin_amdgcn_permlane32_swap(a0, b0, false, false); auto r1 = __builtin_amdgcn_permlane32_swap(a1, b1, false, false); \
        u32x4 w = {r0[0], r1[0], r0[1], r1[1]}; OUT = *reinterpret_cast<bf16x8*>(&w); } while (0)
    PK4(p, 0, pa0); PK4(p, 8, pa1);
#undef PK4
}
template <int KB>
__device__ __forceinline__ void qkt(f32x16& p, const char* K_lds, int r32, int hi, const bf16x8* qr) {
    p = f32x16{};
    const char* kb[4];
#pragma unroll
    for (int dd = 0; dd < 4; ++dd) kb[dd] = K_lds + KB * SHM_K + KSWZ(r32, (dd * 16 + hi * 8) * 2);
#pragma unroll
    for (int d0 = 0; d0 < 8; ++d0) { const bf16x8 b0 = *reinterpret_cast<const bf16x8*>(kb[d0 & 3] + (d0 >> 2) * 128);
        p = __builtin_amdgcn_mfma_f32_32x32x16_bf16(b0, qr[d0], p, 0, 0, 0); }
}
template <int VB>
__device__ __forceinline__ void pv_tile(f32x16* o, int vb0, bf16x8 pa0, bf16x8 pa1) {
#define TRRD(dst, off) asm volatile("ds_read_b64_tr_b16 %0, %1 offset:%2" : "=&v"(dst) : "v"(vb0), "i"(off) : "memory")
#define PV_D0(d0) do { s16x4 l0, l1, h0, h1; constexpr int b_ = VB * SHM_V + v_rd_off(d0, 0, 0); \
        TRRD(l0, b_); TRRD(h0, b_ + 4096); TRRD(l1, b_ + 8192); TRRD(h1, b_ + 12288); \
        asm volatile("s_waitcnt lgkmcnt(0)" ::: "memory"); SBAR(); \
        o[d0] = __builtin_amdgcn_mfma_f32_32x32x16_bf16(pa0, (bf16x8){l0[0], l0[1], l0[2], l0[3], h0[0], h0[1], h0[2], h0[3]}, o[d0], 0, 0, 0);   \
        o[d0] = __builtin_amdgcn_mfma_f32_32x32x16_bf16(pa1, (bf16x8){l1[0], l1[1], l1[2], l1[3], h1[0], h1[1], h1[2], h1[3]}, o[d0], 0, 0, 0); } while (0)
    PV_D0(0); PV_D0(1); PV_D0(2); PV_D0(3); PV_D0(4); PV_D0(5); PV_D0(6); PV_D0(7);
#undef PV_D0
#undef TRRD
}
template <int VB>
__device__ __forceinline__ void pv_partial(f32x16* o, int vb0, bf16x8 pa0, bf16x8 pa1, f32x16& p, float& m_reg, float& mn, float& alpha) {
#define TRRD(dst, off) asm volatile("ds_read_b64_tr_b16 %0, %1 offset:%2" : "=&v"(dst) : "v"(vb0), "i"(off) : "memory")
#define PV_D0(d0) do { s16x4 l0, l1, h0, h1; constexpr int b_ = VB * SHM_V + v_rd_off(d0, 0, 0); \
        TRRD(l0, b_); TRRD(h0, b_ + 4096); TRRD(l1, b_ + 8192); TRRD(h1, b_ + 12288); \
        asm volatile("s_waitcnt lgkmcnt(0)" ::: "memory"); SBAR(); \
        o[d0] = __builtin_amdgcn_mfma_f32_32x32x16_bf16(pa0, (bf16x8){l0[0], l0[1], l0[2], l0[3], h0[0], h0[1], h0[2], h0[3]}, o[d0], 0, 0, 0);   \
        o[d0] = __builtin_amdgcn_mfma_f32_32x32x16_bf16(pa1, (bf16x8){l1[0], l1[1], l1[2], l1[3], h1[0], h1[1], h1[2], h1[3]}, o[d0], 0, 0, 0); } while (0)
    constexpr float C2 = 1.4426950408889634f * SCALE;
    PV_D0(0); float pmax = fmaxf(fmaxf(p[0], p[1]), fmaxf(p[2], p[3]));
    PV_D0(1); pmax = fmaxf(pmax, fmaxf(fmaxf(p[4], p[5]), fmaxf(p[6], p[7])));
    PV_D0(2); pmax = fmaxf(pmax, fmaxf(fmaxf(p[8], p[9]), fmaxf(p[10], p[11])));
    PV_D0(3); pmax = fmaxf(pmax, fmaxf(fmaxf(p[12], p[13]), fmaxf(p[14], p[15])));
    { auto rr = __builtin_amdgcn_permlane32_swap(__float_as_uint(pmax), __float_as_uint(pmax), false, false); pmax = fmaxf(__uint_as_float(rr[0]), __uint_as_float(rr[1])); }
    PV_D0(4);
    if (__builtin_expect(__all((pmax - m_reg) * SCALE <= THR), 1)) { mn = m_reg; alpha = 1.f; }
    else { mn = fmaxf(m_reg, pmax); alpha = __builtin_amdgcn_exp2f((m_reg - mn) * C2); m_reg = mn; }
    const float mnL = -mn * C2;
    PV_D0(5);
#pragma unroll
    for (int r = 0; r < 8; ++r) p[r] = fmaf(p[r], C2, mnL);
    PV_D0(6);
#pragma unroll
    for (int r = 8; r < 16; ++r) p[r] = fmaf(p[r], C2, mnL);
#pragma unroll
    for (int r = 0; r < 4; ++r) p[r] = __builtin_amdgcn_exp2f(p[r]);
    PV_D0(7);
#pragma unroll
    for (int r = 4; r < 8; ++r) p[r] = __builtin_amdgcn_exp2f(p[r]);
#undef PV_D0
#undef TRRD
}
struct BlockRef { const bf16_t* Q; const bf16_t* K; const bf16_t* V; int jlo, jhi, lastbase, first; };
struct Seam { bf16x8 qr[8]; bf16x8 st_v0, st_v1, st_k; };
#define ROW2(p, k0) ((p) + (size_t)((k0) + sr) * PITCH + sc)
#define VMW() asm volatile("s_waitcnt vmcnt(0)" ::: "memory")
#define VMWN(n) asm volatile("s_waitcnt vmcnt(%0)" :: "i"(n) : "memory")
#define SLOAD2(Kp, Vp, k0) do { S.st_v0 = load8(ROW2(Vp, k0)); S.st_v1 = load8(ROW2(Vp, k0) + 128); S.st_k = load8(ROW2(Kp, k0)); } while (0)
#define SWRITE2K(bf) do { *(bf16x8*)(K_lds + (bf) * SHM_K + kws) = S.st_k; } while (0)
#define SWRITE2V(bf) do { *(bf16x8*)(V_lds + (bf) * SHM_V + vst0) = S.st_v0; *(bf16x8*)(V_lds + (bf) * SHM_V + vst1) = S.st_v1; } while (0)
#define SWRITE2(bf) do { SWRITE2V(bf); SWRITE2K(bf); } while (0)
__device__ __forceinline__ void attn_prime(const BlockRef& cur, char* lds, Seam& S, const int wid) {
    int lane = lane_id(); asm volatile("" : "+v"(lane));
    const int tid = wid * 64 + lane, r32 = lane & 31, hi = lane >> 5;
    const int sr = tid >> 4, sc = (tid & 15) * 8, kws = KSWZ(sr, sc * 2); char* K_lds = lds + OFF_K;
    const int kb0 = cur.jlo * KV;
    for (int d0 = 0; d0 < 8; ++d0) S.qr[d0] = load8(cur.Q + (size_t)(wid * QBLK + r32) * PITCH + d0 * 16 + hi * 8);
    SLOAD2(cur.K, cur.V, kb0); VMW(); SWRITE2K(0);
    __syncthreads();
}
__device__ __forceinline__ void attn_block(const int MODE, const BlockRef& cur, const BlockRef& nxt, char* lds, Seam& S, float* stash, bf16_t* Oout, float lam, const int wid) {
    int lane = lane_id(); asm volatile("" : "+v"(lane));
    const int tid = wid * 64 + lane, r32 = lane & 31, hi = lane >> 5;
    const int j_lo = cur.jlo, NT = cur.jhi - cur.jlo;
    const int kbn = nxt.jlo * KV;
    const int lastw = cur.first ? cur.lastbase : cur.lastbase + 2 * (wid >> 1);
    char* V_lds = lds; char* K_lds = lds + OFF_K;
    float* ws = (float*)(lds + OFF_S) + wid * 64; float* li_l = ws, * al_l = ws + 32;
    float m_reg = -1e30f, l_reg = 0; f32x16 o[8] = {};
    const int sr = tid >> 4, sc = (tid & 15) * 8, vst0 = v_st(sr, sc), vst1 = v_st(sr, sc + 128), kws = KSWZ(sr, sc * 2);
    const int vb0 = (int)(uintptr_t)V_lds + v_rd_base(lane);
    const bf16_t* Kh = cur.K; const bf16_t* Vh = cur.V;
#define RESC(a) do { if (__any((a) < 1.f)) { if (hi == 0) al_l[r32] = (a); asm volatile("s_waitcnt lgkmcnt(0)" ::: "memory");              \
                     for (int d_ = 0; d_ < 8; ++d_) for (int r = 0; r < 16; ++r) o[d_][r] *= al_l[crow(r, hi)]; } } while (0)
#define KBASE(t) ((j_lo + (t)) * KV)
#define MASKT(P_, t) do { const int jt_ = j_lo + (t); if (jt_ == 7 || jt_ > lastw) mask1(P_, jt_ > lastw); } while (0)
#define SEAM_K0() do { VMWN(8); SWRITE2K(0); SBAR(); } while (0)
    f32x16 pA, pB; float mnA, mnB, alA, alB; bf16x8 pa0, pa1;
    SWRITE2V(0); SBAR();
    if (NT > 1) { SLOAD2(Kh, Vh, KBASE(1)); }
    SBAR(); qkt<0>(pA, K_lds, r32, hi, S.qr);
    MASKT(pA, 0); partialSM(pA, m_reg, mnA, alA);
    if (NT > 1) { VMW(); SWRITE2(1); }
    __syncthreads();
#define HALF_STEP(PX, mnX, alX, PY, alY, t, KB, VB, SB) do {                                                      \
        SBAR(); qkt<KB>(PX, K_lds, r32, hi, S.qr);                                             \
        finishSM(PY, alY, l_reg, pa0, pa1); SBAR();                                                           \
        if ((t) + 1 < NT) { SLOAD2(Kh, Vh, KBASE((t) + 1)); SBAR(); }                                               \
        MASKT(PX, (t)); pv_partial<VB>(o, vb0, pa0, pa1, PX, m_reg, mnX, alX);                                        \
        __syncthreads();                                                                                                      \
        if ((t) + 1 < NT) { VMW(); SWRITE2(SB); }                                                                          \
        RESC(alX); __syncthreads(); } while (0)
    for (int t = 1; t + 1 < NT; t += 2) {
        HALF_STEP(pB, mnB, alB, pA, alA, t, 1, 0, 0);
        HALF_STEP(pA, mnA, alA, pB, alB, t + 1, 0, 1, 1);
    }
    const bool even = (NT & 1) == 0;
    if (even) { SBAR(); qkt<1>(pB, K_lds, r32, hi, S.qr); SBAR(); }
    SLOAD2(nxt.K, nxt.V, kbn); SBAR();
#pragma unroll
    for (int d0 = 0; d0 < 8; ++d0) S.qr[d0] = load8(nxt.Q + (size_t)(wid * QBLK + r32) * PITCH + d0 * 16 + hi * 8);
    SBAR();
    finishSM(pA, alA, l_reg, pa0, pa1); SBAR();
    pv_tile<0>(o, vb0, pa0, pa1);
    if (even) { MASKT(pB, NT - 1); partialSM(pB, m_reg, mnB, alB); __syncthreads(); RESC(alB);
        finishSM(pB, alB, l_reg, pa0, pa1); SBAR(); pv_tile<1>(o, vb0, pa0, pa1); }
    SBAR(); SEAM_K0();
    if (hi == 0) li_l[r32] = l_reg; asm volatile("s_waitcnt lgkmcnt(0)" ::: "memory");
    int hie = hi; asm volatile("" : "+v"(hie));
    float rli[16];
#pragma unroll
    for (int r = 0; r < 16; ++r) rli[r] = __builtin_amdgcn_rcpf(li_l[crow(r, hie)]);
    if (MODE == 0) {
        float* Ow = stash + (wid * QBLK + 4 * hie) * DV + r32;
#pragma unroll
        for (int r = 0; r < 16; ++r) {
#pragma unroll
            for (int d0 = 0; d0 < 8; ++d0) Ow[((r & 3) + 8 * (r >> 2)) * DV + d0 * 32] = o[d0][r] * rli[r]; }
    } else {
        const float* Sw = stash + (wid * QBLK + 4 * hie) * DV + r32;
        bf16_t* Ow = Oout + (size_t)((wid * QBLK + 4 * hie) * PITCH + r32);
#pragma unroll
        for (int rg = 0; rg < 8; ++rg) {
            float sv[2][8];
#pragma unroll
            for (int rr = 0; rr < 2; ++rr)
#pragma unroll
                for (int d0 = 0; d0 < 8; ++d0) sv[rr][d0] = Sw[((2 * rg + rr) & 3) * DV + 8 * ((2 * rg + rr) >> 2) * DV + d0 * 32];
#pragma unroll
            for (int rr = 0; rr < 2; ++rr) { const int r = 2 * rg + rr;
#pragma unroll
                for (int d0 = 0; d0 < 8; ++d0) { const float v = sv[rr][d0] - lam * (o[d0][r] * rli[r]);
                    const float vn = xor1(v);
                    if ((r32 & 1) == 0) *(unsigned*)(Ow + ((r & 3) + 8 * (r >> 2)) * PITCH + d0 * 32) = cvt_pk_bf16(v, vn); } }
            SBAR(); }
    }
    __syncthreads();
#undef RESC
#undef KBASE
#undef MASKT
#undef SEAM_K0
#undef HALF_STEP
}
#undef ROW2
#undef VMW
#undef VMWN
#undef SLOAD2
#undef SWRITE2K
#undef SWRITE2V
#undef SWRITE2
}
namespace att4 {
using att::crow; using att::load8; using att::v_rd_base; using att::SCALE; using att::THR;
using att2::mask1; using att2::partialSM; using att2::finishSM; using att2::v_rd_off;
constexpr int NW = 8, QBLK = 32, KV = 32, PITCH = 2048, DV = 256;
constexpr int SHM_V = KV * DV * 2, SHM_K = KV * 128 * 2, NVB = 3;
constexpr int OFF_K = NVB * SHM_V, OFF_S = OFF_K + 2 * SHM_K, LDS_BYTES = OFF_S + NW * 64 * 4;
static_assert(SHM_K == att2::SHM_K && SHM_V == att2::SHM_V, "att4 reuses att2's tile readers");
struct PassRef { const bf16_t* Q; const bf16_t* K; const bf16_t* V; int jlo, jhi, lastbase, first; };
#define KRD(dst, addr, off) asm volatile("ds_read_b128 %0, %1 offset:%2" : "=&v"(dst) : "v"(addr), "i"(off) : "memory")
#define LGK0() asm volatile("s_waitcnt lgkmcnt(0)" ::: "memory")
#define MF(acc, a, b) acc = __builtin_amdgcn_mfma_f32_32x32x16_bf16(a, b, acc, 0, 0, 0)
template <int KB>
__device__ __forceinline__ void qkt_finish(f32x16& p, const int (&kb)[4], const bf16x8* qr, f32x16& py, float alY, float& l_reg, bf16x8& pa0, bf16x8& pa1) {
    constexpr int B = KB * SHM_K;
    bf16x8 f0, f1, f2, f3;
    p = f32x16{};
    KRD(f0, kb[0], B); KRD(f1, kb[1], B); LGK0(); SBAR();
    KRD(f2, kb[2], B); KRD(f3, kb[3], B); MF(p, f0, qr[0]); MF(p, f1, qr[1]);
#pragma unroll
    for (int r = 8; r < 12; ++r) py[r] = __builtin_amdgcn_exp2f(py[r]);
    LGK0(); SBAR();
    KRD(f0, kb[0], B + 128); KRD(f1, kb[1], B + 128); MF(p, f2, qr[2]); MF(p, f3, qr[3]);
#pragma unroll
    for (int r = 12; r < 16; ++r) py[r] = __builtin_amdgcn_exp2f(py[r]);
    LGK0(); SBAR();
    KRD(f2, kb[2], B + 128); KRD(f3, kb[3], B + 128); MF(p, f0, qr[4]); MF(p, f1, qr[5]);
    { float ps = 0;
#pragma unroll
      for (int r = 0; r < 16; ++r) ps += py[r];
      auto rr = __builtin_amdgcn_permlane32_swap(__float_as_uint(ps), __float_as_uint(ps), false, false);
      ps = __uint_as_float(rr[0]) + __uint_as_float(rr[1]); l_reg = l_reg * alY + ps; }
    LGK0(); SBAR();
    MF(p, f2, qr[6]); MF(p, f3, qr[7]);
#define PK4(P, B_, OUT) do { unsigned a0 = cvt_pk_bf16(P[B_+0], P[B_+1]), a1 = cvt_pk_bf16(P[B_+2], P[B_+3]);                          \
        unsigned b0 = cvt_pk_bf16(P[B_+4], P[B_+5]), b1 = cvt_pk_bf16(P[B_+6], P[B_+7]);                                             \
        auto r0 = __builtin_amdgcn_permlane32_swap(a0, b0, false, false); auto r1 = __builtin_amdgcn_permlane32_swap(a1, b1, false, false); \
        u32x4 w = {r0[0], r1[0], r0[1], r1[1]}; OUT = *reinterpret_cast<bf16x8*>(&w); } while (0)
    PK4(py, 0, pa0); PK4(py, 8, pa1);
#undef PK4
    SBAR();
}
template <bool WITH_P>
__device__ __forceinline__ void pv_partial(f32x16* o, int vbase, bf16x8 pa0, bf16x8 pa1, f32x16& p, float& m_reg, float& mn, float& alpha) {
#define TRRD(dst, off) asm volatile("ds_read_b64_tr_b16 %0, %1 offset:%2" : "=&v"(dst) : "v"(vbase), "i"(off) : "memory")
#define PV_RD(l0, h0, l1, h1, d0) do { constexpr int b_ = v_rd_off(d0, 0, 0); TRRD(l0, b_); TRRD(h0, b_ + 4096); TRRD(l1, b_ + 8192); TRRD(h1, b_ + 12288); } while (0)
#define PV_MM(l0, h0, l1, h1, d0) do { __builtin_amdgcn_s_setprio(1); \
        MF(o[d0], pa0, ((bf16x8){l0[0], l0[1], l0[2], l0[3], h0[0], h0[1], h0[2], h0[3]}));   \
        MF(o[d0], pa1, ((bf16x8){l1[0], l1[1], l1[2], l1[3], h1[0], h1[1], h1[2], h1[3]})); __builtin_amdgcn_s_setprio(0); } while (0)
    constexpr float C2 = 1.4426950408889634f * SCALE;
    s16x4 a0, a1, a2, a3, b0, b1, b2, b3; float pmax = 0.f, mnL = 0.f;
    PV_RD(a0, a1, a2, a3, 0); LGK0(); SBAR();
    PV_RD(b0, b1, b2, b3, 1); PV_MM(a0, a1, a2, a3, 0);
    if (WITH_P) pmax = fmaxf(fmaxf(fmaxf(p[0], p[1]), fmaxf(p[2], p[3])), fmaxf(fmaxf(p[4], p[5]), fmaxf(p[6], p[7])));
    LGK0(); SBAR();
    PV_RD(a0, a1, a2, a3, 2); PV_MM(b0, b1, b2, b3, 1);
    if (WITH_P) { pmax = fmaxf(pmax, fmaxf(fmaxf(fmaxf(p[8], p[9]), fmaxf(p[10], p[11])), fmaxf(fmaxf(p[12], p[13]), fmaxf(p[14], p[15]))));
        auto rr = __builtin_amdgcn_permlane32_swap(__float_as_uint(pmax), __float_as_uint(pmax), false, false); pmax = fmaxf(__uint_as_float(rr[0]), __uint_as_float(rr[1])); }
    LGK0(); SBAR();
    PV_RD(b0, b1, b2, b3, 3); PV_MM(a0, a1, a2, a3, 2);
    if (WITH_P) { if (__builtin_expect(__all((pmax - m_reg) * SCALE <= THR), 1)) { mn = m_reg; alpha = 1.f; }
        else { mn = fmaxf(m_reg, pmax); alpha = __builtin_amdgcn_exp2f((m_reg - mn) * C2); m_reg = mn; }
        mnL = -mn * C2; }
    LGK0(); SBAR();
    PV_RD(a0, a1, a2, a3, 4); PV_MM(b0, b1, b2, b3, 3);
    if (WITH_P) {
#pragma unroll
        for (int r = 0; r < 8; ++r) p[r] = fmaf(p[r], C2, mnL); }
    LGK0(); SBAR();
    PV_RD(b0, b1, b2, b3, 5); PV_MM(a0, a1, a2, a3, 4);
    if (WITH_P) {
#pragma unroll
        for (int r = 8; r < 16; ++r) p[r] = fmaf(p[r], C2, mnL); }
    LGK0(); SBAR();
    PV_RD(a0, a1, a2, a3, 6); PV_MM(b0, b1, b2, b3, 5);
    if (WITH_P) {
#pragma unroll
        for (int r = 0; r < 4; ++r) p[r] = __builtin_amdgcn_exp2f(p[r]); }
    LGK0(); SBAR();
    PV_RD(b0, b1, b2, b3, 7); PV_MM(a0, a1, a2, a3, 6);
    if (WITH_P) {
#pragma unroll
        for (int r = 4; r < 8; ++r) p[r] = __builtin_amdgcn_exp2f(p[r]); }
    LGK0(); SBAR();
    PV_MM(b0, b1, b2, b3, 7);
    SBAR();
#undef PV_MM
#undef PV_RD
#undef TRRD
}
__device__ __forceinline__ void attn_pass(const int MODE, const PassRef& cur, LAS unsigned char* ldsL, float* stash, bf16_t* Oout, float lam, const int wid) {
    int lane = lane_id(); asm volatile("" : "+v"(lane));
    const int r32 = lane & 31, hi = lane >> 5;
    const int j_lo = cur.jlo, NT = cur.jhi - cur.jlo;
    const int lastw = cur.first ? cur.lastbase : cur.lastbase + 2 * (wid >> 1);
    char* lds = (char*)ldsL;
    float* ws = (float*)(lds + OFF_S) + wid * 64; float* li_l = ws, * al_l = ws + 32;
    unsigned voffK, voffV0, voffV1;
    { const int o = wid * 1024 + lane * 16, row = o >> 8, c = ((o >> 4) & 15) ^ (row & 7); voffK = (unsigned)(row * PITCH * 2 + c * 16); }
    { const int o = wid * 1024 + lane * 16, st = o >> 9, kk = (st >> 3) * 8 + ((o & 511) >> 6), q = (o >> 4) & 3, c = (st & 7) * 32 + 8 * q, k = (kk & ~0xC) | ((kk & 4) << 1) | ((kk & 8) >> 1);
      voffV0 = (unsigned)(k * PITCH * 2 + c * 2); }
    { const int o = 8192 + wid * 1024 + lane * 16, st = o >> 9, kk = (st >> 3) * 8 + ((o & 511) >> 6), q = (o >> 4) & 3, c = (st & 7) * 32 + 8 * q, k = (kk & ~0xC) | ((kk & 4) << 1) | ((kk & 8) >> 1);
      voffV1 = (unsigned)(k * PITCH * 2 + c * 2); }
    const char* Kg = (const char*)cur.K + (size_t)j_lo * KV * PITCH * 2; const char* Vg = (const char*)cur.V + (size_t)j_lo * KV * PITCH * 2;
    constexpr size_t TSTEP = (size_t)KV * PITCH * 2;
#define DMA_K(t, kbuf) __builtin_amdgcn_global_load_lds((const unsigned*)(Kg + (size_t)(t) * TSTEP + voffK), (LAS unsigned*)(ldsL + OFF_K + (kbuf) * SHM_K + wid * 1024), 16, 0, 0)
#define DMA_V(t, vbuf) do { __builtin_amdgcn_global_load_lds((const unsigned*)(Vg + (size_t)(t) * TSTEP + voffV0), (LAS unsigned*)(ldsL + (vbuf) * SHM_V + wid * 1024), 16, 0, 0); \
                            __builtin_amdgcn_global_load_lds((const unsigned*)(Vg + (size_t)(t) * TSTEP + voffV1), (LAS unsigned*)(ldsL + (vbuf) * SHM_V + 8192 + wid * 1024), 16, 0, 0); } while (0)
#define VMC(n) asm volatile("s_waitcnt vmcnt(" #n ")" ::: "memory")
#define BAR() __builtin_amdgcn_s_barrier()
    bf16x8 qr[8];
#pragma unroll
    for (int d0 = 0; d0 < 8; ++d0) qr[d0] = load8(cur.Q + (size_t)(wid * QBLK + r32) * PITCH + d0 * 16 + hi * 8);
    DMA_K(0, 0); DMA_V(0, 0);
    if (NT > 1) { DMA_K(1, 1); DMA_V(1, 1); }
    const char* K_lds = lds + OFF_K;
    const int vb0 = (int)(uintptr_t)lds + v_rd_base(lane);
    float m_reg = -1e30f, l_reg = 0; f32x16 o[8] = {};
#define RESC(a) do { if (__any((a) < 1.f)) { if (hi == 0) al_l[r32] = (a); asm volatile("s_waitcnt lgkmcnt(0)" ::: "memory");              \
                     _Pragma("unroll") for (int d_ = 0; d_ < 8; ++d_) _Pragma("unroll") for (int r = 0; r < 16; ++r) o[d_][r] *= al_l[crow(r, hi)]; } } while (0)
#define MASKT(P_, t) do { const int jt_ = j_lo + (t); if (jt_ == 7 || jt_ > lastw) mask1(P_, jt_ > lastw); } while (0)
    f32x16 p; float mn, al; bf16x8 pa0, pa1;
    if (NT > 1) VMC(3); else VMC(0);
    BAR();
    att2::qkt<0>(p, K_lds, r32, hi, qr); MASKT(p, 0); partialSM(p, m_reg, mn, al);
    if (NT > 1) { VMC(2); BAR(); }
    int vslot = 0;
    for (int t = 1; t < NT; ++t) {
        SBAR();
        if (t + 1 < NT) { const int vn_ = vslot == 0 ? 2 : vslot - 1; DMA_K(t + 1, (t + 1) & 1); DMA_V(t + 1, vn_); }
        f32x16 pn; float aln;
        att2::qkt<0>(pn, K_lds + (t & 1) * SHM_K, r32, hi, qr); finishSM(p, al, l_reg, pa0, pa1); SBAR();
        MASKT(pn, t); pv_partial<true>(o, vb0 + vslot * SHM_V, pa0, pa1, pn, m_reg, mn, aln);
        RESC(aln);
        p = pn; al = aln;
        if (t + 1 < NT) VMC(2); else VMC(0);
        asm volatile("s_waitcnt lgkmcnt(0)" ::: "memory");
        BAR(); vslot = vslot == 2 ? 0 : vslot + 1;
    }
    finishSM(p, al, l_reg, pa0, pa1); SBAR();
    att2::pv_tile<0>(o, vb0 + vslot * SHM_V, pa0, pa1);
    if (hi == 0) li_l[r32] = l_reg; asm volatile("s_waitcnt lgkmcnt(0)" ::: "memory");
    int hie = hi; asm volatile("" : "+v"(hie));
    float rli[16];
#pragma unroll
    for (int r = 0; r < 16; ++r) rli[r] = __builtin_amdgcn_rcpf(li_l[crow(r, hie)]);
    if (MODE == 0) {
        float* Ow = stash + (wid * QBLK + 4 * hie) * DV + r32;
#pragma unroll
        for (int r = 0; r < 16; ++r) {
#pragma unroll
            for (int d0 = 0; d0 < 8; ++d0) Ow[((r & 3) + 8 * (r >> 2)) * DV + d0 * 32] = o[d0][r] * rli[r]; }
    } else {
        const float* Sw = stash + (wid * QBLK + 4 * hie) * DV + r32;
        bf16_t* Ow = Oout + (size_t)((wid * QBLK + 4 * hie) * PITCH + r32);
#pragma unroll
        for (int rg = 0; rg < 8; ++rg) {
            float sv[2][8];
#pragma unroll
            for (int rr = 0; rr < 2; ++rr)
#pragma unroll
                for (int d0 = 0; d0 < 8; ++d0) sv[rr][d0] = Sw[((2 * rg + rr) & 3) * DV + 8 * ((2 * rg + rr) >> 2) * DV + d0 * 32];
#pragma unroll
            for (int rr = 0; rr < 2; ++rr) { const int r = 2 * rg + rr;
#pragma unroll
                for (int d0 = 0; d0 < 8; ++d0) { const float v = sv[rr][d0] - lam * (o[d0][r] * rli[r]);
                    const float vn = xor1(v);
                    if ((r32 & 1) == 0) *(unsigned*)(Ow + ((r & 3) + 8 * (r >> 2)) * PITCH + d0 * 32) = cvt_pk_bf16(v, vn); } }
            SBAR(); }
    }
    VMC(0); BAR();
#undef RESC
#undef MASKT
#undef DMA_K
#undef DMA_V
#undef VMC
#undef BAR
}
#undef KRD
#undef LGK0
#undef MF
}
namespace att7 {
using att::crow; using att::load8; using att::v_rd_base; using att::SCALE; using att::THR;
using att2::mask1; using att2::v_rd_off;
constexpr int NW = 8, QBLK = 32, KV = 32, PITCH = 2048, DV = 256;
constexpr int SHM_V = KV * DV * 2, SHM_K = KV * 128 * 2, NVB = 3;
constexpr int OFF_K = NVB * SHM_V, OFF_Q = OFF_K + 2 * SHM_K, OFF_S = 132096, LDS_BYTES = OFF_S + NW * 64 * 4;
struct PassRef { const bf16_t* Q; const bf16_t* K; const bf16_t* V; int jlo, jhi, lastbase, first; };

#define KRD(dst, addr, off) asm volatile("ds_read_b128 %0, %1 offset:%2" : "=&v"(dst) : "v"(addr), "i"(off) : "memory")
#define LGK0() asm volatile("s_waitcnt lgkmcnt(0)" ::: "memory")
#define MF(acc, a, b) acc = __builtin_amdgcn_mfma_f32_32x32x16_bf16(a, b, acc, 0, 0, 0)
#define TRRD(dst, off) asm volatile("ds_read_b64_tr_b16 %0, %1 offset:%2" : "=&v"(dst) : "v"(vbase), "i"(off) : "memory")
#define PV_RD(l0, h0, l1, h1, d0) do { constexpr int b_ = v_rd_off(d0, 0, 0); TRRD(l0, b_); TRRD(h0, b_ + 4096); TRRD(l1, b_ + 8192); TRRD(h1, b_ + 12288); } while (0)
#define PV_MM(l0, h0, l1, h1, d0) do { \
        MF(o[d0], pa0, ((bf16x8){l0[0], l0[1], l0[2], l0[3], h0[0], h0[1], h0[2], h0[3]}));   \
        MF(o[d0], pa1, ((bf16x8){l1[0], l1[1], l1[2], l1[3], h1[0], h1[1], h1[2], h1[3]})); } while (0)
#define K_RD(dst, d0) KRD(dst, kbs[(d0) & 3], ((d0) >> 2) * 128)
#define Q_RD(dst, d0) KRD(dst, qb[(d0) & 3], ((d0) >> 2) * 128)

template <int N> __device__ __forceinline__ void lgk_wait() { asm volatile("s_waitcnt lgkmcnt(%0)" :: "n"(N) : "memory"); }
template <bool WITH_QK, bool WITH_PV>
__device__ __forceinline__ void fused_step(f32x16* o, int vbase, bf16x8& pa0, bf16x8& pa1, const int (&kbs)[4], const int (&qb)[4], f32x16& p, f32x16& pn, float& m_reg, float& l_reg, float& alpha,
                                           const bool mask_any, const bool mask_all) {
    constexpr float C2 = 1.4426950408889634f * SCALE;
    s16x4 lA, hA, lB, hB, lC, hC; bf16x8 kA, kB, kC, qA, qB, qC; float pmax = 0.f, mn = 0.f, mnL = 0.f, ps = 0.f; unsigned x0 = 0, x1 = 0, x2 = 0, x3 = 0, y0 = 0, y1 = 0, y2 = 0, y3 = 0;
    if (WITH_QK) pn = f32x16{};
#define WAITL(n) asm volatile("s_waitcnt lgkmcnt(" #n ")" ::: "memory")
#define RDV(l, h, g) do { constexpr int b_ = v_rd_off((g) >> 1, 0, 0) + ((g) & 1) * 8192; TRRD(l, b_); TRRD(h, b_ + 4096); } while (0)
#define MMV(l, h, g) MF(o[(g) >> 1], (((g) & 1) ? pa1 : pa0), ((bf16x8){l[0], l[1], l[2], l[3], h[0], h[1], h[2], h[3]}))
    if (WITH_PV) RDV(lA, hA, 0); if (WITH_PV) RDV(lB, hB, 1);
    if (WITH_PV) RDV(lC, hC, 2); lgk_wait<(WITH_PV ? 4 : 0) + (WITH_QK ? 0 : 0)>(); SBAR(); if (WITH_PV) MMV(lA, hA, 0); if (mask_any) mask1(p, mask_all); pmax = fmaxf(fmaxf(p[0], p[1]), fmaxf(p[2], p[3])); SBAR();
    if (WITH_PV) RDV(lA, hA, 3); lgk_wait<(WITH_PV ? 4 : 0) + (WITH_QK ? 0 : 0)>(); SBAR(); if (WITH_PV) MMV(lB, hB, 1); pmax = fmaxf(pmax, fmaxf(fmaxf(p[4], p[5]), fmaxf(p[6], p[7]))); SBAR();
    if (WITH_PV) RDV(lB, hB, 4); lgk_wait<(WITH_PV ? 4 : 0) + (WITH_QK ? 0 : 0)>(); SBAR(); if (WITH_PV) MMV(lC, hC, 2); pmax = fmaxf(pmax, fmaxf(fmaxf(p[8], p[9]), fmaxf(p[10], p[11]))); SBAR();
    if (WITH_PV) RDV(lC, hC, 5); lgk_wait<(WITH_PV ? 4 : 0) + (WITH_QK ? 0 : 0)>(); SBAR(); if (WITH_PV) MMV(lA, hA, 3); pmax = fmaxf(pmax, fmaxf(fmaxf(p[12], p[13]), fmaxf(p[14], p[15]))); SBAR();
    if (WITH_PV) RDV(lA, hA, 6); lgk_wait<(WITH_PV ? 4 : 0) + (WITH_QK ? 0 : 0)>(); SBAR(); if (WITH_PV) MMV(lB, hB, 4); { auto rr = __builtin_amdgcn_permlane32_swap(__float_as_uint(pmax), __float_as_uint(pmax), false, false); pmax = fmaxf(__uint_as_float(rr[0]), __uint_as_float(rr[1])); } SBAR();
    if (WITH_PV) RDV(lB, hB, 7); lgk_wait<(WITH_PV ? 4 : 0) + (WITH_QK ? 0 : 0)>(); SBAR(); if (WITH_PV) MMV(lC, hC, 5); if (__builtin_expect(__all((pmax - m_reg) * SCALE <= THR), 1)) { mn = m_reg; alpha = 1.f; } else { mn = fmaxf(m_reg, pmax); alpha = __builtin_amdgcn_exp2f((m_reg - mn) * C2); m_reg = mn; } mnL = -mn * C2; SBAR();
    if (WITH_PV) RDV(lC, hC, 8); lgk_wait<(WITH_PV ? 4 : 0) + (WITH_QK ? 0 : 0)>(); SBAR(); if (WITH_PV) MMV(lA, hA, 6); p[0] = fmaf(p[0], C2, mnL); p[1] = fmaf(p[1], C2, mnL); p[2] = fmaf(p[2], C2, mnL); p[3] = fmaf(p[3], C2, mnL); SBAR();
    if (WITH_PV) RDV(lA, hA, 9); lgk_wait<(WITH_PV ? 4 : 0) + (WITH_QK ? 0 : 0)>(); SBAR(); if (WITH_PV) MMV(lB, hB, 7); p[4] = fmaf(p[4], C2, mnL); p[5] = fmaf(p[5], C2, mnL); p[6] = fmaf(p[6], C2, mnL); p[7] = fmaf(p[7], C2, mnL); SBAR();
    if (WITH_PV) RDV(lB, hB, 10); lgk_wait<(WITH_PV ? 4 : 0) + (WITH_QK ? 0 : 0)>(); SBAR(); if (WITH_PV) MMV(lC, hC, 8); p[8] = fmaf(p[8], C2, mnL); p[9] = fmaf(p[9], C2, mnL); p[10] = fmaf(p[10], C2, mnL); p[11] = fmaf(p[11], C2, mnL); SBAR();
    if (WITH_PV) RDV(lC, hC, 11); lgk_wait<(WITH_PV ? 4 : 0) + (WITH_QK ? 0 : 0)>(); SBAR(); if (WITH_PV) MMV(lA, hA, 9); p[12] = fmaf(p[12], C2, mnL); p[13] = fmaf(p[13], C2, mnL); p[14] = fmaf(p[14], C2, mnL); p[15] = fmaf(p[15], C2, mnL); SBAR();
    if (WITH_PV) RDV(lA, hA, 12); lgk_wait<(WITH_PV ? 4 : 0) + (WITH_QK ? 0 : 0)>(); SBAR(); if (WITH_PV) MMV(lB, hB, 10); p[0] = __builtin_amdgcn_exp2f(p[0]); p[1] = __builtin_amdgcn_exp2f(p[1]); SBAR();
    if (WITH_PV) RDV(lB, hB, 13); lgk_wait<(WITH_PV ? 4 : 0) + (WITH_QK ? 0 : 0)>(); SBAR(); if (WITH_PV) MMV(lC, hC, 11); p[2] = __builtin_amdgcn_exp2f(p[2]); p[3] = __builtin_amdgcn_exp2f(p[3]); SBAR();
    if (WITH_PV) RDV(lC, hC, 14); lgk_wait<(WITH_PV ? 4 : 0) + (WITH_QK ? 0 : 0)>(); SBAR(); if (WITH_PV) MMV(lA, hA, 12); p[4] = __builtin_amdgcn_exp2f(p[4]); p[5] = __builtin_amdgcn_exp2f(p[5]); SBAR();
    if (WITH_PV) RDV(lA, hA, 15); lgk_wait<(WITH_PV ? 4 : 0) + (WITH_QK ? 0 : 0)>(); SBAR(); if (WITH_PV) MMV(lB, hB, 13); p[6] = __builtin_amdgcn_exp2f(p[6]); p[7] = __builtin_amdgcn_exp2f(p[7]); SBAR();
    if (WITH_QK) { K_RD(kB, 0); Q_RD(qB, 0); } lgk_wait<(WITH_PV ? 2 : 0) + (WITH_QK ? 2 : 0)>(); SBAR(); if (WITH_PV) MMV(lC, hC, 14); p[8] = __builtin_amdgcn_exp2f(p[8]); p[9] = __builtin_amdgcn_exp2f(p[9]); SBAR();
    if (WITH_QK) { K_RD(kC, 1); Q_RD(qC, 1); } lgk_wait<(WITH_PV ? 0 : 0) + (WITH_QK ? 4 : 0)>(); SBAR(); if (WITH_PV) MMV(lA, hA, 15); p[10] = __builtin_amdgcn_exp2f(p[10]); p[11] = __builtin_amdgcn_exp2f(p[11]); SBAR();
    if (WITH_QK) { K_RD(kA, 2); Q_RD(qA, 2); } lgk_wait<(WITH_PV ? 0 : 0) + (WITH_QK ? 4 : 0)>(); SBAR(); if (WITH_QK) MF(pn, kB, qB); p[12] = __builtin_amdgcn_exp2f(p[12]); p[13] = __builtin_amdgcn_exp2f(p[13]); SBAR();
    if (WITH_QK) { K_RD(kB, 3); Q_RD(qB, 3); } lgk_wait<(WITH_PV ? 0 : 0) + (WITH_QK ? 4 : 0)>(); SBAR(); if (WITH_QK) MF(pn, kC, qC); p[14] = __builtin_amdgcn_exp2f(p[14]); p[15] = __builtin_amdgcn_exp2f(p[15]); SBAR();
    if (WITH_QK) { K_RD(kC, 4); Q_RD(qC, 4); } lgk_wait<(WITH_PV ? 0 : 0) + (WITH_QK ? 4 : 0)>(); SBAR(); if (WITH_QK) MF(pn, kA, qA); ps = ((p[0] + p[1]) + (p[2] + p[3])) + ((p[4] + p[5]) + (p[6] + p[7])); SBAR();
    if (WITH_QK) { K_RD(kA, 5); Q_RD(qA, 5); } lgk_wait<(WITH_PV ? 0 : 0) + (WITH_QK ? 4 : 0)>(); SBAR(); if (WITH_QK) MF(pn, kB, qB); ps += ((p[8] + p[9]) + (p[10] + p[11])) + ((p[12] + p[13]) + (p[14] + p[15])); { auto rr = __builtin_amdgcn_permlane32_swap(__float_as_uint(ps), __float_as_uint(ps), false, false); ps = __uint_as_float(rr[0]) + __uint_as_float(rr[1]); } l_reg = l_reg * alpha + ps; SBAR();
    if (WITH_QK) { K_RD(kB, 6); Q_RD(qB, 6); } lgk_wait<(WITH_PV ? 0 : 0) + (WITH_QK ? 4 : 0)>(); SBAR(); if (WITH_QK) MF(pn, kC, qC); x0 = cvt_pk_bf16(p[0], p[1]); x1 = cvt_pk_bf16(p[2], p[3]); y0 = cvt_pk_bf16(p[4], p[5]); y1 = cvt_pk_bf16(p[6], p[7]); SBAR();
    if (WITH_QK) { K_RD(kC, 7); Q_RD(qC, 7); } lgk_wait<(WITH_PV ? 0 : 0) + (WITH_QK ? 4 : 0)>(); SBAR(); if (WITH_QK) MF(pn, kA, qA); x2 = cvt_pk_bf16(p[8], p[9]); x3 = cvt_pk_bf16(p[10], p[11]); y2 = cvt_pk_bf16(p[12], p[13]); y3 = cvt_pk_bf16(p[14], p[15]); SBAR();
     lgk_wait<(WITH_PV ? 0 : 0) + (WITH_QK ? 2 : 0)>(); SBAR(); if (WITH_QK) MF(pn, kB, qB); { auto r0 = __builtin_amdgcn_permlane32_swap(x0, y0, false, false); auto r1 = __builtin_amdgcn_permlane32_swap(x1, y1, false, false); u32x4 w = {r0[0], r1[0], r0[1], r1[1]}; pa0 = *reinterpret_cast<bf16x8*>(&w); } SBAR();
     lgk_wait<(WITH_PV ? 0 : 0) + (WITH_QK ? 0 : 0)>(); SBAR(); if (WITH_QK) MF(pn, kC, qC); { auto r0 = __builtin_amdgcn_permlane32_swap(x2, y2, false, false); auto r1 = __builtin_amdgcn_permlane32_swap(x3, y3, false, false); u32x4 w = {r0[0], r1[0], r0[1], r1[1]}; pa1 = *reinterpret_cast<bf16x8*>(&w); } SBAR();
#undef WAITL
#undef RDV
#undef MMV
}
__device__ __forceinline__ void attn_pass(const int MODE, const PassRef& cur, LAS unsigned char* ldsL, float* stash, bf16_t* Oout, float lam, const int wid) {
    int lane = lane_id(); asm volatile("" : "+v"(lane));
    const int r32 = lane & 31, hi = lane >> 5;
    const int j_lo = cur.jlo, NT = cur.jhi - cur.jlo;
    const int lastw = cur.first ? cur.lastbase : cur.lastbase + 2 * (wid >> 1);
    char* lds = (char*)ldsL;
    float* ws = (float*)(lds + OFF_S) + wid * 64; float* li_l = ws, * al_l = ws + 32;
    unsigned voffK, voffV0;
    { const int o = wid * 1024 + lane * 16, row = o >> 8, c = ((o >> 4) & 15) ^ (row & 7); voffK = (unsigned)(row * PITCH * 2 + c * 16); }
    { const int o = wid * 1024 + lane * 16, st = o >> 9, kk = (st >> 3) * 8 + ((o & 511) >> 6), q = (o >> 4) & 3, c = (st & 7) * 32 + 8 * q, k = (kk & ~0xC) | ((kk & 4) << 1) | ((kk & 8) >> 1);
      voffV0 = (unsigned)(k * PITCH * 2 + c * 2); }
    const char* Kg = (const char*)cur.K + (size_t)j_lo * KV * PITCH * 2; const char* Vg = (const char*)cur.V + (size_t)j_lo * KV * PITCH * 2;
    constexpr size_t TSTEP = (size_t)KV * PITCH * 2;
#define DMA_K(t, kbuf) __builtin_amdgcn_global_load_lds((const unsigned*)(Kg + (size_t)(t) * TSTEP + voffK), (LAS unsigned*)(ldsL + OFF_K + (kbuf) * SHM_K + wid * 1024), 16, 0, 0)
#define DMA_V(t, vbuf) do { __builtin_amdgcn_global_load_lds((const unsigned*)(Vg + (size_t)(t) * TSTEP + voffV0), (LAS unsigned*)(ldsL + (vbuf) * SHM_V + wid * 1024), 16, 0, 0); \
                            __builtin_amdgcn_global_load_lds((const unsigned*)(Vg + (size_t)(t) * TSTEP + (size_t)16 * PITCH * 2 + voffV0), (LAS unsigned*)(ldsL + (vbuf) * SHM_V + 8192 + wid * 1024), 16, 0, 0); } while (0)
#define VMC(n) asm volatile("s_waitcnt vmcnt(" #n ")" ::: "memory")
#define BAR() __builtin_amdgcn_s_barrier()
    { const int rq = lane >> 4;
#pragma unroll
      for (int i = 0; i < 8; ++i) { const int row = 4 * i + rq; const unsigned vq = (unsigned)(row * PITCH * 2 + (((lane & 15) ^ (row & 7)) * 16));
          __builtin_amdgcn_global_load_lds((const unsigned*)((const char*)cur.Q + (size_t)(wid * QBLK) * PITCH * 2 + vq), (LAS unsigned*)(ldsL + OFF_Q + wid * 8192 + i * 1024), 16, 0, 0); } }
    DMA_K(0, 0); DMA_V(0, 0);
    if (NT > 1) { DMA_K(1, 1); DMA_V(1, 1); }
    int kbs[4];
#pragma unroll
    for (int dd = 0; dd < 4; ++dd) kbs[dd] = (int)(uintptr_t)(lds + OFF_K) + KSWZ(r32, (dd * 16 + hi * 8) * 2);
    int qb[4];
#pragma unroll
    for (int dd = 0; dd < 4; ++dd) qb[dd] = kbs[dd] + (OFF_Q - OFF_K) + wid * 8192;
    const int vb0 = (int)(uintptr_t)lds + v_rd_base(lane);
    float m_reg = -1e30f, l_reg = 0; f32x16 o[8] = {};
#define RESC(a) do { if (__any((a) < 1.f)) { const int l_ = lane_id(), r_ = l_ & 31, h_ = l_ >> 5;   \
                     if (h_ == 0) al_l[r_] = (a); asm volatile("s_waitcnt lgkmcnt(0)" ::: "memory");              \
                     _Pragma("unroll") for (int d_ = 0; d_ < 8; ++d_) _Pragma("unroll") for (int r = 0; r < 16; ++r) o[d_][r] *= al_l[crow(r, h_)]; } } while (0)
#define KFLIP() { kbs[0] ^= SHM_K; kbs[1] ^= SHM_K; kbs[2] ^= SHM_K; kbs[3] ^= SHM_K; }
    f32x16 p, pn; float al = 1.f; bf16x8 pa0, pa1;
    if (NT > 1) VMC(3); else VMC(0);
    BAR();
    { p = f32x16{}; bf16x8 kf, qf;
#pragma unroll
      for (int d0 = 0; d0 < 8; ++d0) { K_RD(kf, d0); Q_RD(qf, d0); LGK0(); SBAR(); MF(p, kf, qf); } SBAR(); }
    if (NT > 1) { VMC(2); BAR(); }
    int vslot = 0;
    if (NT > 1) {
        if (NT > 2) DMA_K(2, 0);
        KFLIP();
        { const int jt_ = j_lo; fused_step<true, false>(o, vb0, pa0, pa1, kbs, qb, p, pn, m_reg, l_reg, al, jt_ == 7 || jt_ > lastw, jt_ > lastw); }
        p = pn;
        VMC(0); LGK0(); BAR();
        for (int t = 1; t + 1 < NT; ++t) {
            SBAR();
            { const int vn_ = vslot == 0 ? 2 : vslot - 1; if (t + 2 < NT) DMA_K(t + 2, t & 1); DMA_V(t + 1, vn_); }
            KFLIP();
            { const int jt_ = j_lo + t; fused_step<true, true>(o, vb0 + vslot * SHM_V, pa0, pa1, kbs, qb, p, pn, m_reg, l_reg, al, jt_ == 7 || jt_ > lastw, jt_ > lastw); }
            RESC(al);
            p = pn;
            VMC(2); LGK0();
            BAR(); vslot = vslot == 2 ? 0 : vslot + 1;
        }
        { const int jt_ = j_lo + NT - 1; fused_step<false, true>(o, vb0 + vslot * SHM_V, pa0, pa1, kbs, qb, p, pn, m_reg, l_reg, al, jt_ == 7 || jt_ > lastw, jt_ > lastw); }
        RESC(al);
        VMC(0); LGK0(); BAR();
        vslot = vslot == 2 ? 0 : vslot + 1;
    } else {
        { const int jt_ = j_lo; fused_step<false, false>(o, vb0, pa0, pa1, kbs, qb, p, pn, m_reg, l_reg, al, jt_ == 7 || jt_ > lastw, jt_ > lastw); }
    }
    att2::pv_tile<0>(o, vb0 + vslot * SHM_V, pa0, pa1);
    if (hi == 0) li_l[r32] = l_reg; asm volatile("s_waitcnt lgkmcnt(0)" ::: "memory");
    int hie = hi; asm volatile("" : "+v"(hie));
    float rli[16];
#pragma unroll
    for (int r = 0; r < 16; ++r) rli[r] = __builtin_amdgcn_rcpf(li_l[crow(r, hie)]);
    f32x4* st4 = (f32x4*)stash + (wid * 64 + lane);
    if (MODE == 0) {
#pragma unroll
        for (int k = 0; k < 32; ++k) { const int d0 = k >> 2, rq = k & 3;
            st4[k * 512] = (f32x4){o[d0][4 * rq] * rli[4 * rq], o[d0][4 * rq + 1] * rli[4 * rq + 1], o[d0][4 * rq + 2] * rli[4 * rq + 2], o[d0][4 * rq + 3] * rli[4 * rq + 3]}; }
    } else {
        bf16_t* Ow = Oout + (size_t)((wid * QBLK + 4 * hie) * PITCH + r32);
        f32x4 sa[8], sb[8];
#define ST_LD(buf, kg) do { _Pragma("unroll") for (int k_ = 0; k_ < 8; ++k_) buf[k_] = st4[((kg) * 8 + k_) * 512]; } while (0)
#define ST_USE(buf, kg) do { _Pragma("unroll") for (int k_ = 0; k_ < 8; ++k_) { const int k = (kg) * 8 + k_, d0 = k >> 2, rq = k & 3;                          \
            _Pragma("unroll") for (int j_ = 0; j_ < 4; ++j_) { const int r = 4 * rq + j_; const float v = buf[k_][j_] - lam * (o[d0][r] * rli[r]); const float vn = xor1(v);   \
                if ((r32 & 1) == 0) *(unsigned*)(Ow + ((r & 3) + 8 * (r >> 2)) * PITCH + d0 * 32) = cvt_pk_bf16(v, vn); } } } while (0)
        ST_LD(sa, 0); SBAR();
        ST_LD(sb, 1); SBAR(); ST_USE(sa, 0); SBAR();
        ST_LD(sa, 2); SBAR(); ST_USE(sb, 1); SBAR();
        ST_LD(sb, 3); SBAR(); ST_USE(sa, 2); SBAR();
        ST_USE(sb, 3);
#undef ST_LD
#undef ST_USE
    }
    VMC(0); BAR();
#undef RESC
#undef KFLIP
#undef DMA_K
#undef DMA_V
#undef VMC
#undef BAR
}
#undef KRD
#undef LGK0
#undef MF
#undef TRRD
#undef PV_RD
#undef PV_MM
#undef K_RD
}
namespace att8 {
using att::crow; using att::load8; using att::v_rd_base; using att::SCALE; using att::THR;
using att2::mask1; using att2::v_rd_off;
constexpr int NW = 8, QBLK = 32, KV = 32, PITCH = 2048, DV = 256, KP = 128, VP = 256;
constexpr int SHM_V = KV * DV * 2, SHM_K = KV * 128 * 2, NVB = 3;
constexpr int OFF_K = NVB * SHM_V, OFF_Q = OFF_K + 2 * SHM_K, OFF_S = 132096, LDS_BYTES = OFF_S + NW * 64 * 4;
struct PassRef { const bf16_t* Q; const bf16_t* K; const bf16_t* V; int jlo, jhi, lastbase, first; };

#define KRD(dst, addr, off) asm volatile("ds_read_b128 %0, %1 offset:%2" : "=&v"(dst) : "v"(addr), "i"(off) : "memory")
#define LGK0() asm volatile("s_waitcnt lgkmcnt(0)" ::: "memory")
#define TRRD2(dst, base, off) asm volatile("ds_read_b64_tr_b16 %0, %1 offset:%2" : "=&v"(dst) : "v"(base), "i"(off) : "memory")
#define MF16(a, b, c) __builtin_amdgcn_mfma_f32_16x16x32_bf16(a, b, c, 0, 0, 0)

#define MF(acc, a, b) acc = __builtin_amdgcn_mfma_f32_32x32x16_bf16(a, b, acc, 0, 0, 0)
#define TRRD(dst, off) asm volatile("ds_read_b64_tr_b16 %0, %1 offset:%2" : "=&v"(dst) : "v"(vbase), "i"(off) : "memory")
#define PV_RD(l0, h0, l1, h1, d0) do { constexpr int b_ = v_rd_off(d0, 0, 0); TRRD(l0, b_); TRRD(h0, b_ + 4096); TRRD(l1, b_ + 8192); TRRD(h1, b_ + 12288); } while (0)
#define PV_MM(l0, h0, l1, h1, d0) do { \
        MF(o[d0], pa0, ((bf16x8){l0[0], l0[1], l0[2], l0[3], h0[0], h0[1], h0[2], h0[3]}));   \
        MF(o[d0], pa1, ((bf16x8){l1[0], l1[1], l1[2], l1[3], h1[0], h1[1], h1[2], h1[3]})); } while (0)
#define K_RD(dst, d0) do { const int a_ = kbs[0] ^ (((d0) & 3) << 5); KRD(dst, a_, ((d0) >> 2) * 128); } while (0)
#define Q_RD(dst, d0) do { const int a_ = qb[0] ^ (((d0) & 3) << 5); KRD(dst, a_, ((d0) >> 2) * 128); } while (0)

template <int N> __device__ __forceinline__ void lgk_wait() { asm volatile("s_waitcnt lgkmcnt(%0)" :: "n"(N) : "memory"); }
template <bool WITH_QK, bool WITH_PV>
__device__ __forceinline__ void fused_step(f32x4 (&o)[32], const int vbE, bf16x8& pa0, bf16x8& pa1, const int (&kbs)[4], const int (&qb)[4], f32x16& p, f32x16& pn, float& m_reg, float& l_reg, float& alpha,
                                           const bool mask_any, const bool mask_all) {
    constexpr float C2 = 1.4426950408889634f * SCALE;
    s16x4 lA, hA, lB, hB, lC, hC; bf16x8 kA, kB, kC, qA, qB, qC; float pmax = 0.f, mn = 0.f, mnL = 0.f, ps = 0.f; unsigned x0 = 0, x1 = 0, x2 = 0, x3 = 0, y0 = 0, y1 = 0, y2 = 0, y3 = 0;
    if (WITH_QK) pn = f32x16{};
    int vb = vbE;
#define WAITL(n) asm volatile("s_waitcnt lgkmcnt(" #n ")" ::: "memory")
#define RDV(l, h, g) do { constexpr int b_ = ((g) & 7) * 2048; TRRD2(l, vb, b_); TRRD2(h, vb, b_ + 1024); } while (0)
#define MMV(l, h, g) do { constexpr int ct_ = (g) < 8 ? 2 * (g) : 2 * ((g) - 8) + 1; const bf16x8 vf_ = {l[0], l[1], l[2], l[3], h[0], h[1], h[2], h[3]}; o[ct_] = MF16(vf_, pa0, o[ct_]); o[16 + ct_] = MF16(vf_, pa1, o[16 + ct_]); } while (0)
    if (WITH_PV) RDV(lA, hA, 0); if (WITH_PV) RDV(lB, hB, 1);
    if (WITH_PV) RDV(lC, hC, 2); lgk_wait<(WITH_PV ? 4 : 0) + (WITH_QK ? 0 : 0)>(); SBAR(); if (WITH_PV) MMV(lA, hA, 0); if (mask_any) mask1(p, mask_all); pmax = fmaxf(fmaxf(p[0], p[1]), fmaxf(p[2], p[3])); SBAR();
    if (WITH_PV) RDV(lA, hA, 3); lgk_wait<(WITH_PV ? 4 : 0) + (WITH_QK ? 0 : 0)>(); SBAR(); if (WITH_PV) MMV(lB, hB, 1); pmax = fmaxf(pmax, fmaxf(fmaxf(p[4], p[5]), fmaxf(p[6], p[7]))); SBAR();
    if (WITH_PV) RDV(lB, hB, 4); lgk_wait<(WITH_PV ? 4 : 0) + (WITH_QK ? 0 : 0)>(); SBAR(); if (WITH_PV) MMV(lC, hC, 2); pmax = fmaxf(pmax, fmaxf(fmaxf(p[8], p[9]), fmaxf(p[10], p[11]))); SBAR();
    if (WITH_PV) RDV(lC, hC, 5); lgk_wait<(WITH_PV ? 4 : 0) + (WITH_QK ? 0 : 0)>(); SBAR(); if (WITH_PV) MMV(lA, hA, 3); pmax = fmaxf(pmax, fmaxf(fmaxf(p[12], p[13]), fmaxf(p[14], p[15]))); SBAR();
    if (WITH_PV) RDV(lA, hA, 6); lgk_wait<(WITH_PV ? 4 : 0) + (WITH_QK ? 0 : 0)>(); SBAR(); if (WITH_PV) MMV(lB, hB, 4); { auto rr = __builtin_amdgcn_permlane32_swap(__float_as_uint(pmax), __float_as_uint(pmax), false, false); pmax = fmaxf(__uint_as_float(rr[0]), __uint_as_float(rr[1])); } SBAR();
    if (WITH_PV) RDV(lB, hB, 7); lgk_wait<(WITH_PV ? 4 : 0) + (WITH_QK ? 0 : 0)>(); SBAR(); if (WITH_PV) MMV(lC, hC, 5); if (__builtin_expect(__all((pmax - m_reg) * SCALE <= THR), 1)) { mn = m_reg; alpha = 1.f; } else { mn = fmaxf(m_reg, pmax); alpha = __builtin_amdgcn_exp2f((m_reg - mn) * C2); m_reg = mn; } mnL = -mn * C2; SBAR();
    if (WITH_PV) vb ^= 32; if (WITH_PV) RDV(lC, hC, 8); lgk_wait<(WITH_PV ? 4 : 0) + (WITH_QK ? 0 : 0)>(); SBAR(); if (WITH_PV) MMV(lA, hA, 6); p[0] = fmaf(p[0], C2, mnL); p[1] = fmaf(p[1], C2, mnL); p[2] = fmaf(p[2], C2, mnL); p[3] = fmaf(p[3], C2, mnL); SBAR();
    if (WITH_PV) RDV(lA, hA, 9); lgk_wait<(WITH_PV ? 4 : 0) + (WITH_QK ? 0 : 0)>(); SBAR(); if (WITH_PV) MMV(lB, hB, 7); p[4] = fmaf(p[4], C2, mnL); p[5] = fmaf(p[5], C2, mnL); p[6] = fmaf(p[6], C2, mnL); p[7] = fmaf(p[7], C2, mnL); SBAR();
    if (WITH_PV) RDV(lB, hB, 10); lgk_wait<(WITH_PV ? 4 : 0) + (WITH_QK ? 0 : 0)>(); SBAR(); if (WITH_PV) MMV(lC, hC, 8); p[8] = fmaf(p[8], C2, mnL); p[9] = fmaf(p[9], C2, mnL); p[10] = fmaf(p[10], C2, mnL); p[11] = fmaf(p[11], C2, mnL); SBAR();
    if (WITH_PV) RDV(lC, hC, 11); lgk_wait<(WITH_PV ? 4 : 0) + (WITH_QK ? 0 : 0)>(); SBAR(); if (WITH_PV) MMV(lA, hA, 9); p[12] = fmaf(p[12], C2, mnL); p[13] = fmaf(p[13], C2, mnL); p[14] = fmaf(p[14], C2, mnL); p[15] = fmaf(p[15], C2, mnL); SBAR();
    if (WITH_PV) RDV(lA, hA, 12); lgk_wait<(WITH_PV ? 4 : 0) + (WITH_QK ? 0 : 0)>(); SBAR(); if (WITH_PV) MMV(lB, hB, 10); p[0] = __builtin_amdgcn_exp2f(p[0]); p[1] = __builtin_amdgcn_exp2f(p[1]); SBAR();
    if (WITH_PV) RDV(lB, hB, 13); lgk_wait<(WITH_PV ? 4 : 0) + (WITH_QK ? 0 : 0)>(); SBAR(); if (WITH_PV) MMV(lC, hC, 11); p[2] = __builtin_amdgcn_exp2f(p[2]); p[3] = __builtin_amdgcn_exp2f(p[3]); SBAR();
    if (WITH_PV) RDV(lC, hC, 14); lgk_wait<(WITH_PV ? 4 : 0) + (WITH_QK ? 0 : 0)>(); SBAR(); if (WITH_PV) MMV(lA, hA, 12); p[4] = __builtin_amdgcn_exp2f(p[4]); p[5] = __builtin_amdgcn_exp2f(p[5]); SBAR();
    if (WITH_PV) RDV(lA, hA, 15); lgk_wait<(WITH_PV ? 4 : 0) + (WITH_QK ? 0 : 0)>(); SBAR(); if (WITH_PV) MMV(lB, hB, 13); p[6] = __builtin_amdgcn_exp2f(p[6]); p[7] = __builtin_amdgcn_exp2f(p[7]); SBAR();
    if (WITH_QK) { K_RD(kB, 0); Q_RD(qB, 0); } lgk_wait<(WITH_PV ? 2 : 0) + (WITH_QK ? 2 : 0)>(); SBAR(); if (WITH_PV) MMV(lC, hC, 14); p[8] = __builtin_amdgcn_exp2f(p[8]); p[9] = __builtin_amdgcn_exp2f(p[9]); SBAR();
    if (WITH_QK) { K_RD(kC, 1); Q_RD(qC, 1); } lgk_wait<(WITH_PV ? 0 : 0) + (WITH_QK ? 4 : 0)>(); SBAR(); if (WITH_PV) MMV(lA, hA, 15); p[10] = __builtin_amdgcn_exp2f(p[10]); p[11] = __builtin_amdgcn_exp2f(p[11]); SBAR();
    if (WITH_QK) { K_RD(kA, 2); Q_RD(qA, 2); } lgk_wait<(WITH_PV ? 0 : 0) + (WITH_QK ? 4 : 0)>(); SBAR(); if (WITH_QK) MF(pn, kB, qB); p[12] = __builtin_amdgcn_exp2f(p[12]); p[13] = __builtin_amdgcn_exp2f(p[13]); SBAR();
    if (WITH_QK) { K_RD(kB, 3); Q_RD(qB, 3); } lgk_wait<(WITH_PV ? 0 : 0) + (WITH_QK ? 4 : 0)>(); SBAR(); if (WITH_QK) MF(pn, kC, qC); p[14] = __builtin_amdgcn_exp2f(p[14]); p[15] = __builtin_amdgcn_exp2f(p[15]); SBAR();
    if (WITH_QK) { K_RD(kC, 4); Q_RD(qC, 4); } lgk_wait<(WITH_PV ? 0 : 0) + (WITH_QK ? 4 : 0)>(); SBAR(); if (WITH_QK) MF(pn, kA, qA); ps = ((p[0] + p[1]) + (p[2] + p[3])) + ((p[4] + p[5]) + (p[6] + p[7])); SBAR();
    if (WITH_QK) { K_RD(kA, 5); Q_RD(qA, 5); } lgk_wait<(WITH_PV ? 0 : 0) + (WITH_QK ? 4 : 0)>(); SBAR(); if (WITH_QK) MF(pn, kB, qB); ps += ((p[8] + p[9]) + (p[10] + p[11])) + ((p[12] + p[13]) + (p[14] + p[15])); { auto rr = __builtin_amdgcn_permlane32_swap(__float_as_uint(ps), __float_as_uint(ps), false, false); ps = __uint_as_float(rr[0]) + __uint_as_float(rr[1]); } l_reg = l_reg * alpha + ps; SBAR();
    if (WITH_QK) { K_RD(kB, 6); Q_RD(qB, 6); } lgk_wait<(WITH_PV ? 0 : 0) + (WITH_QK ? 4 : 0)>(); SBAR(); if (WITH_QK) MF(pn, kC, qC); x0 = cvt_pk_bf16(p[0], p[1]); x1 = cvt_pk_bf16(p[2], p[3]); y0 = cvt_pk_bf16(p[4], p[5]); y1 = cvt_pk_bf16(p[6], p[7]); SBAR();
    if (WITH_QK) { K_RD(kC, 7); Q_RD(qC, 7); } lgk_wait<(WITH_PV ? 0 : 0) + (WITH_QK ? 4 : 0)>(); SBAR(); if (WITH_QK) MF(pn, kA, qA); x2 = cvt_pk_bf16(p[8], p[9]); x3 = cvt_pk_bf16(p[10], p[11]); y2 = cvt_pk_bf16(p[12], p[13]); y3 = cvt_pk_bf16(p[14], p[15]); SBAR();
     lgk_wait<(WITH_PV ? 0 : 0) + (WITH_QK ? 2 : 0)>(); SBAR(); if (WITH_QK) MF(pn, kB, qB); { auto r0 = __builtin_amdgcn_permlane16_swap(x0, x2, false, false); auto r1 = __builtin_amdgcn_permlane16_swap(x1, x3, false, false); u32x4 w0 = __builtin_bit_cast(u32x4, pa0), w1 = __builtin_bit_cast(u32x4, pa1); w0[0] = r0[0]; w0[1] = r1[0]; w1[0] = r0[1]; w1[1] = r1[1]; pa0 = __builtin_bit_cast(bf16x8, w0); pa1 = __builtin_bit_cast(bf16x8, w1); } SBAR();
     lgk_wait<(WITH_PV ? 0 : 0) + (WITH_QK ? 0 : 0)>(); SBAR(); if (WITH_QK) MF(pn, kC, qC); { auto r2 = __builtin_amdgcn_permlane16_swap(y0, y2, false, false); auto r3 = __builtin_amdgcn_permlane16_swap(y1, y3, false, false); u32x4 w0 = __builtin_bit_cast(u32x4, pa0), w1 = __builtin_bit_cast(u32x4, pa1); w0[2] = r2[0]; w0[3] = r3[0]; w1[2] = r2[1]; w1[3] = r3[1]; pa0 = __builtin_bit_cast(bf16x8, w0); pa1 = __builtin_bit_cast(bf16x8, w1); } SBAR();
#undef WAITL
#undef RDV
#undef MMV
}
__device__ __forceinline__ void attn_pass(const int MODE, const PassRef& cur, LAS unsigned char* ldsL, float* stash, bf16_t* Oout, float lam, const int wid) {
    int lane = lane_id(); asm volatile("" : "+v"(lane));
    const int r32 = lane & 31, hi = lane >> 5;
    const int j_lo = cur.jlo, NT = cur.jhi - cur.jlo;
    const int lastw = cur.first ? cur.lastbase : cur.lastbase + 2 * (wid >> 1);
    char* lds = (char*)ldsL;
    float* ws = (float*)(lds + OFF_S) + wid * 64; float* li_l = ws, * al_l = ws + 32;
    unsigned voffK, voffV0;
    voffK = (unsigned)(wid * 1024 + lane * 16);
    voffV0 = (unsigned)(wid * 1024 + lane * 16);
    const char* Kg = (const char*)cur.K + (size_t)j_lo * KV * KP * 2; const char* Vg = (const char*)cur.V + (size_t)j_lo * KV * VP * 2;
    constexpr size_t TSTEP_K = (size_t)KV * KP * 2, TSTEP_V = (size_t)KV * VP * 2;
#define DMA_K(t, kbuf) __builtin_amdgcn_global_load_lds((const unsigned*)(Kg + (size_t)(t) * TSTEP_K + voffK), (LAS unsigned*)(ldsL + OFF_K + (kbuf) * SHM_K + wid * 1024), 16, 0, 0)
#define DMA_V(t, vbuf) do { __builtin_amdgcn_global_load_lds((const unsigned*)(Vg + (size_t)(t) * TSTEP_V + voffV0), (LAS unsigned*)(ldsL + (vbuf) * SHM_V + wid * 1024), 16, 0, 0); \
                            __builtin_amdgcn_global_load_lds((const unsigned*)(Vg + (size_t)(t) * TSTEP_V + (size_t)8192 + voffV0), (LAS unsigned*)(ldsL + (vbuf) * SHM_V + 8192 + wid * 1024), 16, 0, 0); } while (0)
#define VMC(n) asm volatile("s_waitcnt vmcnt(" #n ")" ::: "memory")
#define BAR() __builtin_amdgcn_s_barrier()
    { const int rq = lane >> 4;
#pragma unroll
      for (int i = 0; i < 8; ++i) { const int row = 4 * i + rq; const unsigned vq = (unsigned)(row * PITCH * 2 + (((lane & 15) ^ (row & 7)) * 16));
          __builtin_amdgcn_global_load_lds((const unsigned*)((const char*)cur.Q + (size_t)(wid * QBLK) * PITCH * 2 + vq), (LAS unsigned*)(ldsL + OFF_Q + wid * 8192 + i * 1024), 16, 0, 0); } }
    DMA_K(0, 0); DMA_V(0, 0);
    if (NT > 1) { DMA_K(1, 1); DMA_V(1, 1); }
    int kbs[4];
#pragma unroll
    for (int dd = 0; dd < 4; ++dd) kbs[dd] = (int)(uintptr_t)(lds + OFF_K) + KSWZ(r32, (dd * 16 + hi * 8) * 2);
    int qb[4];
#pragma unroll
    for (int dd = 0; dd < 4; ++dd) qb[dd] = kbs[dd] + (OFF_Q - OFF_K) + wid * 8192;
    const int vb0 = (int)(uintptr_t)lds + (((lane >> 2) & 3) + 4 * ((lane >> 4) & 1) + 8 * ((lane >> 5) & 1)) * 64 + ((lane >> 4) & 1) * 32 + (lane & 3) * 8;
    float m_reg = -1e30f, l_reg = 0; f32x4 o[32];
#pragma unroll
    for (int k_ = 0; k_ < 32; ++k_) o[k_] = (f32x4){0.f, 0.f, 0.f, 0.f};
#define RESC(a) do { if (__any((a) < 1.f)) { const int l_ = lane_id();   \
                     if ((l_ >> 5) == 0) al_l[l_ & 31] = (a); asm volatile("s_waitcnt lgkmcnt(0)" ::: "memory");              \
                     const float a0_ = al_l[l_ & 15], a1_ = al_l[16 + (l_ & 15)];                                                \
                     _Pragma("unroll") for (int k_ = 0; k_ < 16; ++k_) { o[k_] *= a0_; o[16 + k_] *= a1_; } } } while (0)
#define KFLIP() { kbs[0] ^= SHM_K; kbs[1] ^= SHM_K; kbs[2] ^= SHM_K; kbs[3] ^= SHM_K; }
    f32x16 p, pn; float al = 1.f; bf16x8 pa0, pa1;
    if (NT > 1) VMC(3); else VMC(0);
    BAR();
    { p = f32x16{}; bf16x8 kf, qf;
#pragma unroll
      for (int d0 = 0; d0 < 8; ++d0) { K_RD(kf, d0); Q_RD(qf, d0); LGK0(); SBAR(); MF(p, kf, qf); } SBAR(); }
    if (NT > 1) { VMC(2); BAR(); }
    int vslot = 0;
    if (NT > 1) {
        if (NT > 2) DMA_K(2, 0);
        KFLIP();
        { const int jt_ = j_lo; fused_step<true, false>(o, vb0, pa0, pa1, kbs, qb, p, pn, m_reg, l_reg, al, jt_ == 7 || jt_ > lastw, jt_ > lastw); }
        p = pn;
        VMC(0); LGK0(); BAR();
        for (int t = 1; t + 1 < NT; ++t) {
            SBAR();
            { const int vn_ = vslot == 0 ? 2 : vslot - 1; if (t + 2 < NT) DMA_K(t + 2, t & 1); DMA_V(t + 1, vn_); }
            KFLIP();
            { const int jt_ = j_lo + t; fused_step<true, true>(o, vb0 + vslot * SHM_V, pa0, pa1, kbs, qb, p, pn, m_reg, l_reg, al, jt_ == 7 || jt_ > lastw, jt_ > lastw); }
            RESC(al);
            p = pn;
            VMC(2); LGK0();
            BAR(); vslot = vslot == 2 ? 0 : vslot + 1;
        }
        { const int jt_ = j_lo + NT - 1; fused_step<false, true>(o, vb0 + vslot * SHM_V, pa0, pa1, kbs, qb, p, pn, m_reg, l_reg, al, jt_ == 7 || jt_ > lastw, jt_ > lastw); }
        RESC(al);
        VMC(0); LGK0(); BAR();
        vslot = vslot == 2 ? 0 : vslot + 1;
    } else {
        { const int jt_ = j_lo; fused_step<false, false>(o, vb0, pa0, pa1, kbs, qb, p, pn, m_reg, l_reg, al, jt_ == 7 || jt_ > lastw, jt_ > lastw); }
    }
    { int vf_b = vb0 + vslot * SHM_V;
#pragma unroll
      for (int g = 0; g < 16; ++g) { s16x4 l_, h_; const int b_ = (g & 7) * 2048, ct_ = g < 8 ? 2 * g : 2 * (g - 8) + 1;
          if (g == 8) vf_b ^= 32;
          asm volatile("ds_read_b64_tr_b16 %0, %1 offset:%2" : "=&v"(l_) : "v"(vf_b), "i"(b_) : "memory"); asm volatile("ds_read_b64_tr_b16 %0, %1 offset:%2" : "=&v"(h_) : "v"(vf_b), "i"(b_ + 1024) : "memory");
          LGK0(); SBAR();
          const bf16x8 vf_ = {l_[0], l_[1], l_[2], l_[3], h_[0], h_[1], h_[2], h_[3]}; o[ct_] = MF16(vf_, pa0, o[ct_]); o[16 + ct_] = MF16(vf_, pa1, o[16 + ct_]); } }
    if (hi == 0) li_l[r32] = l_reg; asm volatile("s_waitcnt lgkmcnt(0)" ::: "memory");
    int l15 = lane & 15; asm volatile("" : "+v"(l15));
    const float rl0 = __builtin_amdgcn_rcpf(li_l[l15]), rl1 = __builtin_amdgcn_rcpf(li_l[16 + l15]);
    f32x4* st4 = (f32x4*)stash + (wid * 64 + lane);
    if (MODE == 0) {
#pragma unroll
        for (int k = 0; k < 32; ++k) st4[k * 512] = o[k] * (k < 16 ? rl0 : rl1);
    } else {
        bf16_t* Ow = Oout + (size_t)((wid * QBLK + l15) * PITCH + 4 * (lane >> 4));
        f32x4 sa[4], sb[4];
#define ST_LD(buf, kg) do { _Pragma("unroll") for (int k_ = 0; k_ < 4; ++k_) buf[k_] = st4[((kg) * 4 + k_) * 512]; } while (0)
#define ST_USE(buf, kg) do { _Pragma("unroll") for (int k_ = 0; k_ < 4; ++k_) { const int k = (kg) * 4 + k_, rt = k >> 4, ct = k & 15;                          \
            const f32x4 v = buf[k_] - o[k] * (lam * (rt ? rl1 : rl0));                                                                                     \
            *(u32x2*)(Ow + (size_t)(16 * rt) * PITCH + 16 * ct) = (u32x2){cvt_pk_bf16(v[0], v[1]), cvt_pk_bf16(v[2], v[3])}; } } while (0)
        ST_LD(sa, 0); SBAR();
        ST_LD(sb, 1); SBAR(); ST_USE(sa, 0); SBAR();
        ST_LD(sa, 2); SBAR(); ST_USE(sb, 1); SBAR();
        ST_LD(sb, 3); SBAR(); ST_USE(sa, 2); SBAR();
        ST_LD(sa, 4); SBAR(); ST_USE(sb, 3); SBAR();
        ST_LD(sb, 5); SBAR(); ST_USE(sa, 4); SBAR();
        ST_LD(sa, 6); SBAR(); ST_USE(sb, 5); SBAR();
        ST_LD(sb, 7); SBAR(); ST_USE(sa, 6); SBAR();
        ST_USE(sb, 7);
#undef ST_LD
#undef ST_USE
    }
    VMC(0); BAR();
#undef RESC
#undef KFLIP
#undef DMA_K
#undef DMA_V
#undef VMC
#undef BAR
}
#undef KRD
#undef LGK0
#undef MF
#undef TRRD
#undef PV_RD
#undef PV_MM
#undef TRRD2
#undef MF16
#undef K_RD
}
constexpr size_t MiB = 1u << 20;
constexpr size_t RB = (size_t)TP * DM * 2;
constexpr size_t WS_CTL = 0, CTL_ZERO_BYTES = 1 * MiB;
constexpr size_t WS_ROPE = 1 * MiB;
constexpr size_t WS_ALOW = 4 * MiB;
constexpr size_t WS_DECAY = 7 * MiB;
constexpr size_t WS_SCORE = 10 * MiB;
constexpr size_t WS_STASH = 28 * MiB;
constexpr size_t WS_W1G = 60 * MiB;
constexpr size_t WS_WGATE = 109 * MiB;
constexpr size_t WS_WBRG = 125 * MiB, WS_WBRD = 133 * MiB, WS_WO = 141 * MiB;
constexpr size_t WS_GV = 150 * MiB;
constexpr size_t WS_GQK = WS_GV + RB;
constexpr size_t WS_DQ = WS_GQK + RB;
constexpr size_t WS_KB = WS_DQ + RB;
constexpr size_t WS_VB = WS_KB + RB;
constexpr size_t WS_OD = WS_VB + RB;
constexpr size_t WS_RB = WS_OD + RB;
constexpr size_t WS_END = WS_RB + RB;
static_assert(WS_END == 1116 * MiB, "ws map");
constexpr size_t WS_WFF1 = WS_STASH, WS_WFF2 = WS_W1G;
constexpr int CW_BAR = 4096;
constexpr int CW_QUEUE = 64;

constexpr int RING_OFF = 0, RING_BYTES = 131072;
constexpr int MISC_OFF = RING_BYTES + 320;
constexpr int LDS_BYTES = 147456;

#define RLX_AGENT __ATOMIC_RELAXED, __HIP_MEMORY_SCOPE_AGENT
#define LDS_WAIT() asm volatile("s_waitcnt lgkmcnt(0)" ::: "memory")
#define VM_WAIT() asm volatile("s_waitcnt vmcnt(0)" ::: "memory")

#define XB_TMO      128
#define XB_XCNT(j)  (256  + 64 * (j))
#define XB_XSUB(j)  (1280 + 64 * (j))
#define XB_XGEN(j)  (2304 + 64 * (j))
#define XB_TOP      3328
#define XB_TOPGEN   3392
#define XCD_BAR_WORDS 3456
#define XB_SPIN_CAP (1u << 22)
__device__ __forceinline__ unsigned xb_ld(unsigned* p)              { return __hip_atomic_load(p, __ATOMIC_RELAXED, __HIP_MEMORY_SCOPE_AGENT); }
__device__ __forceinline__ unsigned xb_add(unsigned* p, unsigned v) { return __hip_atomic_fetch_add(p, v, __ATOMIC_RELAXED, __HIP_MEMORY_SCOPE_AGENT); }
__device__ __forceinline__ unsigned xb_xcc_id() { return (unsigned)__builtin_amdgcn_s_getreg((3 << 11) | 20) & 0xFu; }
#define XB_SPIN(cond, bar) do { unsigned _sp = 0; while (cond) { __builtin_amdgcn_s_sleep(1); \
    if ((++_sp & 255u) == 0u) { if (xb_ld(&(bar)[XB_TMO])) break; if (_sp > XB_SPIN_CAP) { atomicAdd(&(bar)[XB_TMO], 1u); break; } } } } while (0)
struct XcdBarrier { unsigned* bar; unsigned x; volatile LAS unsigned* st; int wave; };
__device__ __forceinline__ XcdBarrier xcd_barrier_post(unsigned* bar, volatile LAS unsigned* st, int wave) {
    XcdBarrier b; b.bar = bar; b.x = xb_xcc_id(); b.st = st; b.wave = wave;
    if (wave == 0 && lane_id() == 0) (void)xb_add(&bar[XB_XCNT(b.x)], 1u);
    return b;
}
__device__ __forceinline__ void xcd_barrier_complete(unsigned* bar, unsigned x, unsigned& nloc, unsigned& nx) {
    const unsigned G = gridDim.x * gridDim.y * gridDim.z;
    unsigned sum, cnt, mine, sp = 0u;
    for (;;) {
        sum = 0u; cnt = 0u; mine = 0u;
#pragma unroll
        for (unsigned j = 0; j < 16; ++j) { const unsigned c = xb_ld(&bar[XB_XCNT(j)]); sum += c; cnt += (c > 0u) ? 1u : 0u; mine = (j == x) ? c : mine; }
        if (sum == G) break;
        __builtin_amdgcn_s_sleep(1);
        if ((++sp & 255u) == 0u) { if (xb_ld(&bar[XB_TMO])) break; if (sp > XB_SPIN_CAP) { atomicAdd(&bar[XB_TMO], 1u); break; } }
    }
    nloc = mine > 0u ? mine : 1u; nx = cnt > 0u ? cnt : 1u;
}
__device__ __forceinline__ void xcd_barrier(const XcdBarrier& b) {
    asm volatile("s_waitcnt vmcnt(0)" ::: "memory");
    __syncthreads();
    if (b.wave == 0 && lane_id() == 0) {
        unsigned* bar = b.bar;
        __builtin_amdgcn_s_waitcnt(0);
        unsigned nloc = b.st[0], nx = b.st[1];
        if (nloc == 0u) { xcd_barrier_complete(bar, b.x, nloc, nx); b.st[0] = nloc; b.st[1] = nx; }
        const unsigned old = xb_add(&bar[XB_XSUB(b.x)], 1u);
        const unsigned gen = old / nloc;
        if (old + 1u == (gen + 1u) * nloc) {
            __builtin_amdgcn_fence(__ATOMIC_RELEASE, "agent");
            asm volatile("s_waitcnt vmcnt(0)" ::: "memory");
            const unsigned og = xb_add(&bar[XB_TOP], 1u);
            const unsigned tg = og / nx;
            if (og + 1u == (tg + 1u) * nx) xb_add(&bar[XB_TOPGEN], 1u);
            else XB_SPIN(xb_ld(&bar[XB_TOPGEN]) == tg, bar);
            __builtin_amdgcn_fence(__ATOMIC_ACQUIRE, "agent");
            xb_add(&bar[XB_XGEN(b.x)], 1u);
            asm volatile("s_waitcnt vmcnt(0)" ::: "memory");
        } else {
            XB_SPIN(xb_ld(&bar[XB_XGEN(b.x)]) == gen, bar);
            __builtin_amdgcn_fence(__ATOMIC_ACQUIRE, "agent");
            asm volatile("s_waitcnt vmcnt(0)" ::: "memory");
        }
    }
    __syncthreads();
}

struct Args { const float* in[24]; float* out; unsigned char* ws; int ph_lo, ph_hi; };
struct Frame {
    LAS unsigned char* lds; volatile LAS unsigned* MISC;
    int wave, G, gw, NGW;
};
typedef const float* cfp_t;
__device__ __forceinline__ const float* inp(int i) { const __attribute__((address_space(4))) cfp_t* t = (const __attribute__((address_space(4))) cfp_t*)__builtin_amdgcn_kernarg_segment_ptr(); asm volatile("" : "+s"(t)); return t[i]; }
__device__ __forceinline__ float* outp() { const __attribute__((address_space(4))) char* t = (const __attribute__((address_space(4))) char*)__builtin_amdgcn_kernarg_segment_ptr(); asm volatile("" : "+s"(t)); return *(float* const __attribute__((address_space(4)))*)(t + 192); }
__device__ __forceinline__ unsigned char* wsp() { const __attribute__((address_space(4))) char* t = (const __attribute__((address_space(4))) char*)__builtin_amdgcn_kernarg_segment_ptr(); asm volatile("" : "+s"(t)); return *(unsigned char* const __attribute__((address_space(4)))*)(t + 200); }
#define TID (F.wave * 64 + lane_id())
#define LANE (lane_id())
__device__ __forceinline__ float wave_sum(float v) {
#pragma unroll
    for (int o = 1; o < 64; o <<= 1) v += __shfl_xor(v, o);
    return v;
}
__device__ __forceinline__ int row_pos(int row) {
    if (row >= SR0) return PAST + ((row - SR0) & 63);
    const int ri = row % BS; return ri >= PADR ? ri - PADR : 0;
}
__device__ __forceinline__ long row_kv(int row, bool& sample) {
    if (row >= SR0) { sample = true; return row - SR0; }
    sample = false; const int b = row / BS, ri = row - b * BS; return ri >= PADR ? (long)b * LP + (ri - PADR) : -1;
}
__device__ __forceinline__ const float* row_x(const Frame& F, int row, float*& y) {
    if (row >= SR0) { y = outp() + O_YS + (size_t)(row - SR0) * DM; return inp(1) + (size_t)(row - SR0) * DM; }
    const int b = row / BS, ri = row - b * BS;
    if (ri >= 256) { y = outp() + O_YP + ((size_t)b * SEQ + (ri - 256)) * DM; return inp(0) + ((size_t)b * SEQ + (ri - 256)) * DM; }
    y = nullptr; if (ri >= PADR) return inp(5) + (size_t)(ri - PADR) * DM; return nullptr;
}

__device__ __forceinline__ void transpose_item(const float* W, int ldw, int K, int c0, int ncv, int k0, bf16_t* WT, int n0, LAS float* scr, int lane) {
    const int n4 = 4 * (lane & 7);
#pragma unroll
    for (int i = 0; i < 8; ++i) { const int kk = (lane >> 3) + 8 * i;
        const f32x4 v = n4 < ncv ? *(const f32x4*)(W + (size_t)(k0 + kk) * ldw + c0 + n4) : (f32x4){0.f, 0.f, 0.f, 0.f};
        LAS float* d = scr + kk * 33 + n4; d[0] = v[0]; d[1] = v[1]; d[2] = v[2]; d[3] = v[3]; }
    LDS_WAIT(); asm volatile("" ::: "memory");
    const int c = lane & 7;
#pragma unroll
    for (int j = 0; j < 4; ++j) { const int n = (lane >> 3) + 8 * j; const LAS float* s = scr + (8 * c) * 33 + n;
        u32x4 o; o.x = cvt_pk_bf16(s[0 * 33], s[1 * 33]); o.y = cvt_pk_bf16(s[2 * 33], s[3 * 33]); o.z = cvt_pk_bf16(s[4 * 33], s[5 * 33]); o.w = cvt_pk_bf16(s[6 * 33], s[7 * 33]);
        *(GAS u32x4*)((GAS char*)WT + pg8::b_img_off(n0 + n, k0 + 8 * c, K)) = o; }
    LDS_WAIT(); asm volatile("" ::: "memory");
}
__device__ __forceinline__ int w1_src_col(int n) {
    if (n < 4096) return n;
    if (n < 10240) return n + 2064;
    if (n < 12288) return n - 6128;
    if (n < 12304) return n - 8192;
    return -1;
}
__device__ __forceinline__ void rms_row_to_bf16(const float* xrow, const float* g, bf16_t* obase, int m, int lane) {
#define O8(j) (*(GAS unsigned long long*)((GAS char*)obase + pg8::a_img_off(m, 256 * (j) + 4 * lane, DM)))
    if (!xrow) {
#pragma unroll
        for (int j = 0; j < 8; ++j) O8(j) = 0ull;
        return; }
    const GAS f32x4* xr = (const GAS f32x4*)xrow + lane; const GAS f32x4* gr = (const GAS f32x4*)g + lane;
    f32x4 v[8]; float s = 0.f;
#pragma unroll
    for (int j = 0; j < 8; ++j) { v[j] = xr[64 * j]; s += (v[j].x * v[j].x + v[j].y * v[j].y) + (v[j].z * v[j].z + v[j].w * v[j].w); }
    const float rs = 1.0f / sqrtf(wave_sum(s) * (1.f / DM) + EPS);
#pragma unroll
    for (int j = 0; j < 8; ++j) { const f32x4 gg = gr[64 * j];
        O8(j) = (unsigned long long)cvt_pk_bf16(v[j].x * rs * gg.x, v[j].y * rs * gg.y) | ((unsigned long long)cvt_pk_bf16(v[j].z * rs * gg.z, v[j].w * rs * gg.w) << 32); }
#undef O8
}
constexpr int CV_WG = 32 * 128, CV_SQ = 32 * 64, CV_F1 = 32 * 256, CV_F2 = 128 * 64, CV_TOTAL = CV_WG + 3 * CV_SQ + CV_F1 + CV_F2;
static_assert(CV_TOTAL % 32 == 0, "conv items");
__device__ __forceinline__ void conv_item(Frame& F, int r, LAS float* scr) {
    const float* W; int ldw, K, c0, k0, n0; size_t wt;
    if (r < CV_WG) { const int kb = r / 128, nb = r % 128; W = inp(7); ldw = 16400; K = DM; c0 = 12304 + nb * 32; k0 = kb * 64; wt = WS_WGATE; n0 = nb * 32; }
    else if (r < CV_WG + 3 * CV_SQ) { r -= CV_WG; const int which = r / CV_SQ; r -= which * CV_SQ; const int kb = r / 64, nb = r % 64;
        W = which == 0 ? inp(16) : (which == 1 ? inp(17) : inp(18)); ldw = DM; K = DM; c0 = nb * 32; k0 = kb * 64; wt = which == 0 ? WS_WBRG : (which == 1 ? WS_WBRD : WS_WO); n0 = nb * 32; }
    else if (r < CV_WG + 3 * CV_SQ + CV_F1) { r -= CV_WG + 3 * CV_SQ; const int kb = r / 256, nb = r % 256; W = inp(21); ldw = DFF; K = DM; c0 = nb * 32; k0 = kb * 64; wt = WS_WFF1; n0 = nb * 32; }
    else { r -= CV_WG + 3 * CV_SQ + CV_F1; const int kb = r / 64, nb = r % 64; W = inp(22); ldw = DM; K = DFF; c0 = nb * 32; k0 = kb * 64; wt = WS_WFF2; n0 = nb * 32; }
    transpose_item(W, ldw, K, c0, 32, k0, (bf16_t*)(wsp() + wt), n0, scr, LANE);
}
__device__ __forceinline__ void p0_prologue(Frame& F) {
    LAS float* scr = (LAS float*)(F.lds + RING_OFF + F.wave * 16384);
    const float* w_in = inp(7);
    constexpr int I_W1 = 32 * (N1 / 32);
    for (int it = F.gw; it < I_W1; it += F.NGW) {
        const int kb = it / (N1 / 32), nb = it % (N1 / 32), n0 = nb * 32; const int sc = w1_src_col(n0);
        const int ncv = sc < 0 ? 0 : (n0 == 12288 ? 16 : 32);
        transpose_item(w_in, 16400, DM, sc < 0 ? 0 : sc, ncv, kb * 64, (bf16_t*)(wsp() + WS_W1G), n0, scr, LANE); }
    { float2* tab = (float2*)(wsp() + WS_ROPE);
      for (int i = blockIdx.x * 512 + TID; i < LP * 16; i += F.G * 512) { const int pos = i >> 4, k = i & 15;
          const float invf = powf(500000.0f, -(float)(2 * k) / 32.0f); const float ang = (float)pos * invf; float sn, cs; sincosf(ang, &sn, &cs); tab[i] = make_float2(cs, sn); } }
    { bf16_t* U = (bf16_t*)(outp() + O_YP);
      for (int m = F.gw; m < TP; m += F.NGW) { float* y; const float* x = row_x(F, m, y); rms_row_to_bf16(x, inp(6), U, m, LANE); } }
}

struct EpiP1 {
    static constexpr bool PERM = true;
    unsigned char* ws; float* out;
    __device__ __forceinline__ bool operator()(f32x4 (&acc)[2][2][4][2], const pg8::Unit& u, int wr, int wc, int fr, int fq) const {
        const int pn = u.pn; const int row0 = u.pm * 256 + wr * 64 + fr;
        if (pn == 48) {
            if (wc == 0 && fq < 2) { float* A = (float*)(ws + WS_ALOW);
#pragma unroll
                for (int ai = 0; ai < 2; ++ai)
#pragma unroll
                    for (int m = 0; m < 4; ++m) { float* ap = A + (size_t)(row0 + ai * 128 + m * 16) * 16 + 8 * fq; *(f32x4*)ap = acc[ai][0][m][0]; *(f32x4*)(ap + 4) = acc[ai][0][m][1]; } }
            return false; }
        if (pn < 8) {
            const float sc = pn < 4 ? 0.0625f : 1.0f; bf16_t* base = (bf16_t*)(ws + WS_GQK) + (pn < 4 ? (size_t)0 : (size_t)TP * 1024); const int h = pn & 3;
#pragma unroll
            for (int ai = 0; ai < 2; ++ai)
#pragma unroll
                for (int m = 0; m < 4; ++m) { const int row = row0 + ai * 128 + m * 16; bf16_t* rp = base + ((size_t)((row >> 6) * 4 + h) * 64 + (row & 63)) * 256 + wc * 32 + 8 * fq;
#pragma unroll
                    for (int bj = 0; bj < 2; ++bj) { const f32x4 v0 = acc[ai][bj][m][0] * sc, v1 = acc[ai][bj][m][1] * sc;
                        *(u32x4*)(rp + bj * 128) = (u32x4){cvt_pk_bf16(v0[0], v0[1]), cvt_pk_bf16(v0[2], v0[3]), cvt_pk_bf16(v1[0], v1[1]), cvt_pk_bf16(v1[2], v1[3])}; } }
            return false; }
        const bool rope = (pn >= 16 && pn < 32) && wc == 0;
        const bool f32o = (pn >= 24 && pn < 40);
        bf16_t* base; int c0; size_t rpitch = DM, bjs = 128;
        if (pn < 16) { base = (bf16_t*)(ws + WS_GV); c0 = (pn - 8) * 256; }
        else if (pn < 24) { base = (bf16_t*)(ws + WS_DQ); c0 = (pn - 16) * 256; }
        else if (pn < 32) { base = (bf16_t*)(ws + WS_KB) + (size_t)(pn - 24) * 2 * TP * 128; c0 = (pn - 24) * 256; rpitch = 128; bjs = (size_t)TP * 128; }
        else if (pn < 40) { base = (bf16_t*)(ws + WS_VB) + (size_t)(pn - 32) * TP * 256; c0 = (pn - 32) * 256; rpitch = 256; }
        else { base = (bf16_t*)(ws + WS_RB); c0 = (pn - 40) * 256; }
        const bool silu = pn >= 40;
        const float2* tab = (const float2*)(ws + WS_ROPE);
        const bool up = fq >= 2;
#pragma unroll
        for (int ai = 0; ai < 2; ++ai)
#pragma unroll
            for (int m = 0; m < 4; ++m) { const int row = row0 + ai * 128 + m * 16;
                f32x4 v[2][2];
#pragma unroll
                for (int bj = 0; bj < 2; ++bj) { v[bj][0] = acc[ai][bj][m][0]; v[bj][1] = acc[ai][bj][m][1]; }
                if (rope) { const int pos = row_pos(row); const f32x4* tp = (const f32x4*)(tab + (size_t)pos * 16 + 8 * (fq & 1));
                    const f32x4 t0 = tp[0], t1 = tp[1], t2 = tp[2], t3 = tp[3];
                    const f32x4 cs[2] = {(f32x4){t0[0], t0[2], t1[0], t1[2]}, (f32x4){t2[0], t2[2], t3[0], t3[2]}}, sn[2] = {(f32x4){t0[1], t0[3], t1[1], t1[3]}, (f32x4){t2[1], t2[3], t3[1], t3[3]}};
#pragma unroll
                    for (int bj = 0; bj < 2; ++bj)
#pragma unroll
                        for (int n = 0; n < 2; ++n) { f32x4 o;
#pragma unroll
                            for (int j = 0; j < 4; ++j) { const float own = v[bj][n][j];
                                auto rr = __builtin_amdgcn_permlane32_swap(__float_as_uint(own), __float_as_uint(own), false, false);
                                const float oth = __uint_as_float(up ? rr[0] : rr[1]);
                                o[j] = own * cs[n][j] + (up ? oth : -oth) * sn[n][j]; }
                            v[bj][n] = o; } }
                if (silu) {
#pragma unroll
                    for (int bj = 0; bj < 2; ++bj)
#pragma unroll
                        for (int n = 0; n < 2; ++n)
#pragma unroll
                            for (int j = 0; j < 4; ++j) { const float x = v[bj][n][j]; v[bj][n][j] = x * sigmoidf_(x); } }
                bf16_t* rp = base + (size_t)row * rpitch + ((pn >= 24 && pn < 40) ? 0 : c0) + wc * 32 + 8 * fq;
                const bool vimg = pn >= 32 && pn < 40;
                if (pn >= 24 && pn < 32) rp = base + (size_t)row * rpitch + 8 * ((wc * 4 + fq) ^ (row & 7));
                bf16_t* vt = base + (size_t)(row >> 5) * 8192;
#pragma unroll
                for (int bj = 0; bj < 2; ++bj)
                    *(u32x4*)(vimg ? vt + (v_img_off(row & 31, bj * 128 + wc * 32 + 8 * fq) >> 1) : rp + bj * bjs) = (u32x4){cvt_pk_bf16(v[bj][0][0], v[bj][0][1]), cvt_pk_bf16(v[bj][0][2], v[bj][0][3]), cvt_pk_bf16(v[bj][1][0], v[bj][1][1]), cvt_pk_bf16(v[bj][1][2], v[bj][1][3])};
                if (f32o) { bool smp; const long kr = row_kv(row, smp);
                    if (kr >= 0) { float* op = out + (pn < 32 ? (smp ? O_KS : O_KP) : (smp ? O_VS : O_VP)) + (size_t)kr * DM + c0 + wc * 32 + 8 * fq;
#pragma unroll
                        for (int bj = 0; bj < 2; ++bj) { *(f32x4*)(op + bj * 128) = v[bj][0]; *(f32x4*)(op + bj * 128 + 4) = v[bj][1]; } } }
            }
        return false;
    }
};

__device__ __forceinline__ float logsigmoid_(float x) { const float e = __expf(-fabsf(x)); return fminf(x, 0.f) - __logf(1.0f + e); }
__device__ __forceinline__ int qperm32(int c32) { return 8 * ((c32 >> 2) & 3) + 4 * (c32 >> 4) + (c32 & 3); }
constexpr int P2_ALOW = 0, P2_TOT = 4096, P2_QS = 8192, P2_PITCH = 528, P2_KS = P2_QS + 64 * P2_PITCH;
__device__ __forceinline__ void p2_unit(Frame& F, int g, int h) {
    LAS unsigned char* L = F.lds + RING_OFF;
    LAS float* alow_s = (LAS float*)(L + P2_ALOW); LAS float* tot = (LAS float*)(L + P2_TOT);
    const int row0 = g * 64, tid = TID, c = tid & 255, hf = tid >> 8, ch = h * 256 + c;
    const int padn = (row0 < SR0 && (row0 % BS) == 192) ? 48 : 0;
    bf16_t* qimg = (bf16_t*)(wsp() + WS_GQK) + (size_t)(g * 4 + h) * 16384; bf16_t* kimg = qimg + (size_t)TP * 1024;
    if (tid < 256) *(LAS f32x4*)(alow_s + tid * 4) = *(const f32x4*)((const float*)(wsp() + WS_ALOW) + (size_t)row0 * 16 + tid * 4);
#pragma unroll
    for (int j = 0; j < 4; ++j) { const int q = tid + 512 * j;
        *(LAS u32x4*)(L + P2_QS + (q >> 5) * P2_PITCH + (q & 31) * 16) = *(const u32x4*)(qimg + (size_t)q * 8);
        *(LAS u32x4*)(L + P2_KS + (q >> 5) * P2_PITCH + (q & 31) * 16) = *(const u32x4*)(kimg + (size_t)q * 8); }
    float wa[16];
#pragma unroll
    for (int j = 0; j < 16; ++j) wa[j] = inp(8)[j * 1024 + ch];
    const float ba = inp(9)[ch];
    __syncthreads();
    float b[32]; float run = 0.f;
#pragma unroll
    for (int i = 0; i < 32; ++i) { const int t = 32 * hf + i; float x = ba;
#pragma unroll
        for (int j4 = 0; j4 < 4; ++j4) { const f32x4 av = *(const LAS f32x4*)(alow_s + t * 16 + 4 * j4); x = fmaf(av[0], wa[4 * j4], x); x = fmaf(av[1], wa[4 * j4 + 1], x); x = fmaf(av[2], wa[4 * j4 + 2], x); x = fmaf(av[3], wa[4 * j4 + 3], x); }
        const float la = t < padn ? 0.f : logsigmoid_(x) * 0.0625f; run += la; b[i] = run; }
    tot[hf * 256 + c] = run;
    __syncthreads();
    const float bmid = tot[c], blast = tot[c] + tot[256 + c];
    if (hf == 1) {
#pragma unroll
        for (int i = 0; i < 32; ++i) b[i] += bmid; }
    if (hf == 0) ((float*)(wsp() + WS_DECAY))[(size_t)g * 1024 + ch] = __expf(blast);
    LAS bf16_t* QS = (LAS bf16_t*)(L + P2_QS); LAS bf16_t* KS = (LAS bf16_t*)(L + P2_KS);
    const int cs = (c & ~31) + qperm32(c & 31);
    unsigned kd[16];
    const float ebm = __expf(bmid), elb = __expf(blast - bmid);
#pragma unroll
    for (int i = 0; i < 32; i += 2) {
        float kdv[2], qh[2], qsv[2], ksv[2];
#pragma unroll
        for (int e = 0; e < 2; ++e) { const int t = 32 * hf + i + e; const float q = bf2f(QS[t * (P2_PITCH / 2) + c]), k = bf2f(KS[t * (P2_PITCH / 2) + c]);
            const float e1 = __expf(b[i + e] - bmid), r1 = __builtin_amdgcn_rcpf(e1);
            qsv[e] = q * e1; ksv[e] = k * r1; qh[e] = qsv[e] * ebm; kdv[e] = ksv[e] * elb; }
        const unsigned wq = cvt_pk_bf16(qh[0], qh[1]), ws_ = cvt_pk_bf16(qsv[0], qsv[1]), wk = cvt_pk_bf16(ksv[0], ksv[1]);
        const int t0 = 32 * hf + i;
        qimg[t0 * 256 + cs] = (bf16_t)(wq & 0xffffu); qimg[(t0 + 1) * 256 + cs] = (bf16_t)(wq >> 16);
        QS[t0 * (P2_PITCH / 2) + c] = (bf16_t)(ws_ & 0xffffu); QS[(t0 + 1) * (P2_PITCH / 2) + c] = (bf16_t)(ws_ >> 16);
        KS[t0 * (P2_PITCH / 2) + c] = (bf16_t)(wk & 0xffffu); KS[(t0 + 1) * (P2_PITCH / 2) + c] = (bf16_t)(wk >> 16);
        kd[i >> 1] = cvt_pk_bf16(kdv[0], kdv[1]); }
    { u32x4* dst = (u32x4*)(kimg + (size_t)c * 64 + 32 * hf);
#pragma unroll
      for (int j = 0; j < 4; ++j) dst[j] = (u32x4){kd[4 * j], kd[4 * j + 1], kd[4 * j + 2], kd[4 * j + 3]}; }
    __syncthreads();
    { const int w = F.wave, fr = LANE & 15, fq = LANE >> 4, mt = w >> 1;
      f32x4 a2[2] = {(f32x4){0.f, 0.f, 0.f, 0.f}, (f32x4){0.f, 0.f, 0.f, 0.f}};
#pragma unroll
      for (int ks = 0; ks < 8; ++ks) { const bf16x8 qf = *(const LAS bf16x8*)(L + P2_QS + (16 * mt + fr) * P2_PITCH + (32 * ks + 8 * fq) * 2);
#pragma unroll
          for (int e = 0; e < 2; ++e) { const int nt = (w & 1) * 2 + e; const bf16x8 kf = *(const LAS bf16x8*)(L + P2_KS + (16 * nt + fr) * P2_PITCH + (32 * ks + 8 * fq) * 2);
              a2[e] = __builtin_amdgcn_mfma_f32_16x16x32_bf16(kf, qf, a2[e], 0, 0, 0); } }
      bf16_t* sc = (bf16_t*)(wsp() + WS_SCORE) + (size_t)(g * 4 + h) * 4096; const int t = 16 * mt + fr;
#pragma unroll
      for (int e = 0; e < 2; ++e) { const int s0 = ((w & 1) * 2 + e) * 16 + 4 * fq; float v[4];
#pragma unroll
          for (int i = 0; i < 4; ++i) v[i] = (s0 + i <= t) ? a2[e][i] : 0.f;
          *(u32x2*)(sc + t * 64 + s0) = (u32x2){cvt_pk_bf16(v[0], v[1]), cvt_pk_bf16(v[2], v[3])}; } }
    __syncthreads();
}
constexpr int SC_QH = 0, SC_QP = 528, SC_KD = SC_QH + 64 * SC_QP, SC_KP = 144, SC_VT = SC_KD + 256 * SC_KP, SC_SC = SC_VT + 64 * 144, SC_DC = SC_SC + 64 * 144, SC_PO = SC_DC + 1024, SC_END = SC_PO + 2 * 64 * 64 * 4;
static_assert(SC_END <= RING_BYTES, "scan LDS");
struct ScanRegs { u32x4 q[4], k[4], v, s; float d; };
__device__ __forceinline__ void scan_load(Frame& F, int g, int h, int vs, ScanRegs& R) {
    const int tid = TID;
    const bf16_t* qimg = (const bf16_t*)(wsp() + WS_GQK) + (size_t)(g * 4 + h) * 16384; const bf16_t* kimg = qimg + (size_t)TP * 1024;
#pragma unroll
    for (int j = 0; j < 4; ++j) { R.q[j] = *(const u32x4*)(qimg + (size_t)(tid + 512 * j) * 8); R.k[j] = *(const u32x4*)(kimg + (size_t)(tid + 512 * j) * 8); }
    R.v = *(const u32x4*)((const bf16_t*)(wsp() + WS_GV) + (size_t)(g * 64 + (tid >> 3)) * DM + h * 512 + vs * 64 + 8 * (tid & 7));
    R.s = *(const u32x4*)((const bf16_t*)(wsp() + WS_SCORE) + (size_t)(g * 4 + h) * 4096 + tid * 8);
    R.d = ((const float*)(wsp() + WS_DECAY))[(size_t)g * 1024 + h * 256 + (tid & 255)];
}
__device__ __forceinline__ void scan_stage(Frame& F, const ScanRegs& R) {
    LAS unsigned char* L = F.lds + RING_OFF; const int tid = TID;
#pragma unroll
    for (int j = 0; j < 4; ++j) { const int q = tid + 512 * j;
        *(LAS u32x4*)(L + SC_QH + (q >> 5) * SC_QP + (q & 31) * 16) = R.q[j];
        *(LAS u32x4*)(L + SC_KD + (q >> 3) * SC_KP + (q & 7) * 16) = R.k[j]; }
    { const int s = tid >> 3, v0 = 8 * (tid & 7); LAS bf16_t* vt = (LAS bf16_t*)(L + SC_VT);
#pragma unroll
      for (int j = 0; j < 4; ++j) { const unsigned w = R.v[j]; vt[(v0 + 2 * j) * 72 + s] = (bf16_t)(w & 0xffffu); vt[(v0 + 2 * j + 1) * 72 + s] = (bf16_t)(w >> 16); } }
    *(LAS u32x4*)(L + SC_SC + (tid >> 3) * 144 + (tid & 7) * 16) = R.s;
    if (tid < 256) ((LAS float*)(L + SC_DC))[tid] = R.d;
}
__device__ __forceinline__ void scan_unit(Frame& F, int seq, int h, int vs) {
    LAS unsigned char* L = F.lds + RING_OFF;
    int lane = LANE; asm volatile("" : "+v"(lane));
    const int w = F.wave, tid = w * 64 + lane, fr = lane & 15, fq = lane >> 4, vg = w & 3, chf = w >> 2;
    const bool smp = seq >= 2; const int s_i = seq - 2;
    const int g0 = smp ? 520 + s_i : 260 * seq + 3, ng = smp ? 1 : 257;
    const size_t st_off = smp ? O_SS + (size_t)(s_i * 4 + h) * 131072 : O_SP + (size_t)(seq * 4 + h) * 131072;
    const int vcol = vs * 64 + 16 * vg + fr;
    f32x4 Sa[8];
#pragma unroll
    for (int mt = 0; mt < 8; ++mt) {
        if (smp) { const float* sp = inp(4) + (size_t)(s_i * 4 + h) * 131072 + (size_t)(128 * chf + 16 * mt + 4 * fq) * 512 + vcol;
            Sa[mt] = (f32x4){sp[0], sp[512], sp[1024], sp[1536]}; }
        else Sa[mt] = (f32x4){0.f, 0.f, 0.f, 0.f}; }
    ScanRegs R; scan_load(F, g0, h, vs, R);
    for (int gi = 0; gi < ng; ++gi) {
        const int g = g0 + gi;
        scan_stage(F, R);
        __syncthreads();
        if (gi + 1 < ng) scan_load(F, g + 1, h, vs, R);
        f32x4 po[4];
#pragma unroll
        for (int mt = 0; mt < 4; ++mt) po[mt] = (f32x4){0.f, 0.f, 0.f, 0.f};
#pragma unroll
        for (int ks = 0; ks < 4; ++ks) {
            u32x4 bw = {cvt_pk_bf16(Sa[2 * ks][0], Sa[2 * ks][1]), cvt_pk_bf16(Sa[2 * ks][2], Sa[2 * ks][3]), cvt_pk_bf16(Sa[2 * ks + 1][0], Sa[2 * ks + 1][1]), cvt_pk_bf16(Sa[2 * ks + 1][2], Sa[2 * ks + 1][3])};
            const bf16x8 bfrag = __builtin_bit_cast(bf16x8, bw);
#pragma unroll
            for (int mt = 0; mt < 4; ++mt) { const bf16x8 af = *(const LAS bf16x8*)(L + SC_QH + (16 * mt + fr) * SC_QP + (128 * chf + 32 * ks + 8 * fq) * 2);
                po[mt] = __builtin_amdgcn_mfma_f32_16x16x32_bf16(af, bfrag, po[mt], 0, 0, 0); } }
        { const bf16x8 vf = *(const LAS bf16x8*)(L + SC_VT + (16 * vg + fr) * 144 + (32 * chf + 8 * fq) * 2);
#pragma unroll
          for (int mt = 0; mt < 4; ++mt) { const bf16x8 sf = *(const LAS bf16x8*)(L + SC_SC + (16 * mt + fr) * 144 + (32 * chf + 8 * fq) * 2);
              po[mt] = __builtin_amdgcn_mfma_f32_16x16x32_bf16(sf, vf, po[mt], 0, 0, 0); } }
        { LAS float* PO = (LAS float*)(L + SC_PO) + chf * 4096;
#pragma unroll
          for (int mt = 0; mt < 4; ++mt)
#pragma unroll
              for (int i = 0; i < 4; ++i) PO[(16 * mt + 4 * fq + i) * 64 + 16 * vg + fr] = po[mt][i]; }
        { bf16x8 vf[2];
#pragma unroll
          for (int ks = 0; ks < 2; ++ks) vf[ks] = *(const LAS bf16x8*)(L + SC_VT + (16 * vg + fr) * 144 + (32 * ks + 8 * fq) * 2);
#pragma unroll
          for (int mt = 0; mt < 8; ++mt) { const f32x4 dc = *(const LAS f32x4*)(L + SC_DC + (128 * chf + 16 * mt + 4 * fq) * 4); Sa[mt] = Sa[mt] * dc;
#pragma unroll
              for (int ks = 0; ks < 2; ++ks) { const bf16x8 kf = *(const LAS bf16x8*)(L + SC_KD + (128 * chf + 16 * mt + fr) * SC_KP + (32 * ks + 8 * fq) * 2);
                  Sa[mt] = __builtin_amdgcn_mfma_f32_16x16x32_bf16(kf, vf[ks], Sa[mt], 0, 0, 0); } } }
        __syncthreads();
        { const int t = tid >> 3, vc = 8 * (tid & 7); const LAS float* P0 = (const LAS float*)(L + SC_PO) + t * 64 + vc; const LAS float* P1 = P0 + 4096;
          const f32x4 a0 = *(const LAS f32x4*)P0, a1 = *(const LAS f32x4*)(P0 + 4), b0 = *(const LAS f32x4*)P1, b1 = *(const LAS f32x4*)(P1 + 4);
          const f32x4 s0 = a0 + b0, s1 = a1 + b1;
          *(u32x4*)((bf16_t*)(wsp() + WS_GV) + (size_t)(g * 64 + t) * DM + h * 512 + vs * 64 + vc) = (u32x4){cvt_pk_bf16(s0[0], s0[1]), cvt_pk_bf16(s0[2], s0[3]), cvt_pk_bf16(s1[0], s1[1]), cvt_pk_bf16(s1[2], s1[3])}; }
        __syncthreads();
    }
#pragma unroll
    for (int mt = 0; mt < 8; ++mt) { float* sp = outp() + st_off + (size_t)(128 * chf + 16 * mt + 4 * fq) * 512 + vcol;
#pragma unroll
        for (int i = 0; i < 4; ++i) sp[(size_t)i * 512] = Sa[mt][i]; }
}
__device__ __forceinline__ float diff_lambda(const Frame& F) {
    float s1 = 0.f, s2 = 0.f;
    for (int i = 0; i < 128; ++i) { s1 = fmaf(inp(11)[i], inp(12)[i], s1); s2 = fmaf(inp(13)[i], inp(14)[i], s2); }
    return expf(s1) - expf(s2) + 0.2f;
}
__device__ __forceinline__ void attn_item(Frame& F, int b, int h, int I, float lam) {
    const bf16_t* Dq = (const bf16_t*)(wsp() + WS_DQ); const bf16_t* Kb = (const bf16_t*)(wsp() + WS_KB); const bf16_t* Vb = (const bf16_t*)(wsp() + WS_VB);
    const size_t brow = (size_t)b * BS;
    att8::PassRef r0;
    r0.Q = Dq + (brow + (size_t)I * 256) * DM + h * 256; r0.K = Kb + ((size_t)(h * 2) * TP + brow) * 128; r0.V = Vb + ((size_t)h * TP + brow) * 256;
    r0.jlo = 7; r0.jhi = 8 * I + 8; r0.lastbase = I == 0 ? 7 : 8 * I + 1; r0.first = I == 0;
    float* stash = outp() + O_YP + (size_t)36700160 + (size_t)blockIdx.x * 65536;
    bf16_t* Oo = (bf16_t*)(wsp() + WS_OD) + (brow + (size_t)I * 256) * DM + h * 256;
    for (int map = 0; map < 2; ++map) {
        att8::attn_pass(map, r0, F.lds + RING_OFF, stash, Oo, lam, F.wave);
        r0.Q += 128; r0.K += (size_t)TP * 128; }
}
__device__ __forceinline__ void attn_sample_item(Frame& F, int b, int h, float lam) {
    using namespace att;
    char* lds = (char*)(F.lds + RING_OFF);
    int lane = LANE; asm volatile("" : "+v"(lane));
    const int wid = F.wave, tid = wid * 64 + lane, r32 = lane & 31, hi = lane >> 5;
    const int map = wid & 1, rh = (wid >> 1) & 1, vhf = wid >> 2;
    char* V_lds = lds; char* K_lds = lds + 2 * SHM_V;
    float* wsl = (float*)(lds + 2 * SHM_V + 2 * SHM_K) + wid * 64; float* li_l = wsl, * al_l = wsl + 32;
    const int sr = tid >> 4, sc = (tid & 15) * 8, vst0 = v_st(sr, sc), vst1 = v_st(32 + sr, sc), kws = KSWZ(sr, sc * 2);
    const int vb0 = (int)(uintptr_t)V_lds + vhf * SHM_V + v_rd_base(lane);
    const bf16_t* Dq = (const bf16_t*)(wsp() + WS_DQ); const bf16_t* Kb = (const bf16_t*)(wsp() + WS_KB); const bf16_t* Vb = (const bf16_t*)(wsp() + WS_VB);
    const size_t srow = (size_t)SR0 + (size_t)b * 64;
    bf16x8 qr[8];
#pragma unroll
    for (int d0 = 0; d0 < 8; ++d0) qr[d0] = load8(Dq + (srow + 32 * rh + r32) * DM + h * 256 + map * 128 + d0 * 16 + hi * 8);
    float m_reg = -1e30f, l_reg = 0.f; f32x16 o[4] = {};
    const float* ck = inp(2) + ((size_t)b * PAST * 8 + h) * 256; const float* cv = inp(3) + ((size_t)b * PAST * 8 + h) * 256;
    f32x4 R[16];
#define SMP_LOAD(jj) do { if ((jj) < 16) { _Pragma("unroll") for (int part = 0; part < 4; ++part) { const float* xp = (part < 2 ? ck : cv) + (size_t)(64 * (jj) + sr) * 2048 + (part & 1) * 128 + sc;   \
            R[4 * part] = *(const f32x4*)xp; R[4 * part + 1] = *(const f32x4*)(xp + 4); R[4 * part + 2] = *(const f32x4*)(xp + 32 * 2048); R[4 * part + 3] = *(const f32x4*)(xp + 32 * 2048 + 4); } }   \
        else { _Pragma("unroll") for (int part = 0; part < 4; ++part) { const bf16_t* xp = part < 2 ? Kb + ((size_t)(h * 2 + part) * TP + srow + sr) * 128 + 8 * ((sc >> 3) ^ (sr & 7)) : Vb + ((size_t)h * TP + srow) * 256 + (v_img_off(sr, (part & 1) * 128 + sc) >> 1);   \
            const u32x4 u0 = *(const u32x4*)xp, u1 = *(const u32x4*)(xp + (size_t)(part < 2 ? 32 * 128 : 8192));   \
            R[4 * part] = (f32x4){bf_lo(u0[0]), bf_hi(u0[0]), bf_lo(u0[1]), bf_hi(u0[1])}; R[4 * part + 1] = (f32x4){bf_lo(u0[2]), bf_hi(u0[2]), bf_lo(u0[3]), bf_hi(u0[3])};   \
            R[4 * part + 2] = (f32x4){bf_lo(u1[0]), bf_hi(u1[0]), bf_lo(u1[1]), bf_hi(u1[1])}; R[4 * part + 3] = (f32x4){bf_lo(u1[2]), bf_hi(u1[2]), bf_lo(u1[3]), bf_hi(u1[3])}; } } } while (0)
    SMP_LOAD(0);
    for (int j = 0; j < 17; ++j) {
#pragma unroll
        for (int part = 0; part < 4; ++part) { const int sub = part & 1;
            const f32x4 a0 = R[4 * part], a1 = R[4 * part + 1], a2 = R[4 * part + 2], a3 = R[4 * part + 3];
            u32x4 w0 = (u32x4){cvt_pk_bf16(a0[0], a0[1]), cvt_pk_bf16(a0[2], a0[3]), cvt_pk_bf16(a1[0], a1[1]), cvt_pk_bf16(a1[2], a1[3])};
            u32x4 w1 = (u32x4){cvt_pk_bf16(a2[0], a2[1]), cvt_pk_bf16(a2[2], a2[3]), cvt_pk_bf16(a3[0], a3[1]), cvt_pk_bf16(a3[2], a3[3])};
            const bf16x8 x0 = __builtin_bit_cast(bf16x8, w0), x1 = __builtin_bit_cast(bf16x8, w1);
            if (part < 2) { *(bf16x8*)(K_lds + sub * SHM_K + kws) = x0; *(bf16x8*)(K_lds + sub * SHM_K + kws + 32 * 256) = x1; }
            else { *(bf16x8*)(V_lds + sub * SHM_V + vst0) = x0; *(bf16x8*)(V_lds + sub * SHM_V + vst1) = x1; } }
        __syncthreads();
        if (j + 1 < 17) SMP_LOAD(j + 1);
        f32x16 p0, p1; float mn, al; bf16x8 pa0, pa1, pa2, pa3;
        qkt<0>(p0, p1, K_lds + map * SHM_K, r32, hi, qr, true);
        partialSM(p0, p1, m_reg, mn, al);
        finishSM(p0, p1, al, l_reg, pa0, pa1, pa2, pa3);
        if (__any(al < 1.f)) { if (hi == 0) al_l[r32] = al; asm volatile("s_waitcnt lgkmcnt(0)" ::: "memory");
            for (int d_ = 0; d_ < 4; ++d_) for (int r = 0; r < 16; ++r) o[d_][r] *= al_l[crow(r, hi)]; }
        pv_tile<0>(o, vb0, pa0, pa1, pa2, pa3, true);
        __syncthreads();
    }
#undef SMP_LOAD
    if (hi == 0) li_l[r32] = l_reg; asm volatile("s_waitcnt lgkmcnt(0)" ::: "memory");
    int hie = hi; asm volatile("" : "+v"(hie));
    float rli[16];
#pragma unroll
    for (int r = 0; r < 16; ++r) rli[r] = __builtin_amdgcn_rcpf(li_l[crow(r, hie)]);
    float* X = (float*)lds + ((vhf * 2 + rh) * 32 + 4 * hie) * 128 + r32;
    if (map == 1) {
#pragma unroll
        for (int r = 0; r < 16; ++r)
#pragma unroll
            for (int d0 = 0; d0 < 4; ++d0) X[((r & 3) + 8 * (r >> 2)) * 128 + d0 * 32] = lam * (o[d0][r] * rli[r]); }
    __syncthreads();
    if (map == 0) { bf16_t* Ow = (bf16_t*)(wsp() + WS_OD) + (srow + 32 * rh + 4 * hie) * DM + h * 256 + vhf * 128 + r32;
#pragma unroll
        for (int r = 0; r < 16; ++r) { const int ro = (r & 3) + 8 * (r >> 2);
#pragma unroll
            for (int d0 = 0; d0 < 4; ++d0) { const float v = o[d0][r] * rli[r] - X[ro * 128 + d0 * 32]; const float vn = xor1(v);
                if ((r32 & 1) == 0) *(unsigned*)(Ow + ro * DM + d0 * 32) = cvt_pk_bf16(v, vn); } } }
    __syncthreads();
}
constexpr int Q_SCAN_P = 64, Q_SCAN_S = 1024, Q_ATT_P = 1040, Q_ATT_S = 256, Q_TOTAL = Q_SCAN_P + Q_SCAN_S + Q_ATT_P + Q_ATT_S;
__device__ __forceinline__ int q_next(Frame& F, int slot) {
    __syncthreads();
    if (TID == 0) { gu32* qp = ((gu32*)wsp()) + CW_QUEUE + 64 * slot; unsigned old_, zero_ = 0u, one_ = 1u;
        asm volatile("global_atomic_add %0, %1, %2, %3 sc0\n\ts_waitcnt vmcnt(0)" : "=&v"(old_) : "v"(zero_), "v"(one_), "s"(qp) : "memory");
        F.MISC[4] = old_; }
    __syncthreads();
    volatile LAS unsigned* mp = F.MISC + 4; asm volatile("" : "+v"(mp));
    return __builtin_amdgcn_readfirstlane((int)*mp);
}
__device__ __forceinline__ void p3_run(Frame& F) {
    const float lam = __uint_as_float(__builtin_amdgcn_readfirstlane(__float_as_uint(diff_lambda(F))));
    for (;;) { const int it = q_next(F, 0); if (it >= Q_SCAN_P + Q_SCAN_S) break;
        if (it < Q_SCAN_P) scan_unit(F, (it & 7) >> 2, it & 3, it >> 3);
        else { const int j = it - Q_SCAN_P; scan_unit(F, 2 + (j >> 5), (j >> 3) & 3, j & 7); } }
    for (;;) { const int it = q_next(F, 2); if (it >= Q_ATT_S) break; attn_sample_item(F, it >> 3, it & 7, lam); }
    for (;;) { const int it = q_next(F, 1); if (it >= Q_ATT_P) break;
        const int bb = it >= 520 ? 1 : 0, r_ = it - 520 * bb, I = 64 - (r_ >> 3); attn_item(F, bb, r_ & 7, I, lam); }
    { LAS float* scr = (LAS float*)(F.lds + RING_OFF + F.wave * 16384);
      for (;;) { const int it = q_next(F, 3); if (it >= CV_TOTAL / 32) break;
          for (int s_ = 0; s_ < 4; ++s_) conv_item(F, it * 32 + s_ * 8 + F.wave, scr); } }
}

__device__ __forceinline__ void p4_row(Frame& F, int m) {
    const int lane = LANE;
    { u32x4* op = (u32x4*)((bf16_t*)(wsp() + WS_GV) + (size_t)m * DM) + lane; const u32x4* rp = (const u32x4*)((const bf16_t*)(wsp() + WS_RB) + (size_t)m * DM) + lane;
      const f32x4* gp = (const f32x4*)inp(10) + lane * 2;
      const f32x4 g0 = gp[0], g1 = gp[1];
      u32x4 ov[4], rv[4];
#pragma unroll
      for (int j = 0; j < 4; ++j) { ov[j] = op[64 * j]; rv[j] = rp[64 * j]; }
#pragma unroll
      for (int j = 0; j < 4; ++j) { float ss = 0.f;
#pragma unroll
          for (int e = 0; e < 4; ++e) { const float a = bf_lo(ov[j][e]), b = bf_hi(ov[j][e]); ss += a * a + b * b; }
          const float rs = 1.0f / sqrtf(wave_sum(ss) * (1.f / 512.f) + EPS);
          u32x4 w;
          w[0] = cvt_pk_bf16(bf_lo(ov[j][0]) * rs * g0[0] * bf_lo(rv[j][0]), bf_hi(ov[j][0]) * rs * g0[1] * bf_hi(rv[j][0]));
          w[1] = cvt_pk_bf16(bf_lo(ov[j][1]) * rs * g0[2] * bf_lo(rv[j][1]), bf_hi(ov[j][1]) * rs * g0[3] * bf_hi(rv[j][1]));
          w[2] = cvt_pk_bf16(bf_lo(ov[j][2]) * rs * g1[0] * bf_lo(rv[j][2]), bf_hi(ov[j][2]) * rs * g1[1] * bf_hi(rv[j][2]));
          w[3] = cvt_pk_bf16(bf_lo(ov[j][3]) * rs * g1[2] * bf_lo(rv[j][3]), bf_hi(ov[j][3]) * rs * g1[3] * bf_hi(rv[j][3]));
          op[64 * j] = w; } }
    { u32x4* op = (u32x4*)((bf16_t*)(wsp() + WS_OD) + (size_t)m * DM) + lane;
      const f32x4* gp = (const f32x4*)inp(15) + (lane & 31) * 2;
      const f32x4 g0 = gp[0], g1 = gp[1];
      u32x4 ov[4];
#pragma unroll
      for (int j = 0; j < 4; ++j) ov[j] = op[64 * j];
#pragma unroll
      for (int j = 0; j < 4; ++j) { float ss = 0.f;
#pragma unroll
          for (int e = 0; e < 4; ++e) { const float a = bf_lo(ov[j][e]), b = bf_hi(ov[j][e]); ss += a * a + b * b; }
          ss += __shfl_xor(ss, 1); ss += __shfl_xor(ss, 2); ss += __shfl_xor(ss, 4); ss += __shfl_xor(ss, 8); ss += __shfl_xor(ss, 16);
          const float rs = 0.8f / sqrtf(ss * (1.f / 256.f) + EPS);
          u32x4 w;
          w[0] = cvt_pk_bf16(bf_lo(ov[j][0]) * rs * g0[0], bf_hi(ov[j][0]) * rs * g0[1]);
          w[1] = cvt_pk_bf16(bf_lo(ov[j][1]) * rs * g0[2], bf_hi(ov[j][1]) * rs * g0[3]);
          w[2] = cvt_pk_bf16(bf_lo(ov[j][2]) * rs * g1[0], bf_hi(ov[j][2]) * rs * g1[1]);
          w[3] = cvt_pk_bf16(bf_lo(ov[j][3]) * rs * g1[2], bf_hi(ov[j][3]) * rs * g1[3]);
          op[64 * j] = w; } }
}

#define OPAQUE(p) asm volatile("" : "+v"(p))
template <int MODE> struct EpiGate {
    static constexpr bool PERM = true;
    u32x4* st0; const u32x4* st1; bf16_t* O;
    __device__ __forceinline__ bool operator()(f32x4 (&acc)[2][2][4][2], const pg8::Unit& u, int wr, int wc, int fr, int fq) const {
        int tid = (wr * 4 + wc) * 64 + lane_id(); OPAQUE(tid);
        const size_t tb = (size_t)(u.pm * 8 + u.pn) * 8192 + tid;
        u32x4* p0 = st0 + tb; const u32x4* p1 = st1 + tb;
        bf16_t* op = O + (size_t)(u.pm * 256 + wr * 64 + (tid & 15)) * DM + u.pn * 256 + wc * 32 + 8 * ((tid >> 4) & 3);
        constexpr int PD = 4;
        const u32x4* l1 = p1; const u32x4* l0 = p0; u32x4 rb[PD], qb[PD];
        if (MODE != 0) {
#pragma unroll
            for (int k = 0; k < PD; ++k) { rb[k] = *l1; if (MODE == 2) qb[k] = *l0; l1 += 512; l0 += 512; OPAQUE(l1); OPAQUE(l0); }
            __builtin_amdgcn_sched_barrier(0); }
#pragma unroll
        for (int g = 0; g < 16; ++g) { const int ai = g >> 3, bj = (g >> 2) & 1, m = g & 3; const f32x4 x = acc[ai][bj][m][0], y = acc[ai][bj][m][1];
            if (MODE == 0) { *p0 = (u32x4){cvt_pk_bf16(sigmoidf_(x[0]), sigmoidf_(x[1])), cvt_pk_bf16(sigmoidf_(x[2]), sigmoidf_(x[3])), cvt_pk_bf16(sigmoidf_(y[0]), sigmoidf_(y[1])), cvt_pk_bf16(sigmoidf_(y[2]), sigmoidf_(y[3]))}; }
            else { const u32x4 r = rb[g % PD]; const u32x4 q = MODE == 2 ? qb[g % PD] : r;
                if (g + PD < 16) { rb[g % PD] = *l1; if (MODE == 2) qb[g % PD] = *l0; l1 += 512; l0 += 512; OPAQUE(l1); OPAQUE(l0); }
                const f32x4 v0 = x * (f32x4){bf_lo(r[0]), bf_hi(r[0]), bf_lo(r[1]), bf_hi(r[1])}, v1 = y * (f32x4){bf_lo(r[2]), bf_hi(r[2]), bf_lo(r[3]), bf_hi(r[3])};
                if (MODE == 1) { *p0 = (u32x4){cvt_pk_bf16(v0[0], v0[1]), cvt_pk_bf16(v0[2], v0[3]), cvt_pk_bf16(v1[0], v1[1]), cvt_pk_bf16(v1[2], v1[3])}; }
                else { const f32x4 w0 = v0 + (f32x4){bf_lo(q[0]), bf_hi(q[0]), bf_lo(q[1]), bf_hi(q[1])}, w1 = v1 + (f32x4){bf_lo(q[2]), bf_hi(q[2]), bf_lo(q[3]), bf_hi(q[3])};
                    *(u32x4*)((char*)O + pg8::a_img_off(u.pm * 256 + wr * 64 + (tid & 15) + ai * 128 + m * 16, u.pn * 256 + wc * 32 + 8 * ((tid >> 4) & 3) + bj * 128, DM)) = (u32x4){cvt_pk_bf16(w0[0], w0[1]), cvt_pk_bf16(w0[2], w0[3]), cvt_pk_bf16(w1[0], w1[1]), cvt_pk_bf16(w1[2], w1[3])}; } }
            p0 += 512; OPAQUE(p0); __builtin_amdgcn_sched_barrier(0); }
        return false;
    }
};
template <int ACT, bool IMG = false> struct EpiBf16 {
    static constexpr bool PERM = true;
    bf16_t* O; int ldc;
    __device__ __forceinline__ bool operator()(f32x4 (&acc)[2][2][4][2], const pg8::Unit& u, int wr, int wc, int fr, int fq) const {
        const int row0 = u.pm * 256 + wr * 64 + fr, col0 = u.pn * 256 + wc * 32 + 8 * fq;
#pragma unroll
        for (int ai = 0; ai < 2; ++ai)
#pragma unroll
            for (int m = 0; m < 4; ++m) { bf16_t* rowp = O + (size_t)(row0 + ai * 128 + m * 16) * ldc + col0;
#pragma unroll
                for (int bj = 0; bj < 2; ++bj) { f32x4 v0 = acc[ai][bj][m][0], v1 = acc[ai][bj][m][1];
                    if (ACT == 1) {
#pragma unroll
                        for (int j = 0; j < 4; ++j) { const float a = fmaxf(v0[j], 0.f), b = fmaxf(v1[j], 0.f); v0[j] = a * a; v1[j] = b * b; } }
                    *(u32x4*)(IMG ? (bf16_t*)((char*)O + pg8::a_img_off(row0 + ai * 128 + m * 16, col0 + bj * 128, ldc)) : rowp + bj * 128) = (u32x4){cvt_pk_bf16(v0[0], v0[1]), cvt_pk_bf16(v0[2], v0[3]), cvt_pk_bf16(v1[0], v1[1]), cvt_pk_bf16(v1[2], v1[3])}; } }
        return false;
    }
};

__device__ __forceinline__ void p7_row(Frame& F, int m) {
    const int lane = LANE; float* y; const float* x = row_x(F, m, y);
    bf16_t* u2b = (bf16_t*)(wsp() + WS_GV);
    if (!y) { rms_row_to_bf16(nullptr, nullptr, u2b, m, lane); return; }
    const bf16_t* t = (const bf16_t*)(wsp() + WS_GQK) + (size_t)m * DM;
    const GAS f32x4* xr = (const GAS f32x4*)x + lane; const GAS u32x2* tr = (const GAS u32x2*)t + lane;
    f32x4 tv[8]; float s = 0.f;
#pragma unroll
    for (int j = 0; j < 8; ++j) { const u32x2 w = tr[64 * j]; tv[j] = (f32x4){bf_lo(w[0]), bf_hi(w[0]), bf_lo(w[1]), bf_hi(w[1])}; s += (tv[j].x * tv[j].x + tv[j].y * tv[j].y) + (tv[j].z * tv[j].z + tv[j].w * tv[j].w); }
    const float rs = 1.0f / sqrtf(wave_sum(s) * (1.f / DM) + EPS);
    const GAS f32x4* g1 = (const GAS f32x4*)inp(19) + lane; float s2 = 0.f;
#pragma unroll
    for (int j = 0; j < 8; ++j) { const f32x4 hv = xr[64 * j] + tv[j] * rs * g1[64 * j]; tv[j] = hv; s2 += (hv.x * hv.x + hv.y * hv.y) + (hv.z * hv.z + hv.w * hv.w); }
    const float rs2 = 1.0f / sqrtf(wave_sum(s2) * (1.f / DM) + EPS);
    GAS f32x4* yr = (GAS f32x4*)y + lane; const GAS f32x4* g2 = (const GAS f32x4*)inp(20) + lane; GAS char* o8b = (GAS char*)u2b;
#pragma unroll
    for (int j = 0; j < 8; ++j) { yr[64 * j] = tv[j]; const f32x4 gg = g2[64 * j];
        *(GAS unsigned long long*)(o8b + pg8::a_img_off(m, 256 * j + 4 * lane, DM)) = (unsigned long long)cvt_pk_bf16(tv[j].x * rs2 * gg.x, tv[j].y * rs2 * gg.y) | ((unsigned long long)cvt_pk_bf16(tv[j].z * rs2 * gg.z, tv[j].w * rs2 * gg.w) << 32); }
}
__device__ __forceinline__ void p10_row(Frame& F, int m) {
    const int lane = LANE; float* y; (void)row_x(F, m, y); if (!y) return;
    const bf16_t* t = (const bf16_t*)(wsp() + WS_GQK) + (size_t)m * DM; const GAS u32x2* tr = (const GAS u32x2*)t + lane;
    f32x4 tv[8]; float s = 0.f;
#pragma unroll
    for (int j = 0; j < 8; ++j) { const u32x2 w = tr[64 * j]; tv[j] = (f32x4){bf_lo(w[0]), bf_hi(w[0]), bf_lo(w[1]), bf_hi(w[1])}; s += (tv[j].x * tv[j].x + tv[j].y * tv[j].y) + (tv[j].z * tv[j].z + tv[j].w * tv[j].w); }
    const float rs = 1.0f / sqrtf(wave_sum(s) * (1.f / DM) + EPS);
    GAS f32x4* yr = (GAS f32x4*)y + lane; const GAS f32x4* g = (const GAS f32x4*)inp(23) + lane;
#pragma unroll
    for (int j = 0; j < 8; ++j) yr[64 * j] = yr[64 * j] + tv[j] * rs * g[64 * j];
}
#ifndef PH_MASK
#define PH_MASK 0x7ff
#endif
#ifndef MK_N_LAUNCHES
#define MK_N_LAUNCHES 1
#endif
constexpr int N_PHASES = 11;
constexpr int WGM_P1 = 4, WGM_P5 = 4, WGM_P6 = 4, WGM_P8 = 4, WGM_P9 = 4;
__global__ void __launch_bounds__(512, 2) fwd(Args args) {
    extern __shared__ __attribute__((aligned(16))) unsigned char lds[];
    Frame F;
    F.lds = (LAS unsigned char*)lds; F.MISC = (volatile LAS unsigned*)(F.lds + MISC_OFF);
    F.wave = __builtin_amdgcn_readfirstlane((int)threadIdx.x >> 6);
    F.G = gridDim.x; F.gw = blockIdx.x * 8 + F.wave; F.NGW = F.G * 8;
    for (int u = (int)threadIdx.x; u < (LDS_BYTES - RING_BYTES) / 4; u += 512) ((LAS unsigned*)(F.lds + RING_BYTES))[u] = 0u;
    __syncthreads();
    if (MK_N_LAUNCHES == 1) (void)xcd_barrier_post((unsigned*)(((gu32*)wsp()) + CW_BAR), F.MISC + 8, F.wave);
    const int lo = args.ph_lo, hi = args.ph_hi;
#define IN(k) (lo <= (k) && (k) < hi)
#define SEAM(k) do { if (IN(k) && IN((k) + 1)) { XcdBarrier bar_; bar_.bar = (unsigned*)(((gu32*)wsp()) + CW_BAR); bar_.x = xb_xcc_id(); bar_.st = F.MISC + 8; bar_.wave = F.wave; xcd_barrier(bar_); } } while (0)
    if (((PH_MASK >> 0) & 1) && IN(0)) { p0_prologue(F); } SEAM(0);
    if (((PH_MASK >> 1) & 1) && IN(1)) {
        pg8::StaticOrderAI S{(const bf16_t*)(outp() + O_YP), (const bf16_t*)(wsp() + WS_W1G), TP / 256, N1 / 256, F.G, (int)blockIdx.x, DM, WGM_P1};
        EpiP1 E{wsp(), outp()};
        pg8::gemm_phase<EpiP1, pg8::StaticOrderAI>(F.lds + RING_OFF, DM, S, E, F.wave);
    } SEAM(1);
    if (((PH_MASK >> 2) & 1) && IN(2)) {
        for (int un = blockIdx.x; un < NCHUNK * 4; un += F.G) { const int g = un >> 2, h = un & 3;
            if (g < 520 && (g % 260) < 3) continue;
            p2_unit(F, g, h); }
    } SEAM(2);
    if (((PH_MASK >> 3) & 1) && IN(3)) { p3_run(F); } SEAM(3);
    if (((PH_MASK >> 4) & 1) && IN(4)) { for (int m = F.gw; m < TP; m += F.NGW) p4_row(F, m); } SEAM(4);
    if (((PH_MASK >> 5) & 1) && IN(5)) {
        const bf16_t* U = (const bf16_t*)(outp() + O_YP);
        u32x4* sga = (u32x4*)(wsp() + WS_KB); u32x4* sgb = (u32x4*)(wsp() + WS_VB); u32x4* sp = (u32x4*)(wsp() + WS_GQK);
        { pg8::StaticOrderAI S{U, (const bf16_t*)(wsp() + WS_WGATE), TP / 256, 8, F.G, (int)blockIdx.x, DM, WGM_P5}; EpiGate<0> E{sga, sga, nullptr}; pg8::gemm_phase<EpiGate<0>, pg8::StaticOrderAI>(F.lds + RING_OFF, DM, S, E, F.wave); }
        { pg8::StaticOrderAI S{U, (const bf16_t*)(wsp() + WS_WGATE) + (size_t)2048 * DM, TP / 256, 8, F.G, (int)blockIdx.x, DM, WGM_P5}; EpiGate<0> E{sgb, sgb, nullptr}; pg8::gemm_phase<EpiGate<0>, pg8::StaticOrderAI>(F.lds + RING_OFF, DM, S, E, F.wave); }
        { pg8::StaticOrder S{(const bf16_t*)(wsp() + WS_GV), (const bf16_t*)(wsp() + WS_WBRG), TP / 256, 8, F.G, (int)blockIdx.x, DM, WGM_P5}; EpiGate<1> E{sp, sga, nullptr}; pg8::gemm_phase<EpiGate<1>, pg8::StaticOrder>(F.lds + RING_OFF, DM, S, E, F.wave); }
        { pg8::StaticOrder S{(const bf16_t*)(wsp() + WS_OD), (const bf16_t*)(wsp() + WS_WBRD), TP / 256, 8, F.G, (int)blockIdx.x, DM, WGM_P5}; EpiGate<2> E{sp, sgb, (bf16_t*)(wsp() + WS_DQ)}; pg8::gemm_phase<EpiGate<2>, pg8::StaticOrder>(F.lds + RING_OFF, DM, S, E, F.wave); }
    } SEAM(5);
    if (((PH_MASK >> 6) & 1) && IN(6)) {
        pg8::StaticOrderAI S{(const bf16_t*)(wsp() + WS_DQ), (const bf16_t*)(wsp() + WS_WO), TP / 256, 8, F.G, (int)blockIdx.x, DM, WGM_P6, true};
        EpiBf16<0> E{(bf16_t*)(wsp() + WS_GQK), DM};
        pg8::gemm_phase<EpiBf16<0>, pg8::StaticOrderAI>(F.lds + RING_OFF, DM, S, E, F.wave);
    } SEAM(6);
    if (((PH_MASK >> 7) & 1) && IN(7)) {
        for (int m = F.gw; m < TP; m += F.NGW) p7_row(F, m);
    } SEAM(7);
    if (((PH_MASK >> 8) & 1) && IN(8)) {
        pg8::StaticOrderAI S{(const bf16_t*)(wsp() + WS_GV), (const bf16_t*)(wsp() + WS_WFF1), TP / 256, DFF / 256, F.G, (int)blockIdx.x, DM, WGM_P8};
        EpiBf16<1, true> E{(bf16_t*)(wsp() + WS_DQ), DFF};
        pg8::gemm_phase<EpiBf16<1, true>, pg8::StaticOrderAI>(F.lds + RING_OFF, DM, S, E, F.wave);
    } SEAM(8);
    if (((PH_MASK >> 9) & 1) && IN(9)) {
        pg8::StaticOrderAI S{(const bf16_t*)(wsp() + WS_DQ), (const bf16_t*)(wsp() + WS_WFF2), TP / 256, 8, F.G, (int)blockIdx.x, DFF, WGM_P9, true};
        EpiBf16<0> E{(bf16_t*)(wsp() + WS_GQK), DM};
        pg8::gemm_phase<EpiBf16<0>, pg8::StaticOrderAI>(F.lds + RING_OFF, DFF, S, E, F.wave);
    } SEAM(9);
    if (((PH_MASK >> 10) & 1) && IN(10)) { for (int m = F.gw; m < TP; m += F.NGW) p10_row(F, m); }
#undef IN
#undef SEAM
}

extern "C" void kernel_launch(void* const* d_in, const int* in_sizes, int n_in, void* d_out, int out_size, void* d_ws, size_t ws_size, hipStream_t stream) {
    static int grid = 0;
    if (grid == 0) {
        if (n_in != 24 || (size_t)out_size != O_END || ws_size < WS_END) { fprintf(stderr, "kernel_launch: unexpected shapes (n_in %d out %d ws %zu)\n", n_in, out_size, ws_size); grid = -1; return; }
        int dev = 0, cus = 0, per_cu = 0;
        if (hipGetDevice(&dev) != hipSuccess || hipDeviceGetAttribute(&cus, hipDeviceAttributeMultiprocessorCount, dev) != hipSuccess) { grid = -1; return; }
        if (hipFuncSetAttribute((const void*)fwd, hipFuncAttributeMaxDynamicSharedMemorySize, LDS_BYTES) != hipSuccess) { grid = -1; return; }
        if (hipOccupancyMaxActiveBlocksPerMultiprocessor(&per_cu, (const void*)fwd, 512, LDS_BYTES) != hipSuccess || per_cu < 1) { fprintf(stderr, "kernel_launch: occupancy query says %d\n", per_cu); }
        (void)hipGetLastError();
        grid = cus > 256 ? 256 : cus;
    }
    if (grid < 0) return;
    (void)hipMemsetAsync((char*)d_ws + WS_CTL, 0, CTL_ZERO_BYTES, stream);
    Args a{};
    for (int i = 0; i < 24; ++i) a.in[i] = (const float*)d_in[i];
    a.out = (float*)d_out; a.ws = (unsigned char*)d_ws;
    if (MK_N_LAUNCHES == 1) { a.ph_lo = 0; a.ph_hi = N_PHASES; hipLaunchKernelGGL(fwd, dim3(grid), dim3(512), LDS_BYTES, stream, a); }
    else { for (int p = 0; p < N_PHASES; ++p) { a.ph_lo = p; a.ph_hi = p + 1; hipLaunchKernelGGL(fwd, dim3(grid), dim3(512), LDS_BYTES, stream, a); } }
}
```
